# Optimizing an MI355X kernel written in HIP

```python
import jax, jax.numpy as jnp
from jax import lax
import numpy as np

D_MODEL = 4096
BATCH = 4
SEQ = 2048
DEPTH = 1

MEM_LEN = 256
MIX_WIDTH = D_MODEL
RET_WIDTH = MIX_WIDTH // 2
RET_HEADS = 8
RET_DH = RET_WIDTH // RET_HEADS
RET_CHUNK = 128
ROPE_BASE = 10000.0
GM_WIDTH = MIX_WIDTH - RET_WIDTH
GM_GROUPS = 8
GM_CG = GM_WIDTH // GM_GROUPS
GM_CHUNK = 128
XA_HEADS = 4
XA_DH = 256
XA_WIDTH = XA_HEADS * XA_DH
MOE_GROUPS = 8
MOE_PER_GROUP = 8
MOE_EXPERTS = MOE_GROUPS * MOE_PER_GROUP
MOE_TOPK = 2
MOE_FF = 512
MOE_BLOCK = 128
NORM_EPS = 1e-6
IN_COLS = 4 * RET_WIDTH + 2 * GM_WIDTH

kernel_name = "hybrid_retention_gmlp_hmoe_layer"


def standardize(x):
    xf = x.astype(jnp.float32)
    mu = jnp.mean(xf, axis=-1, keepdims=True)
    var = jnp.mean(jnp.square(xf - mu), axis=-1, keepdims=True)
    return ((xf - mu) * lax.rsqrt(var + NORM_EPS)).astype(x.dtype)


def layer_norm(x, g, b):
    return standardize(x) * g + b


def rms_norm(x, g):
    xf = x.astype(jnp.float32)
    xf = xf * lax.rsqrt(jnp.mean(xf * xf, axis=-1, keepdims=True) + NORM_EPS)
    return xf.astype(x.dtype) * g


def rotary(t, cos, sin):
    half = t.shape[-1] // 2
    t1, t2 = t[..., :half], t[..., half:]
    return jnp.concatenate([t1 * cos - t2 * sin, t1 * sin + t2 * cos], axis=-1)


def retention_chunkwise(q, k, v):
    B, S, H, dk = q.shape
    dv = v.shape[-1]
    C = RET_CHUNK
    NC = S // C
    dt = q.dtype
    log_gamma = jnp.log(1.0 - jnp.exp2(-5.0 - jnp.arange(H, dtype=jnp.float32)))
    pos = jnp.arange(C, dtype=jnp.float32)
    diff = pos[:, None] - pos[None, :]
    decay = jnp.where(diff >= 0, jnp.exp(jnp.maximum(diff, 0.0) * log_gamma[:, None, None]), 0.0).astype(dt)
    q_decay = jnp.exp((pos + 1.0) * log_gamma[:, None]).astype(dt)
    k_decay = jnp.exp((C - 1.0 - pos) * log_gamma[:, None]).astype(dt)
    chunk_decay = jnp.exp(C * log_gamma).astype(dt)

    def to_chunks(t):
        return t.reshape(B, NC, C, H, t.shape[-1]).transpose(1, 0, 3, 2, 4)

    qc, kc, vc = to_chunks(q), to_chunks(k), to_chunks(v)
    inner = jnp.einsum('nbhqd,nbhkd->nbhqk', qc, kc) * decay
    inner = jnp.einsum('nbhqk,nbhke->nbhqe', inner, vc)

    def step(state, chunk):
        q_i, k_i, v_i = chunk
        cross = jnp.einsum('bhqd,bhde->bhqe', q_i * q_decay[None, :, :, None], state)
        state = state * chunk_decay[None, :, None, None] + jnp.einsum(
            'bhkd,bhke->bhde', k_i * k_decay[None, :, :, None], v_i)
        return state, cross

    state0 = jnp.zeros((B, H, dk, dv), dt)
    _, cross = lax.scan(step, state0, (qc, kc, vc))
    out = inner + cross
    return out.transpose(1, 0, 3, 2, 4).reshape(B, S, H, dv)


def chunked_gmlp(u, v, ln_g, ln_b, ws, bs):
    B, S, W = v.shape
    C = GM_CHUNK
    NC = S // C
    u = jax.nn.gelu(u)
    v = layer_norm(jax.nn.gelu(v), ln_g, ln_b)
    mask = jnp.tril(jnp.ones((C, C), dtype=bool))
    w = jnp.where(mask[None], ws, 0.0)
    vc = v.reshape(B, NC, C, GM_GROUPS, GM_CG)
    spatial = jnp.einsum('gts,bnsgc->bntgc', w, vc) + bs.T[None, None, :, :, None]
    return u * spatial.reshape(B, S, W)


def token_mixer(xn, cos, sin, w_in, ret_norm_g, gm_ln_g, gm_ln_b, gm_ws, gm_bs, w_out):
    B, S, _ = xn.shape
    R, G = RET_WIDTH, GM_WIDTH
    q, k, v, g, u, vs = jnp.split(xn @ w_in, [R, 2 * R, 3 * R, 4 * R, 4 * R + G], axis=-1)

    def heads(t):
        return t.reshape(B, S, RET_HEADS, RET_DH)

    q = rotary(heads(q), cos, sin)
    k = rotary(heads(k), cos, sin) * (RET_DH ** -0.5)
    ret = retention_chunkwise(q, k, heads(v))
    ret = standardize(ret) * ret_norm_g.reshape(RET_HEADS, RET_DH)
    ret = jax.nn.silu(g) * ret.reshape(B, S, R)
    gm = chunked_gmlp(u, vs, gm_ln_g, gm_ln_b, gm_ws, gm_bs)
    return jnp.concatenate([ret, gm], axis=-1) @ w_out


def memory_cross_attention(hn, mn, wq, wkv, wo):
    B, S, _ = hn.shape
    M = mn.shape[1]
    q = (hn @ wq).reshape(B, S, XA_HEADS, XA_DH)
    k, v = jnp.split(mn @ wkv, 2, axis=-1)
    k = k.reshape(B, M, XA_HEADS, XA_DH)
    v = v.reshape(B, M, XA_HEADS, XA_DH)
    s = jnp.einsum('bshd,bmhd->bhsm', q, k).astype(jnp.float32) * (XA_DH ** -0.5)
    p = jax.nn.softmax(s, axis=-1).astype(v.dtype)
    o = jnp.einsum('bhsm,bmhd->bshd', p, v).reshape(B, S, XA_WIDTH)
    return o @ wo


def hierarchical_moe(xn, grp_w, grp_b, exp_w, exp_b, w_gate, w_up, w_down):
    B, S, D = xn.shape
    N = B * S
    dt = xn.dtype
    xt = xn.reshape(N, D)
    grp_prob = jax.nn.softmax((xt @ grp_w + grp_b).astype(jnp.float32), axis=-1)
    grp_idx = jnp.argmax(grp_prob, axis=-1)
    grp_gate = jnp.take_along_axis(grp_prob, grp_idx[:, None], axis=-1)
    exp_logits = (xt @ exp_w + exp_b).astype(jnp.float32).reshape(N, MOE_GROUPS, MOE_PER_GROUP)
    in_group = jnp.take_along_axis(exp_logits, grp_idx[:, None, None], axis=1)[:, 0]
    top_val, top_idx = lax.top_k(in_group, MOE_TOPK)
    gates = (jax.nn.softmax(top_val, axis=-1) * grp_gate).astype(dt)
    expert_id = (grp_idx[:, None] * MOE_PER_GROUP + top_idx).astype(jnp.int32)

    A = N * MOE_TOPK
    e_flat = expert_id.reshape(A)
    t_flat = jnp.repeat(jnp.arange(N, dtype=jnp.int32), MOE_TOPK)
    g_flat = gates.reshape(A)
    order = jnp.argsort(e_flat)
    e_s, t_s, g_s = e_flat[order], t_flat[order], g_flat[order]
    counts = jax.ops.segment_sum(jnp.ones((A,), jnp.int32), e_flat, num_segments=MOE_EXPERTS)
    starts = jnp.cumsum(counts) - counts
    padded = (counts + MOE_BLOCK - 1) // MOE_BLOCK * MOE_BLOCK
    pad_end = jnp.cumsum(padded)
    pad_start = pad_end - padded
    dest = pad_start[e_s] + (jnp.arange(A, dtype=jnp.int32) - starts[e_s])
    n_blocks = -(-A // MOE_BLOCK) + MOE_EXPERTS
    n_rows = n_blocks * MOE_BLOCK
    row_tok = jnp.zeros((n_rows,), jnp.int32).at[dest].set(t_s)
    row_gate = jnp.zeros((n_rows,), dt).at[dest].set(g_s)
    block_start = jnp.arange(n_blocks, dtype=jnp.int32) * MOE_BLOCK
    block_exp = jnp.minimum(jnp.searchsorted(pad_end, block_start, side='right'), MOE_EXPERTS - 1)

    def expert_block(args):
        e, toks, g = args
        xb = xt[toks]
        hdn = jax.nn.silu(xb @ w_gate[e]) * (xb @ w_up[e])
        return (hdn @ w_down[e]) * g[:, None]

    y = lax.map(expert_block, (block_exp, row_tok.reshape(n_blocks, MOE_BLOCK),
                               row_gate.reshape(n_blocks, MOE_BLOCK)))
    out = jnp.zeros((N, D), y.dtype).at[row_tok].add(y.reshape(n_rows, D))
    return out.reshape(B, S, D)


def setup_inputs(seed: int = 0) -> dict:
    key = jax.random.key(seed)
    ks = jax.random.split(key, 25)

    def nrm(k, shape, scale):
        return jax.random.normal(k, shape, jnp.float32) * scale

    def gain(k, shape):
        return 1.0 + 0.1 * jax.random.normal(k, shape, jnp.float32)

    D = D_MODEL
    positions = (jax.random.randint(ks[2], (BATCH, 1), 0, 4096, dtype=jnp.int32)
                 + jnp.arange(SEQ, dtype=jnp.int32)[None, :])
    return {
        "x": nrm(ks[0], (BATCH, SEQ, D), 1.0),
        "mem": nrm(ks[1], (BATCH, MEM_LEN, D), 1.0),
        "positions": positions,
        "norm_mix_g": gain(ks[3], (D,)),
        "w_in": nrm(ks[4], (D, IN_COLS), D ** -0.5),
        "ret_norm_g": gain(ks[5], (RET_WIDTH,)),
        "gm_ln_g": gain(ks[6], (GM_WIDTH,)),
        "gm_ln_b": nrm(ks[7], (GM_WIDTH,), 0.02),
        "gm_ws": nrm(ks[8], (GM_GROUPS, GM_CHUNK, GM_CHUNK), GM_CHUNK ** -0.5),
        "gm_bs": gain(ks[9], (GM_GROUPS, GM_CHUNK)),
        "w_out": nrm(ks[10], (MIX_WIDTH, D), MIX_WIDTH ** -0.5),
        "norm_xa_g": gain(ks[11], (D,)),
        "norm_mem_g": gain(ks[12], (D,)),
        "xa_wq": nrm(ks[13], (D, XA_WIDTH), D ** -0.5),
        "xa_wkv": nrm(ks[14], (D, 2 * XA_WIDTH), D ** -0.5),
        "xa_wo": nrm(ks[15], (XA_WIDTH, D), XA_WIDTH ** -0.5),
        "norm_moe_g": gain(ks[16], (D,)),
        "router_grp_w": nrm(ks[17], (D, MOE_GROUPS), D ** -0.5),
        "router_grp_b": nrm(ks[18], (MOE_GROUPS,), 0.01),
        "router_exp_w": nrm(ks[19], (D, MOE_EXPERTS), D ** -0.5),
        "router_exp_b": nrm(ks[20], (MOE_EXPERTS,), 0.01),
        "moe_w_gate": nrm(ks[21], (MOE_EXPERTS, D, MOE_FF), D ** -0.5),
        "moe_w_up": nrm(ks[22], (MOE_EXPERTS, D, MOE_FF), D ** -0.5),
        "moe_w_down": nrm(ks[23], (MOE_EXPERTS, MOE_FF, D), MOE_FF ** -0.5),
        "norm_final_g": gain(ks[24], (D,)),
    }


def reference(x, mem, positions, norm_mix_g, w_in, ret_norm_g, gm_ln_g, gm_ln_b, gm_ws, gm_bs,
              w_out, norm_xa_g, norm_mem_g, xa_wq, xa_wkv, xa_wo, norm_moe_g,
              router_grp_w, router_grp_b, router_exp_w, router_exp_b,
              moe_w_gate, moe_w_up, moe_w_down, norm_final_g):
    inv_freq = ROPE_BASE ** (-jnp.arange(0, RET_DH, 2, dtype=jnp.float32) / RET_DH)
    ang = positions.astype(jnp.float32)[..., None] * inv_freq
    cos = jnp.cos(ang)[:, :, None, :].astype(x.dtype)
    sin = jnp.sin(ang)[:, :, None, :].astype(x.dtype)
    h = x
    for _layer in range(DEPTH):
        h = h + token_mixer(rms_norm(h, norm_mix_g), cos, sin, w_in, ret_norm_g,
                            gm_ln_g, gm_ln_b, gm_ws, gm_bs, w_out)
        h = h + memory_cross_attention(rms_norm(h, norm_xa_g), rms_norm(mem, norm_mem_g),
                                       xa_wq, xa_wkv, xa_wo)
        h = h + hierarchical_moe(rms_norm(h, norm_moe_g), router_grp_w, router_grp_b,
                                 router_exp_w, router_exp_b, moe_w_gate, moe_w_up, moe_w_down)
    return rms_norm(h, norm_final_g)
```

```cpp
#include <hip/hip_runtime.h>
#include <cstdio>
#include <cstdint>

constexpr int D = 4096, NB = 4, SEQ = 2048, NTOK = NB * SEQ, MEML = 256, NMEM = NB * MEML;
constexpr int RW = 2048, GMW = 2048, INC = 12288, RH = 8, RDH = 256, GG = 8, GCG = 256, CHK = 128;
constexpr int XH = 4, XDH = 256, XW = 1024;
constexpr int NE = 64, FF = 512;
constexpr float EPS = 1e-6f;
constexpr int NT = 512;

__device__ __forceinline__ float wave_sum(float v) {
#pragma unroll
    for (int o = 1; o < 64; o <<= 1) v += __shfl_xor(v, o);
    return v;
}
__device__ __forceinline__ float block_sum(float v, float* red) {
    v = wave_sum(v);
    __syncthreads();
    if ((threadIdx.x & 63) == 0) red[threadIdx.x >> 6] = v;
    __syncthreads();
    float s = 0.f;
#pragma unroll
    for (int i = 0; i < 8; ++i) s += red[i];
    return s;
}
__device__ __forceinline__ float gelu_tanh(float x) { return 0.5f * x * (1.0f + tanhf(0.7978845608028654f * (x + 0.044715f * x * x * x))); }
__device__ __forceinline__ float silu(float x) { return x / (1.0f + expf(-x)); }

__global__ void __launch_bounds__(NT) k_rmsnorm(const float* x, const float* g, float* out, int rows) {
    __shared__ float red[8];
    for (int r = blockIdx.x; r < rows; r += gridDim.x) {
        const float* xr = x + (size_t)r * D; float ss = 0.f;
        for (int c = threadIdx.x; c < D; c += NT) { float v = xr[c]; ss += v * v; }
        ss = block_sum(ss, red);
        const float rs = rsqrtf(ss / D + EPS);
        for (int c = threadIdx.x; c < D; c += NT) out[(size_t)r * D + c] = xr[c] * rs * g[c];
    }
}

struct GArgs {
    const float* A; const float* B; float* C;
    int lda, ldb, ldc, M, N, K;
    const int* arow; const int* crow; const int* cnt; const int* off;
    long long strideB; int nbatch; int maxM;
};
__global__ void __launch_bounds__(NT) k_gemm(GArgs g) {
    __shared__ float As[16][132];
    __shared__ float Bs[16][68];
    const int tid = threadIdx.x, tx = tid & 15, ty = tid >> 4;
    const int ntn = g.N / 64, ntm = (g.maxM + 127) / 128;
    const long long nvb = (long long)g.nbatch * ntm * ntn;
    for (long long vb = blockIdx.x; vb < nvb; vb += gridDim.x) {
        const int z = (int)(vb / ((long long)ntm * ntn)); const int rem = (int)(vb % ((long long)ntm * ntn));
        const int tm = rem / ntn, tn = rem % ntn;
        const int M = g.cnt ? g.cnt[z] : g.M; const int row0 = tm * 128; if (row0 >= M) continue;
        const int base = g.off ? g.off[z] : 0; const float* Bz = g.B + (size_t)z * g.strideB; const int col0 = tn * 64;
        float acc[4][4];
#pragma unroll
        for (int i = 0; i < 4; ++i)
#pragma unroll
            for (int j = 0; j < 4; ++j) acc[i][j] = 0.f;
        for (int k0 = 0; k0 < g.K; k0 += 16) {
            __syncthreads();
#pragma unroll
            for (int i = 0; i < 4; ++i) { const int e = tid + i * NT, r = e >> 4, kk = e & 15, gr = row0 + r; float v = 0.f;
                if (gr < M) { const int ar = g.arow ? g.arow[base + gr] : base + gr; v = g.A[(size_t)ar * g.lda + k0 + kk]; }
                As[kk][r] = v; }
#pragma unroll
            for (int i = 0; i < 2; ++i) { const int e = tid + i * NT, kk = e >> 6, n = e & 63; Bs[kk][n] = Bz[(size_t)(k0 + kk) * g.ldb + col0 + n]; }
            __syncthreads();
#pragma unroll
            for (int kk = 0; kk < 16; ++kk) {
                float a[4], b[4];
#pragma unroll
                for (int i = 0; i < 4; ++i) { a[i] = As[kk][ty * 4 + i]; b[i] = Bs[kk][tx * 4 + i]; }
#pragma unroll
                for (int i = 0; i < 4; ++i)
#pragma unroll
                    for (int j = 0; j < 4; ++j) acc[i][j] += a[i] * b[j];
            }
        }
#pragma unroll
        for (int i = 0; i < 4; ++i) { const int gr = row0 + ty * 4 + i;
            if (gr < M) { const int cr = g.crow ? g.crow[base + gr] : base + gr;
#pragma unroll
                for (int j = 0; j < 4; ++j) g.C[(size_t)cr * g.ldc + col0 + tx * 4 + j] = acc[i][j]; } }
    }
}

__global__ void __launch_bounds__(NT) k_rotary(float* proj, const int* pos) {
    const size_t total = (size_t)NTOK * 2 * RH * 128;
    for (size_t i = (size_t)blockIdx.x * NT + threadIdx.x; i < total; i += (size_t)gridDim.x * NT) {
        const int j = (int)(i & 127); const int h = (int)((i >> 7) & 7); const int w = (int)((i >> 10) & 1); const size_t row = i >> 11;
        const float inv = powf(10000.0f, -(float)(2 * j) / 256.0f);
        const float ang = (float)pos[row] * inv; const float c = cosf(ang), s = sinf(ang);
        float* p = proj + row * INC + w * RW + h * RDH + j;
        const float t1 = p[0], t2 = p[128]; const float sc = w ? 0.0625f : 1.0f;
        p[0] = (t1 * c - t2 * s) * sc; p[128] = (t1 * s + t2 * c) * sc;
    }
}

__global__ void __launch_bounds__(NT) k_retention(const float* proj, float* ret) {
    const int nvb = NB * RH * 8;
    for (int vb = blockIdx.x; vb < nvb; vb += gridDim.x) {
        const int es = vb & 7, h = (vb >> 3) & 7, b = vb >> 6;
        const int tid = threadIdx.x, dg = tid & 15, el = tid >> 4, e = es * 32 + el;
        const float gamma = 1.0f - exp2f(-5.0f - (float)h);
        float st[16];
#pragma unroll
        for (int i = 0; i < 16; ++i) st[i] = 0.f;
        for (int t = 0; t < SEQ; ++t) {
            const size_t row = (size_t)b * SEQ + t; const float* pr = proj + row * INC + h * RDH;
            const float4* q4 = (const float4*)(pr + dg * 16); const float4* k4 = (const float4*)(pr + RW + dg * 16);
            const float vv = pr[2 * RW + e]; float part = 0.f;
#pragma unroll
            for (int i = 0; i < 4; ++i) { const float4 qq = q4[i], kk = k4[i];
                st[4 * i + 0] = gamma * st[4 * i + 0] + kk.x * vv; part += qq.x * st[4 * i + 0];
                st[4 * i + 1] = gamma * st[4 * i + 1] + kk.y * vv; part += qq.y * st[4 * i + 1];
                st[4 * i + 2] = gamma * st[4 * i + 2] + kk.z * vv; part += qq.z * st[4 * i + 2];
                st[4 * i + 3] = gamma * st[4 * i + 3] + kk.w * vv; part += qq.w * st[4 * i + 3]; }
            part += __shfl_xor(part, 1); part += __shfl_xor(part, 2); part += __shfl_xor(part, 4); part += __shfl_xor(part, 8);
            if (dg == 0) ret[row * RW + h * RDH + e] = part;
        }
    }
}
__global__ void __launch_bounds__(NT) k_retpost(const float* ret, const float* proj, const float* rg, float* mix) {
    const int wave = threadIdx.x >> 6, lane = threadIdx.x & 63; const int nitem = NTOK * RH;
    for (int it = blockIdx.x * 8 + wave; it < nitem; it += gridDim.x * 8) {
        const int h = it & 7; const size_t row = it >> 3; const float* r = ret + row * RW + h * RDH;
        float v[4]; float s = 0.f;
#pragma unroll
        for (int i = 0; i < 4; ++i) { v[i] = r[lane + 64 * i]; s += v[i]; }
        const float mu = wave_sum(s) / 256.f; float q = 0.f;
#pragma unroll
        for (int i = 0; i < 4; ++i) { v[i] -= mu; q += v[i] * v[i]; }
        const float rs = rsqrtf(wave_sum(q) / 256.f + EPS);
#pragma unroll
        for (int i = 0; i < 4; ++i) { const int c = h * RDH + lane + 64 * i; const float gt = proj[row * INC + 3 * RW + c];
            mix[row * D + c] = silu(gt) * (v[i] * rs * rg[c]); }
    }
}
__global__ void __launch_bounds__(NT) k_gm_prep(float* proj, const float* lg, const float* lb) {
    __shared__ float red[8];
    for (int r = blockIdx.x; r < NTOK; r += gridDim.x) {
        float* u = proj + (size_t)r * INC + 4 * RW; float* vs = u + GMW;
        float v[4]; float s = 0.f;
#pragma unroll
        for (int i = 0; i < 4; ++i) { const int c = threadIdx.x + NT * i; u[c] = gelu_tanh(u[c]); v[i] = gelu_tanh(vs[c]); s += v[i]; }
        const float mu = block_sum(s, red) / (float)GMW; float q = 0.f;
#pragma unroll
        for (int i = 0; i < 4; ++i) { v[i] -= mu; q += v[i] * v[i]; }
        const float rs = rsqrtf(block_sum(q, red) / (float)GMW + EPS);
#pragma unroll
        for (int i = 0; i < 4; ++i) { const int c = threadIdx.x + NT * i; vs[c] = v[i] * rs * lg[c] + lb[c]; }
    }
}
__global__ void __launch_bounds__(NT) k_gm_spatial(const float* proj, const float* ws, const float* bs, float* mix) {
    const size_t total = (size_t)NTOK * GMW;
    for (size_t i = (size_t)blockIdx.x * NT + threadIdx.x; i < total; i += (size_t)gridDim.x * NT) {
        const int c = (int)(i & (GMW - 1)); const size_t row = i >> 11; const int t = (int)(row & (CHK - 1)); const size_t row0 = row - t; const int g = c >> 8;
        const float* w = ws + ((size_t)g * CHK + t) * CHK; float acc = 0.f;
        for (int s = 0; s <= t; ++s) acc += w[s] * proj[(row0 + s) * INC + 5 * RW + c];
        mix[row * D + RW + c] = proj[row * INC + 4 * RW + c] * (acc + bs[g * CHK + t]);
    }
}
__global__ void __launch_bounds__(NT) k_add(const float* a, const float* b, float* o, size_t n) {
    for (size_t i = (size_t)blockIdx.x * NT + threadIdx.x; i < n; i += (size_t)gridDim.x * NT) o[i] = a[i] + b[i];
}
__global__ void __launch_bounds__(NT) k_xattn(const float* qx, const float* kvx, float* ox) {
    __shared__ float qs[XDH]; __shared__ float ps[MEML]; __shared__ float red[8]; __shared__ float part[2][XDH];
    for (int it = blockIdx.x; it < NTOK * XH; it += gridDim.x) {
        const int h = it & 3; const size_t row = it >> 2; const int b = (int)(row / SEQ); const int tid = threadIdx.x;
        __syncthreads();
        if (tid < XDH) qs[tid] = qx[row * XW + h * XDH + tid];
        __syncthreads();
        float sc = -1e30f;
        if (tid < MEML) { const float* kr = kvx + ((size_t)b * MEML + tid) * (2 * XW) + h * XDH; float a = 0.f;
            for (int d = 0; d < XDH; ++d) a += qs[d] * kr[d];
            sc = a * 0.0625f; }
        float m = sc;
#pragma unroll
        for (int o = 1; o < 64; o <<= 1) m = fmaxf(m, __shfl_xor(m, o));
        __syncthreads(); if ((tid & 63) == 0) red[tid >> 6] = m; __syncthreads();
        float mx = red[0];
#pragma unroll
        for (int i = 1; i < 8; ++i) mx = fmaxf(mx, red[i]);
        const float ex = (tid < MEML) ? expf(sc - mx) : 0.f;
        const float sum = block_sum(ex, red);
        if (tid < MEML) ps[tid] = ex / sum;
        __syncthreads();
        { const int d = tid & 255, half = tid >> 8; float a = 0.f;
          for (int mm = half * 128; mm < half * 128 + 128; ++mm) a += ps[mm] * kvx[((size_t)b * MEML + mm) * (2 * XW) + XW + h * XDH + d];
          part[half][d] = a; }
        __syncthreads();
        if (tid < XDH) ox[row * XW + h * XDH + tid] = part[0][tid] + part[1][tid];
    }
}
__global__ void __launch_bounds__(NT) k_router(const float* hn, const float* gw, const float* gb, const float* ew, const float* eb, int* eid, float* gate, int* counts) {
    __shared__ float xs[D]; __shared__ float part[4][72]; __shared__ float lg[72];
    for (int tok = blockIdx.x; tok < NTOK; tok += gridDim.x) {
        const int tid = threadIdx.x;
        __syncthreads();
        for (int c = tid; c < D; c += NT) xs[c] = hn[(size_t)tok * D + c];
        __syncthreads();
        { const int j = tid & 127, kq = tid >> 7;
          if (j < 72) { float a = 0.f;
              if (j < 8) { for (int k = kq * 1024; k < kq * 1024 + 1024; ++k) a += xs[k] * gw[(size_t)k * 8 + j]; }
              else { for (int k = kq * 1024; k < kq * 1024 + 1024; ++k) a += xs[k] * ew[(size_t)k * 64 + (j - 8)]; }
              part[kq][j] = a; } }
        __syncthreads();
        if (tid < 72) lg[tid] = ((part[0][tid] + part[1][tid]) + (part[2][tid] + part[3][tid])) + (tid < 8 ? gb[tid] : eb[tid - 8]);
        __syncthreads();
        if (tid == 0) {
            int gi = 0; float gm = lg[0];
            for (int j = 1; j < 8; ++j) if (lg[j] > gm) { gm = lg[j]; gi = j; }
            float den = 0.f; for (int j = 0; j < 8; ++j) den += expf(lg[j] - gm);
            const float ggate = 1.0f / den;
            int i0 = 0; float v0 = lg[8 + gi * 8];
            for (int p = 1; p < 8; ++p) { const float v = lg[8 + gi * 8 + p]; if (v > v0) { v0 = v; i0 = p; } }
            int i1 = -1; float v1 = -3.0e38f;
            for (int p = 0; p < 8; ++p) { if (p == i0) continue; const float v = lg[8 + gi * 8 + p]; if (v > v1) { v1 = v; i1 = p; } }
            const float e1 = expf(v1 - v0); const float g0 = 1.0f / (1.0f + e1), g1 = e1 / (1.0f + e1);
            const int e0i = gi * 8 + i0, e1i = gi * 8 + i1;
            eid[tok * 2] = e0i; eid[tok * 2 + 1] = e1i; gate[tok * 2] = g0 * ggate; gate[tok * 2 + 1] = g1 * ggate;
            atomicAdd(&counts[e0i], 1); atomicAdd(&counts[e1i], 1);
        }
    }
}
__global__ void k_offsets(const int* counts, int* off, int* cursor) {
    if (threadIdx.x == 0 && blockIdx.x == 0) { int a = 0; for (int e = 0; e < NE; ++e) { off[e] = a; a += counts[e]; cursor[e] = 0; } }
}
__global__ void __launch_bounds__(NT) k_fill(const int* eid, const int* off, int* cursor, int* stok, int* sslot) {
    for (int i = blockIdx.x * NT + threadIdx.x; i < NTOK * 2; i += gridDim.x * NT) { const int e = eid[i]; const int p = off[e] + atomicAdd(&cursor[e], 1); stok[p] = i >> 1; sslot[p] = i; }
}
__global__ void __launch_bounds__(NT) k_silumul(float* hg, const float* hu, size_t n) {
    for (size_t i = (size_t)blockIdx.x * NT + threadIdx.x; i < n; i += (size_t)gridDim.x * NT) hg[i] = silu(hg[i]) * hu[i];
}
__global__ void __launch_bounds__(NT) k_final(const float* h, const float* Y, const float* gate, const float* g, float* out) {
    __shared__ float red[8];
    for (int r = blockIdx.x; r < NTOK; r += gridDim.x) {
        const float g0 = gate[2 * r], g1 = gate[2 * r + 1]; float v[8]; float ss = 0.f;
#pragma unroll
        for (int i = 0; i < 8; ++i) { const int c = threadIdx.x + NT * i; v[i] = (h[(size_t)r * D + c] + g0 * Y[(size_t)(2 * r) * D + c]) + g1 * Y[(size_t)(2 * r + 1) * D + c]; ss += v[i] * v[i]; }
        ss = block_sum(ss, red); const float rs = rsqrtf(ss / D + EPS);
#pragma unroll
        for (int i = 0; i < 8; ++i) { const int c = threadIdx.x + NT * i; out[(size_t)r * D + c] = v[i] * rs * g[c]; }
    }
}

static void gemm(hipStream_t st, const float* A, int lda, const float* B, int ldb, float* C, int ldc, int M, int N, int K) {
    GArgs g{}; g.A = A; g.B = B; g.C = C; g.lda = lda; g.ldb = ldb; g.ldc = ldc; g.M = M; g.N = N; g.K = K; g.nbatch = 1; g.maxM = M; g.strideB = 0;
    hipLaunchKernelGGL(k_gemm, dim3(4096), dim3(NT), 0, st, g);
}

extern "C" void kernel_launch(void* const* d_in, const int* in_sizes, int n_in, void* d_out, int out_size, void* d_ws, size_t ws_size, hipStream_t stream) {
    const float* x = (const float*)d_in[0]; const float* mem = (const float*)d_in[1]; const int* pos = (const int*)d_in[2];
    const float* g_mix = (const float*)d_in[3]; const float* w_in = (const float*)d_in[4]; const float* ret_g = (const float*)d_in[5];
    const float* ln_g = (const float*)d_in[6]; const float* ln_b = (const float*)d_in[7]; const float* gm_ws = (const float*)d_in[8]; const float* gm_bs = (const float*)d_in[9];
    const float* w_out = (const float*)d_in[10]; const float* g_xa = (const float*)d_in[11]; const float* g_mem = (const float*)d_in[12];
    const float* wq = (const float*)d_in[13]; const float* wkv = (const float*)d_in[14]; const float* wo = (const float*)d_in[15];
    const float* g_moe = (const float*)d_in[16]; const float* rgw = (const float*)d_in[17]; const float* rgb = (const float*)d_in[18];
    const float* rew = (const float*)d_in[19]; const float* reb = (const float*)d_in[20];
    const float* wg = (const float*)d_in[21]; const float* wu = (const float*)d_in[22]; const float* wd = (const float*)d_in[23]; const float* g_fin = (const float*)d_in[24];
    float* out = (float*)d_out;
    char* ws = (char*)d_ws; size_t o = 0;
    auto take = [&](size_t bytes) { char* p = ws + o; o += (bytes + 255) & ~(size_t)255; return p; };
    int* ctl = (int*)take(4096);
    float* n1 = (float*)take((size_t)NTOK * D * 4);
    float* proj = (float*)take((size_t)NTOK * INC * 4);
    float* ret = (float*)take((size_t)NTOK * RW * 4);
    float* mix = (float*)take((size_t)NTOK * D * 4);
    float* h = (float*)take((size_t)NTOK * D * 4);
    float* tmp = (float*)take((size_t)NTOK * D * 4);
    float* mn = (float*)take((size_t)NMEM * D * 4);
    float* qx = (float*)take((size_t)NTOK * XW * 4);
    float* kvx = (float*)take((size_t)NMEM * 2 * XW * 4);
    float* ox = (float*)take((size_t)NTOK * XW * 4);
    int* eid = (int*)take((size_t)NTOK * 2 * 4); float* gate = (float*)take((size_t)NTOK * 2 * 4);
    int* stok = (int*)take((size_t)NTOK * 2 * 4); int* sslot = (int*)take((size_t)NTOK * 2 * 4);
    float* hg = (float*)take((size_t)NTOK * 2 * FF * 4); float* hu = (float*)take((size_t)NTOK * 2 * FF * 4);
    if (o > ws_size) { fprintf(stderr, "kernel_launch: workspace too small: need %zu have %zu\n", o, ws_size); return; }
    float* Y = proj;
    int* counts = ctl, *off = ctl + 64, *cursor = ctl + 128;
    const int G = 2048;
    hipMemsetAsync(ctl, 0, 4096, stream);
    hipLaunchKernelGGL(k_rmsnorm, dim3(G), dim3(NT), 0, stream, x, g_mix, n1, NTOK);
    gemm(stream, n1, D, w_in, INC, proj, INC, NTOK, INC, D);
    hipLaunchKernelGGL(k_rotary, dim3(G), dim3(NT), 0, stream, proj, pos);
    hipLaunchKernelGGL(k_retention, dim3(NB * RH * 8), dim3(NT), 0, stream, (const float*)proj, ret);
    hipLaunchKernelGGL(k_retpost, dim3(G), dim3(NT), 0, stream, (const float*)ret, (const float*)proj, ret_g, mix);
    hipLaunchKernelGGL(k_gm_prep, dim3(G), dim3(NT), 0, stream, proj, ln_g, ln_b);
    hipLaunchKernelGGL(k_gm_spatial, dim3(G * 4), dim3(NT), 0, stream, (const float*)proj, gm_ws, gm_bs, mix);
    gemm(stream, mix, D, w_out, D, tmp, D, NTOK, D, D);
    hipLaunchKernelGGL(k_add, dim3(G), dim3(NT), 0, stream, x, (const float*)tmp, h, (size_t)NTOK * D);
    hipLaunchKernelGGL(k_rmsnorm, dim3(G), dim3(NT), 0, stream, (const float*)h, g_xa, n1, NTOK);
    hipLaunchKernelGGL(k_rmsnorm, dim3(NMEM), dim3(NT), 0, stream, mem, g_mem, mn, NMEM);
    gemm(stream, n1, D, wq, XW, qx, XW, NTOK, XW, D);
    gemm(stream, mn, D, wkv, 2 * XW, kvx, 2 * XW, NMEM, 2 * XW, D);
    hipLaunchKernelGGL(k_xattn, dim3(G * 2), dim3(NT), 0, stream, (const float*)qx, (const float*)kvx, ox);
    gemm(stream, ox, XW, wo, D, tmp, D, NTOK, D, XW);
    hipLaunchKernelGGL(k_add, dim3(G), dim3(NT), 0, stream, (const float*)h, (const float*)tmp, h, (size_t)NTOK * D);
    hipLaunchKernelGGL(k_rmsnorm, dim3(G), dim3(NT), 0, stream, (const float*)h, g_moe, n1, NTOK);
    hipLaunchKernelGGL(k_router, dim3(G), dim3(NT), 0, stream, (const float*)n1, rgw, rgb, rew, reb, eid, gate, counts);
    hipLaunchKernelGGL(k_offsets, dim3(1), dim3(64), 0, stream, (const int*)counts, off, cursor);
    hipLaunchKernelGGL(k_fill, dim3(32), dim3(NT), 0, stream, (const int*)eid, (const int*)off, cursor, stok, sslot);
    { GArgs g{}; g.A = n1; g.lda = D; g.B = wg; g.ldb = FF; g.C = hg; g.ldc = FF; g.M = 0; g.N = FF; g.K = D; g.arow = stok; g.crow = nullptr; g.cnt = counts; g.off = off; g.strideB = (long long)D * FF; g.nbatch = NE; g.maxM = NTOK;
      hipLaunchKernelGGL(k_gemm, dim3(4096), dim3(NT), 0, stream, g);
      g.B = wu; g.C = hu; hipLaunchKernelGGL(k_gemm, dim3(4096), dim3(NT), 0, stream, g); }
    hipLaunchKernelGGL(k_silumul, dim3(G), dim3(NT), 0, stream, hg, (const float*)hu, (size_t)NTOK * 2 * FF);
    { GArgs g{}; g.A = hg; g.lda = FF; g.B = wd; g.ldb = D; g.C = Y; g.ldc = D; g.M = 0; g.N = D; g.K = FF; g.arow = nullptr; g.crow = sslot; g.cnt = counts; g.off = off; g.strideB = (long long)FF * D; g.nbatch = NE; g.maxM = NTOK;
      hipLaunchKernelGGL(k_gemm, dim3(8192), dim3(NT), 0, stream, g); }
    hipLaunchKernelGGL(k_final, dim3(G), dim3(NT), 0, stream, (const float*)h, (const float*)Y, (const float*)gate, g_fin, out);
}
```

```cpp
#include <hip/hip_runtime.h>
#include <cstdio>
#include <cstdint>

#ifndef PG8_SP2
#define PG8_SP2 true
#endif
#ifndef PG8_ALIGN
#define PG8_ALIGN true
#endif
constexpr int NWAVES = 8, NT = 512;
constexpr int D = 4096, NB = 4, SEQ = 2048, NTOK = NB * SEQ, MEML = 256, NMEM = NB * MEML;
constexpr int RW = 2048, GMW = 2048, INC = 12288, RH = 8, RDH = 256, GG = 8, GCG = 256, CHK = 128;
constexpr int XH = 4, XDH = 256, XW = 1024;
constexpr int NE = 64, FF = 512, NSLOT = NTOK * 2;
constexpr float EPS = 1e-6f;
constexpr size_t MiB = 1u << 20;
constexpr size_t WS_CTL = 0, CTL_ZERO_BYTES = 1 * MiB;
constexpr size_t WS_WRT = 1 * MiB;
constexpr size_t WS_WIN = 3 * MiB;
constexpr size_t WS_WOUT = 99 * MiB;
constexpr size_t WS_WQ = 131 * MiB;
constexpr size_t WS_WKV = 139 * MiB;
constexpr size_t WS_WO = 155 * MiB;
constexpr size_t WS_XN = 163 * MiB;
constexpr size_t WS_MN = 227 * MiB;
constexpr size_t WS_COS = 235 * MiB, WS_SIN = 239 * MiB;
constexpr size_t WS_PROJ = 243 * MiB;
constexpr size_t WS_RET = 435 * MiB;
constexpr size_t WS_MIX = 467 * MiB;
constexpr size_t WS_H = 531 * MiB;
constexpr size_t WS_QX = 659 * MiB;
constexpr size_t WS_KVX = 675 * MiB;
constexpr size_t WS_OX = 679 * MiB;
constexpr size_t WS_EID = 695 * MiB;
constexpr size_t WS_HACT = 696 * MiB;
constexpr size_t WS_Y = 712 * MiB;
constexpr size_t WS_END = 840 * MiB;
constexpr int CW_TMO = 0, CW_CODE = 1, CW_BAR = 4096;
constexpr int RING_OFF = 0, RING_BYTES = 131072;
constexpr int LDSCTL_OFF = RING_BYTES, MISC_OFF = LDSCTL_OFF + 320;
constexpr int AUX_OFF = LDSCTL_OFF + 1024;
constexpr int LDS_BYTES = 147456;

#define GAS __attribute__((address_space(1)))
#define LAS __attribute__((address_space(3)))
typedef unsigned short bf16;
typedef unsigned v4u __attribute__((ext_vector_type(4)));
typedef unsigned v2u __attribute__((ext_vector_type(2)));
typedef float f32x4 __attribute__((ext_vector_type(4)));
typedef short bf16x8 __attribute__((ext_vector_type(8)));
typedef GAS unsigned gu32;
#define RLX_AGENT __ATOMIC_RELAXED, __HIP_MEMORY_SCOPE_AGENT
#define LDS_WAIT() asm volatile("s_waitcnt lgkmcnt(0)" ::: "memory")
#define VM_WAIT() asm volatile("s_waitcnt vmcnt(0)" ::: "memory")
__device__ __forceinline__ unsigned f2bf(float f) { unsigned u = __builtin_bit_cast(unsigned, f); return (u + 0x7fffu + ((u >> 16) & 1u)) >> 16; }
__device__ __forceinline__ unsigned pk2(float lo, float hi) { return f2bf(lo) | (f2bf(hi) << 16); }
__device__ __forceinline__ float bf2f(unsigned b) { return __builtin_bit_cast(float, b << 16); }
__device__ __forceinline__ float bflo(unsigned w) { return __builtin_bit_cast(float, w << 16); }
__device__ __forceinline__ float bfhi(unsigned w) { return __builtin_bit_cast(float, w & 0xffff0000u); }
__device__ __forceinline__ float wave_sum(float v) {
#pragma unroll
    for (int o = 1; o < 64; o <<= 1) v += __shfl_xor(v, o);
    return v;
}
__device__ __forceinline__ float fast_sigmoid(float x) { return __builtin_amdgcn_rcpf(1.0f + __builtin_amdgcn_exp2f(-1.4426950408889634f * x)); }
__device__ __forceinline__ float gelu_tanh_f(float x) { return x * fast_sigmoid(1.5957691216057308f * (x + 0.044715f * x * x * x)); }
__device__ __forceinline__ float silu_f(float x) { return x * fast_sigmoid(x); }
namespace pg8 {
#define PG8_LAS __attribute__((address_space(3)))
typedef unsigned short bf16_t;
typedef short bf16x8 __attribute__((ext_vector_type(8)));
typedef float f32x4 __attribute__((ext_vector_type(4)));
typedef unsigned u32x4 __attribute__((ext_vector_type(4)));
constexpr int BM = 256, BK = 64, HALF = 128, HTB = HALF * BK * 2  , STAGE_BYTES = 8 * HTB, NXCD = 8, WGM = 8;

__host__ __device__ __forceinline__ int lds_byte(int r, int c) { const int st = (r >> 4) * 2 + (c >> 5), rr = r & 15, cc = c & 31, ob = rr * 64 + cc * 2; return st * 1024 + (ob ^ (((ob >> 9) & 1) << 5)); }
__host__ __device__ __forceinline__ void stage_rc(int b, int& R, int& C) { const int st = b / 1024, sb = b % 1024, swz = sb ^ (((sb >> 9) & 1) << 5); R = (st >> 1) * 16 + swz / 64; C = (st & 1) * 32 + (swz % 64) / 2; }
__host__ __device__ __forceinline__ int perm32(int rho) { const int n = rho >> 4, i = rho & 15; return 8 * (i >> 2) + 4 * n + (i & 3); }

struct Unit { int pm, pn; };
struct Gemm { const bf16_t* A; const bf16_t* Bt; int M, N, K; };

struct StaticOrder {
    int nM, nN, nwg, G, c;
    __host__ __device__ void init(int M, int N, int G_, int c_) { nM = M / BM; nN = N / BM; nwg = nM * nN; G = G_; c = c_; }
    __host__ __device__ bool next(int i, Unit& u) const {
        const long L = (long)i * G + c; if (L >= nwg) return false;
        int wgid = (int)L; { const int q = nwg / NXCD, r = nwg % NXCD, xcd = wgid % NXCD, off = wgid / NXCD; wgid = (xcd < r ? xcd * (q + 1) : r * (q + 1) + (xcd - r) * q) + off; }
        const int nig = WGM * nN, gid = wgid / nig, fm = gid * WGM, gsz = (nM - fm) < WGM ? (nM - fm) : WGM;
        u.pm = fm + ((wgid % nig) % gsz); u.pn = (wgid % nig) / gsz; return true;
    }
    __device__ __forceinline__ void a_ready(const Unit&) const {}
    __device__ __forceinline__ void done(const Unit&) const {}
};

__device__ __forceinline__ unsigned cvt_pk_bf16(float lo, float hi) { unsigned r; asm volatile("v_cvt_pk_bf16_f32 %0, %1, %2" : "=v"(r) : "v"(lo), "v"(hi)); return r; }
typedef float f32x2 __attribute__((ext_vector_type(2)));
__device__ __forceinline__ f32x2 gelu_pk(f32x2 v) {
    const f32x2 av = __builtin_elementwise_abs(v), d = av * 0.2316418882f + 1.0f;
    f32x2 t; t.x = __builtin_amdgcn_rcpf(d.x); t.y = __builtin_amdgcn_rcpf(d.y);
    f32x2 q = t * 0.5307027145f + (-0.7265760135f); q = q * t + 0.7107068705f; q = q * t + (-0.142248368f); q = q * t + 0.127414796f; q = q * t;
    const f32x2 s = (v * v) * (-0.72134752044f);
    f32x2 e; e.x = __builtin_amdgcn_exp2f(s.x); e.y = __builtin_amdgcn_exp2f(s.y);
    const f32x2 m = v * (q * e), r = v - m;
    f32x2 o; o.x = v.x < 0.f ? m.x : r.x; o.y = v.y < 0.f ? m.y : r.y; return o;
}

template <int ACT  > struct EpiBf16 {
    static constexpr bool PERM = true, AFTER_DRAIN = false; static_assert(ACT == 0 || ACT == 1, "EpiBf16: ACT is 0 (none) or 1 (gelu_pk)");
    bf16_t* O; int ldc; const float* bias; int split_cols; size_t split_stride; float scale0;
    __device__ __forceinline__ void operator()(const f32x4 (&acc)[2][2][4][2], const Unit& u, int wr, int wc, int fr, int fq) const {
        const int row0 = u.pm * BM + wr * 64 + fr; int colt = u.pn * BM; bf16_t* base = O;
        float sc = 1.f; if (split_cols) { const int t = colt / split_cols; base += (size_t)t * split_stride; colt -= t * split_cols; if (t == 0) sc = scale0; }
        const int col0 = colt + wc * 32 + 8 * fq, bcol0 = u.pn * BM + wc * 32 + 8 * fq;
        f32x4 bv[2][2];
#pragma unroll
        for (int bj = 0; bj < 2; ++bj)
#pragma unroll
            for (int n = 0; n < 2; ++n) bv[bj][n] = bias ? *(const f32x4*)(bias + bcol0 + bj * HALF + 4 * n) : (f32x4){0.f, 0.f, 0.f, 0.f};
#pragma unroll
        for (int ai = 0; ai < 2; ++ai)
#pragma unroll
            for (int m = 0; m < 4; ++m) { bf16_t* rowp = base + (size_t)(row0 + ai * HALF + m * 16) * ldc + col0;
#pragma unroll
                for (int bj = 0; bj < 2; ++bj) { f32x4 v0 = acc[ai][bj][m][0] + bv[bj][0], v1 = acc[ai][bj][m][1] + bv[bj][1];
                    if (ACT == 1) { f32x2 a = gelu_pk((f32x2){v0[0], v0[1]}), b = gelu_pk((f32x2){v0[2], v0[3]}), c = gelu_pk((f32x2){v1[0], v1[1]}), d = gelu_pk((f32x2){v1[2], v1[3]});
                        v0 = (f32x4){a.x, a.y, b.x, b.y}; v1 = (f32x4){c.x, c.y, d.x, d.y}; }
                    v0 = v0 * sc; v1 = v1 * sc; u32x4 w; w.x = cvt_pk_bf16(v0[0], v0[1]); w.y = cvt_pk_bf16(v0[2], v0[3]); w.z = cvt_pk_bf16(v1[0], v1[1]); w.w = cvt_pk_bf16(v1[2], v1[3]);
                    *(u32x4*)(rowp + bj * HALF) = w; } }
    }
};

struct EpiProj {
    static constexpr bool PERM = true, AFTER_DRAIN = false;
    bf16_t* O; const float* cs; const float* sn;
    __device__ __forceinline__ void operator()(const f32x4 (&acc)[2][2][4][2], const Unit& u, int wr, int wc, int fr, int fq) const {
        const int sec = u.pn >> 3;
        const int row0 = u.pm * BM + wr * 64 + fr, j0 = wc * 32 + 8 * fq, col0 = u.pn * BM + j0;
#pragma unroll
        for (int ai = 0; ai < 2; ++ai)
#pragma unroll
            for (int m = 0; m < 4; ++m) {
                const int row = row0 + ai * HALF + m * 16;
                f32x4 a0 = acc[ai][0][m][0], a1 = acc[ai][0][m][1], b0 = acc[ai][1][m][0], b1 = acc[ai][1][m][1];
                if (sec < 2) {
                    const float* cp = cs + (size_t)row * 128 + j0; const float* sp = sn + (size_t)row * 128 + j0;
                    const f32x4 c0 = *(const f32x4*)cp, c1 = *(const f32x4*)(cp + 4), s0 = *(const f32x4*)sp, s1 = *(const f32x4*)(sp + 4);
                    const float sc = sec ? 0.0625f : 1.0f;
                    const f32x4 t0 = (a0 * c0 - b0 * s0) * sc, t1 = (a1 * c1 - b1 * s1) * sc;
                    b0 = (a0 * s0 + b0 * c0) * sc; b1 = (a1 * s1 + b1 * c1) * sc; a0 = t0; a1 = t1;
                } else if (sec == 3) {
#pragma unroll
                    for (int j = 0; j < 4; ++j) { a0[j] = silu_f(a0[j]); a1[j] = silu_f(a1[j]); b0[j] = silu_f(b0[j]); b1[j] = silu_f(b1[j]); }
                } else if (sec >= 4) {
#pragma unroll
                    for (int j = 0; j < 4; ++j) { a0[j] = gelu_tanh_f(a0[j]); a1[j] = gelu_tanh_f(a1[j]); b0[j] = gelu_tanh_f(b0[j]); b1[j] = gelu_tanh_f(b1[j]); }
                }
                bf16_t* rowp = O + (size_t)row * 12288 + col0;
                u32x4 w; w.x = cvt_pk_bf16(a0[0], a0[1]); w.y = cvt_pk_bf16(a0[2], a0[3]); w.z = cvt_pk_bf16(a1[0], a1[1]); w.w = cvt_pk_bf16(a1[2], a1[3]);
                *(u32x4*)rowp = w;
                w.x = cvt_pk_bf16(b0[0], b0[1]); w.y = cvt_pk_bf16(b0[2], b0[3]); w.z = cvt_pk_bf16(b1[0], b1[1]); w.w = cvt_pk_bf16(b1[2], b1[3]);
                *(u32x4*)(rowp + HALF) = w;
            }
    }
};
struct EpiResid {
    static constexpr bool PERM = false, AFTER_DRAIN = false;
    const float* base; float* out; int ldc;
    __device__ __forceinline__ void operator()(const f32x4 (&acc)[2][2][4][2], const Unit& u, int wr, int wc, int fr, int fq) const {
        const int row0 = u.pm * BM + wr * 64 + fr, col0 = u.pn * BM + wc * 32 + 4 * fq;
#pragma unroll
        for (int ai = 0; ai < 2; ++ai)
#pragma unroll
            for (int m = 0; m < 4; ++m) { const size_t off = (size_t)(row0 + ai * HALF + m * 16) * ldc + col0;
#pragma unroll
                for (int bj = 0; bj < 2; ++bj)
#pragma unroll
                    for (int n = 0; n < 2; ++n) { const f32x4 bs = *(const f32x4*)(base + off + bj * HALF + n * 16); *(f32x4*)(out + off + bj * HALF + n * 16) = bs + acc[ai][bj][m][n]; } }
    }
};
template <class Epi, class Sched, bool ALIGN_EPI = false, bool SP2 = false>
__device__ __forceinline__ void gemm_phase(PG8_LAS unsigned char* lds, const Gemm g, const Sched& S, const Epi& E) {
    const int tid = threadIdx.x, wid = __builtin_amdgcn_readfirstlane(tid >> 6), lane = tid & 63, wr = wid >> 2, wc = wid & 3, fr = lane & 15, fq = lane >> 4;
    const int K = g.K, nt = K / BK;
    unsigned voffA[2], voffB[2];
#pragma unroll
    for (int i = 0; i < 2; ++i) { int R, C; stage_rc(tid * 16 + i * 8192, R, C); const int Rb = Epi::PERM ? ((R & ~31) + perm32(R & 31)) : R;
        voffA[i] = (unsigned)(R * K + C) * 2u; voffB[i] = (unsigned)(Rb * K + C) * 2u; }
    const size_t kstep = (size_t)(BK * 2);
    const size_t hstep = (size_t)HALF * K * 2;
    const size_t tstep = 2 * hstep;
    const unsigned ldsw = (unsigned)wid * 1024u;
    const int aoff = lds_byte(wr * 64 + fr, fq * 8), boff = lds_byte(wc * 32 + fr, fq * 8);
#define PG8_SA(b, h) (((b) * 2 + (h)) * HTB)
#define PG8_SB(b, h) ((4 + (b) * 2 + (h)) * HTB)
#define PG8_STAGE(bufoff, gbase, voff) do { _Pragma("unroll") for (int _i = 0; _i < 2; ++_i) \
        __builtin_amdgcn_global_load_lds((const unsigned*)((const char*)(gbase) + (voff)[_i]), (PG8_LAS unsigned*)(lds + (bufoff) + ldsw + _i * 8192), 16, 0, 0); } while (0)
#define PG8_LDA(dst, b, h) do { _Pragma("unroll") for (int m = 0; m < 4; ++m) _Pragma("unroll") for (int k = 0; k < 2; ++k) dst[m][k] = *(const PG8_LAS bf16x8*)(lds + PG8_SA(b, h) + aoff + m * 2048 + k * 1024); } while (0)
#define PG8_LDB(dst, b, h) do { _Pragma("unroll") for (int n = 0; n < 2; ++n) _Pragma("unroll") for (int k = 0; k < 2; ++k) dst[n][k] = *(const PG8_LAS bf16x8*)(lds + PG8_SB(b, h) + boff + n * 2048 + k * 1024); } while (0)
#define PG8_MMA(ai, bj, At, Bt) do { __builtin_amdgcn_s_setprio(1); _Pragma("unroll") for (int m = 0; m < 4; ++m) _Pragma("unroll") for (int n = 0; n < 2; ++n) _Pragma("unroll") for (int k = 0; k < 2; ++k) \
        acc[ai][bj][m][n] = __builtin_amdgcn_mfma_f32_16x16x32_bf16(Bt[n][k], At[m][k], acc[ai][bj][m][n], 0, 0, 0); __builtin_amdgcn_s_setprio(0); } while (0)
#define PG8_WAIT_V(n) asm volatile("s_waitcnt vmcnt(" #n ")" ::: "memory")
#define PG8_WAIT_L(n) asm volatile("s_waitcnt lgkmcnt(" #n ")" ::: "memory")
#define PG8_BAR __builtin_amdgcn_s_barrier()
#define PG8_SCHED __builtin_amdgcn_sched_barrier(0)
    Unit cur, nxt; int ui = 0;
    if (!S.next(0, cur)) return;
    f32x4 acc[2][2][4][2];
#pragma unroll
    for (int a = 0; a < 2; ++a)
#pragma unroll
        for (int b = 0; b < 2; ++b)
#pragma unroll
            for (int m = 0; m < 4; ++m)
#pragma unroll
                for (int n = 0; n < 2; ++n) acc[a][b][m][n] = (f32x4){0.f, 0.f, 0.f, 0.f};
    bf16x8 At[4][2], B0[2][2], B1[2][2];
    const char* cA = (const char*)g.A + (size_t)cur.pm * tstep; const char* cB = (const char*)g.Bt + (size_t)cur.pn * tstep;
    S.a_ready(cur);
    if constexpr (SP2) {
        PG8_STAGE(PG8_SB(0, 0), cB, voffB); PG8_STAGE(PG8_SB(0, 1), cB + hstep, voffB); PG8_STAGE(PG8_SA(0, 0), cA, voffA); PG8_STAGE(PG8_SA(0, 1), cA + hstep, voffA);
        if (wr == 1) PG8_BAR;
        PG8_WAIT_V(2); PG8_BAR;
        PG8_STAGE(PG8_SB(1, 0), cB + kstep, voffB); PG8_STAGE(PG8_SA(1, 0), cA + kstep, voffA); PG8_STAGE(PG8_SB(1, 1), cB + hstep + kstep, voffB);
        PG8_WAIT_V(6); PG8_BAR;
    } else {
        PG8_STAGE(PG8_SB(0, 0), cB, voffB); PG8_STAGE(PG8_SA(0, 0), cA, voffA); PG8_STAGE(PG8_SB(0, 1), cB + hstep, voffB); PG8_STAGE(PG8_SA(0, 1), cA + hstep, voffA);
        if (wr == 1) PG8_BAR;
        PG8_WAIT_V(4); PG8_BAR;
        PG8_STAGE(PG8_SB(1, 0), cB + kstep, voffB); PG8_STAGE(PG8_SA(1, 0), cA + kstep, voffA); PG8_STAGE(PG8_SB(1, 1), cB + hstep + kstep, voffB);
        PG8_WAIT_V(6); PG8_BAR;
    }
    for (;;) {
        const bool has_next = S.next(ui + 1, nxt);
        const char* nA = has_next ? (const char*)g.A + (size_t)nxt.pm * tstep : cA; const char* nB = has_next ? (const char*)g.Bt + (size_t)nxt.pn * tstep : cB;
        for (int t = 0; t < nt; t += 2) {
            const bool last = (t == nt - 2);
            const char* a1 = cA + (size_t)(t + 1) * kstep;
            const char* a2 = last ? nA : cA + (size_t)(t + 2) * kstep; const char* b2 = last ? nB : cB + (size_t)(t + 2) * kstep;
            const char* a3 = a2 + kstep; const char* b3 = b2 + kstep;
            if (last && has_next) S.a_ready(nxt);
            if constexpr (SP2) {
            PG8_LDB(B0, 0, 0); PG8_LDB(B1, 0, 1); PG8_SCHED; PG8_LDA(At, 0, 0); PG8_STAGE(PG8_SA(1, 1), a1 + hstep, voffA);
            PG8_WAIT_V(8); PG8_WAIT_L(0); PG8_BAR; PG8_MMA(0, 0, At, B0); PG8_MMA(0, 1, At, B1); PG8_BAR; PG8_SCHED;
            PG8_LDA(At, 0, 1); PG8_STAGE(PG8_SB(0, 0), b2, voffB); PG8_STAGE(PG8_SB(0, 1), b2 + hstep, voffB); PG8_STAGE(PG8_SA(0, 0), a2, voffA);
            PG8_WAIT_V(8); PG8_WAIT_L(0); PG8_BAR; PG8_MMA(1, 0, At, B0); PG8_MMA(1, 1, At, B1); PG8_BAR; PG8_SCHED;
            PG8_LDB(B0, 1, 0); PG8_LDB(B1, 1, 1); PG8_SCHED; PG8_LDA(At, 1, 0); PG8_STAGE(PG8_SA(0, 1), a2 + hstep, voffA);
            PG8_WAIT_V(8); PG8_WAIT_L(0); PG8_BAR; PG8_MMA(0, 0, At, B0); PG8_MMA(0, 1, At, B1); PG8_BAR; PG8_SCHED;
            PG8_LDA(At, 1, 1); PG8_STAGE(PG8_SB(1, 0), b3, voffB); PG8_STAGE(PG8_SB(1, 1), b3 + hstep, voffB); PG8_STAGE(PG8_SA(1, 0), a3, voffA);
            PG8_WAIT_V(8); PG8_WAIT_L(0); PG8_BAR; PG8_MMA(1, 0, At, B0); PG8_MMA(1, 1, At, B1); PG8_BAR; PG8_SCHED;
            } else {
            PG8_LDB(B0, 0, 0); PG8_SCHED; PG8_LDA(At, 0, 0); PG8_STAGE(PG8_SA(1, 1), a1 + hstep, voffA);
            PG8_WAIT_L(8); PG8_BAR; PG8_WAIT_L(0); PG8_MMA(0, 0, At, B0); PG8_BAR; PG8_SCHED;
            PG8_LDB(B1, 0, 1); PG8_STAGE(PG8_SB(0, 0), b2, voffB);
            PG8_BAR; PG8_WAIT_L(0); PG8_MMA(0, 1, At, B1); PG8_BAR;
            PG8_LDA(At, 0, 1); PG8_STAGE(PG8_SA(0, 0), a2, voffA);
            PG8_BAR; PG8_WAIT_L(0); PG8_MMA(1, 0, At, B0); PG8_BAR; PG8_SCHED;
            PG8_STAGE(PG8_SB(0, 1), b2 + hstep, voffB);
            PG8_WAIT_V(6); PG8_BAR; PG8_MMA(1, 1, At, B1); PG8_BAR;
            PG8_LDB(B0, 1, 0); PG8_SCHED; PG8_LDA(At, 1, 0); PG8_STAGE(PG8_SA(0, 1), a2 + hstep, voffA);
            PG8_WAIT_L(8); PG8_BAR; PG8_WAIT_L(0); PG8_MMA(0, 0, At, B0); PG8_BAR; PG8_SCHED;
            PG8_LDB(B1, 1, 1); PG8_STAGE(PG8_SB(1, 0), b3, voffB);
            PG8_BAR; PG8_WAIT_L(0); PG8_MMA(0, 1, At, B1); PG8_BAR;
            PG8_LDA(At, 1, 1); PG8_STAGE(PG8_SA(1, 0), a3, voffA);
            PG8_BAR; PG8_WAIT_L(0); PG8_MMA(1, 0, At, B0); PG8_BAR; PG8_SCHED;
            PG8_STAGE(PG8_SB(1, 1), b3 + hstep, voffB);
            PG8_WAIT_V(6); PG8_BAR; PG8_MMA(1, 1, At, B1); PG8_BAR;
            }
        }
        if constexpr (ALIGN_EPI) { if (wr == 0) PG8_BAR; }
        if constexpr (!Epi::AFTER_DRAIN) { E(acc, cur, wr, wc, fr, fq); S.done(cur); }
        if (!has_next) break;
#pragma unroll
        for (int a = 0; a < 2; ++a)
#pragma unroll
            for (int b = 0; b < 2; ++b)
#pragma unroll
                for (int m = 0; m < 4; ++m)
#pragma unroll
                    for (int n = 0; n < 2; ++n) acc[a][b][m][n] = (f32x4){0.f, 0.f, 0.f, 0.f};
        cur = nxt; cA = nA; cB = nB; ++ui;
        if constexpr (ALIGN_EPI) { if (wr == 1) PG8_BAR; }
    }
    PG8_WAIT_V(0);
    if constexpr (!ALIGN_EPI) { if (wr == 0) PG8_BAR; }
    PG8_BAR;
    if constexpr (Epi::AFTER_DRAIN) { E.fused(acc, cur, wr, wc, fr, fq, lds, wid, lane); S.done(cur); }
#undef PG8_SA
#undef PG8_SB
#undef PG8_STAGE
#undef PG8_LDA
#undef PG8_LDB
#undef PG8_MMA
#undef PG8_WAIT_V
#undef PG8_WAIT_L
#undef PG8_BAR
#undef PG8_SCHED
}
}
#define XB_TMO      128
#define XB_XCNT(j)  (256  + 64 * (j))
#define XB_XSUB(j)  (1280 + 64 * (j))
#define XB_XGEN(j)  (2304 + 64 * (j))
#define XB_TOP      3328
#define XB_TOPGEN   3392
#define XCD_BAR_WORDS 3456
#define XB_SPIN_CAP (1u << 18)

__device__ __forceinline__ unsigned xb_ld(unsigned* p)              { return __hip_atomic_load(p, __ATOMIC_RELAXED, __HIP_MEMORY_SCOPE_AGENT); }
__device__ __forceinline__ unsigned xb_add(unsigned* p, unsigned v) { return __hip_atomic_fetch_add(p, v, __ATOMIC_RELAXED, __HIP_MEMORY_SCOPE_AGENT); }
__device__ __forceinline__ unsigned xb_xcc_id() { return (unsigned)__builtin_amdgcn_s_getreg((3 << 11) | 20) & 0xFu; }
#define XB_SPIN(cond, bar) do { unsigned _sp = 0; while (cond) { __builtin_amdgcn_s_sleep(1); \
    if ((++_sp & 255u) == 0u) { if (xb_ld(&(bar)[XB_TMO])) break; if (_sp > XB_SPIN_CAP) { atomicAdd(&(bar)[XB_TMO], 1u); break; } } } } while (0)

struct XcdBarrier {
    unsigned* bar; unsigned x;
    volatile LAS unsigned* st;
};

__device__ __forceinline__ XcdBarrier xcd_barrier_post(unsigned* bar, volatile LAS unsigned* st) {
    XcdBarrier b; b.bar = bar; b.x = xb_xcc_id(); b.st = st;
    if (threadIdx.x == 0) (void)xb_add(&bar[XB_XCNT(b.x)], 1u);
    return b;
}
__device__ __forceinline__ void xcd_barrier_complete(unsigned* bar, unsigned x, unsigned& nloc, unsigned& nx) {
    const unsigned G = gridDim.x * gridDim.y * gridDim.z;
    unsigned sum, cnt, mine, sp = 0u;
    for (;;) {
        sum = 0u; cnt = 0u; mine = 0u;
#pragma unroll
        for (unsigned j = 0; j < 16; ++j) { const unsigned c = xb_ld(&bar[XB_XCNT(j)]); sum += c; cnt += (c > 0u) ? 1u : 0u; mine = (j == x) ? c : mine; }
        if (sum == G) break;
        __builtin_amdgcn_s_sleep(1);
        if ((++sp & 255u) == 0u) { if (xb_ld(&bar[XB_TMO])) break; if (sp > XB_SPIN_CAP) { atomicAdd(&bar[XB_TMO], 1u); break; } }
    }
    nloc = mine > 0u ? mine : 1u; nx = cnt > 0u ? cnt : 1u;
}

__device__ __forceinline__ void xcd_barrier(const XcdBarrier& b) {
    asm volatile("s_waitcnt vmcnt(0)" ::: "memory");
    __syncthreads();
    if (threadIdx.x == 0) {
        unsigned* bar = b.bar;
        __builtin_amdgcn_s_waitcnt(0);
        unsigned nloc = b.st[0], nx = b.st[1];
        if (nloc == 0u) { xcd_barrier_complete(bar, b.x, nloc, nx); b.st[0] = nloc; b.st[1] = nx; }
        const unsigned old = xb_add(&bar[XB_XSUB(b.x)], 1u);
        const unsigned gen = old / nloc;
        if (old + 1u == (gen + 1u) * nloc) {
            __builtin_amdgcn_fence(__ATOMIC_RELEASE, "agent");
            asm volatile("s_waitcnt vmcnt(0)" ::: "memory");
            const unsigned og = xb_add(&bar[XB_TOP], 1u);
            const unsigned tg = og / nx;
            if (og + 1u == (tg + 1u) * nx) xb_add(&bar[XB_TOPGEN], 1u);
            else XB_SPIN(xb_ld(&bar[XB_TOPGEN]) == tg, bar);
            __builtin_amdgcn_fence(__ATOMIC_ACQUIRE, "agent");
            xb_add(&bar[XB_XGEN(b.x)], 1u);
            asm volatile("s_waitcnt vmcnt(0)" ::: "memory");
        } else {
            XB_SPIN(xb_ld(&bar[XB_XGEN(b.x)]) == gen, bar);
            __builtin_amdgcn_fence(__ATOMIC_ACQUIRE, "agent");
            asm volatile("s_waitcnt vmcnt(0)" ::: "memory");
        }
    }
    __syncthreads();
}


__device__ __forceinline__ void p0_transpose_item(const float* W, int K, int N, bf16* WT, LAS float* scr, int item, int lane) {
    const int nblk = N / 32, kb = item / nblk, nb = item % nblk, k0 = 64 * kb, n0 = 32 * nb;
#pragma unroll 8
    for (int i = 0; i < 32; ++i) { const int kk = 2 * i + (lane >> 5); scr[kk * 33 + (lane & 31)] = W[(size_t)(k0 + kk) * N + n0 + (lane & 31)]; }
    LDS_WAIT(); asm volatile("" ::: "memory");
    const int c = lane & 7;
#pragma unroll
    for (int j = 0; j < 4; ++j) { const int n = (lane >> 3) + 8 * j; const LAS float* s = scr + (8 * c) * 33 + n;
        v4u o; o.x = pk2(s[0 * 33], s[1 * 33]); o.y = pk2(s[2 * 33], s[3 * 33]); o.z = pk2(s[4 * 33], s[5 * 33]); o.w = pk2(s[6 * 33], s[7 * 33]);
        *(v4u*)(WT + (size_t)(n0 + n) * K + k0 + 8 * c) = o; }
    LDS_WAIT(); asm volatile("" ::: "memory");
}
__device__ __forceinline__ void rms_row_to_bf16(const float* xrow, const float* g, bf16* orow, int lane) {
    const f32x4* xr = (const f32x4*)xrow + lane; f32x4 v[16]; float ss = 0.f;
#pragma unroll
    for (int j = 0; j < 16; ++j) { v[j] = xr[64 * j]; ss += (v[j].x * v[j].x + v[j].y * v[j].y) + (v[j].z * v[j].z + v[j].w * v[j].w); }
    const float rs = rsqrtf(wave_sum(ss) * (1.f / D) + EPS);
    const f32x4* gr = (const f32x4*)g + lane; v2u* o8 = (v2u*)orow + lane;
#pragma unroll
    for (int j = 0; j < 16; ++j) { const f32x4 gg = gr[64 * j]; v2u o; o.x = pk2(v[j].x * rs * gg.x, v[j].y * rs * gg.y); o.y = pk2(v[j].z * rs * gg.z, v[j].w * rs * gg.w); o8[64 * j] = o; }
}
__device__ __forceinline__ int block_excl_scan(int v, LAS int* sc, int tid, int& tot) {
    const int lane = tid & 63, w = tid >> 6; int x = v;
#pragma unroll
    for (int o = 1; o < 64; o <<= 1) { const int y = __shfl_up(x, o); if (lane >= o) x += y; }
    __syncthreads();
    if (lane == 63) sc[w] = x;
    __syncthreads();
    int base = 0, t = 0;
#pragma unroll
    for (int i = 0; i < 8; ++i) { const int s = sc[i]; if (i < w) base += s; t += s; }
    tot = t; return base + x - v;
}
__device__ __forceinline__ int build_list(const int* eid, int e, LAS int* list, LAS int* sc, int tid, int& off) {
    const int4* p = (const int4*)(eid + 32 * tid); unsigned mask = 0u; int cm = 0, cl = 0;
#pragma unroll
    for (int i = 0; i < 8; ++i) { const int4 v = p[i];
        if (v.x == e) { mask |= 1u << (4 * i); ++cm; } if (v.y == e) { mask |= 2u << (4 * i); ++cm; } if (v.z == e) { mask |= 4u << (4 * i); ++cm; } if (v.w == e) { mask |= 8u << (4 * i); ++cm; }
        cl += (v.x < e) + (v.y < e) + (v.z < e) + (v.w < e); }
    int tot; int pos = block_excl_scan(cm, sc, tid, tot);
    int tl; (void)block_excl_scan(cl, sc + 8, tid, tl); off = tl;
    while (mask) { const int b = __builtin_ctz(mask); mask &= mask - 1u; list[pos++] = 32 * tid + b; }
    __syncthreads();
    return tot;
}

struct Args { const void* in[25]; float* out; unsigned char* ws; };
__global__ void __launch_bounds__(NWAVES * 64, 2) mk_fwd(Args a) {
    extern __shared__ __attribute__((aligned(16))) unsigned char lds_raw[];
    LAS unsigned char* lds = (LAS unsigned char*)lds_raw;
    const int tid = threadIdx.x, lane = tid & 63, wave = __builtin_amdgcn_readfirstlane(tid >> 6);
    const int G = gridDim.x, bid = blockIdx.x;
    unsigned char* ws = a.ws;
    gu32* ctl = (gu32*)(ws + WS_CTL);
    const float* x = (const float*)a.in[0]; const float* mem = (const float*)a.in[1]; const int* pos = (const int*)a.in[2];
    const float* g_mix = (const float*)a.in[3]; const float* w_in = (const float*)a.in[4]; const float* ret_g = (const float*)a.in[5];
    const float* ln_g = (const float*)a.in[6]; const float* ln_b = (const float*)a.in[7]; const float* gm_ws = (const float*)a.in[8]; const float* gm_bs = (const float*)a.in[9];
    const float* w_out = (const float*)a.in[10]; const float* g_xa = (const float*)a.in[11]; const float* g_mem = (const float*)a.in[12];
    const float* wq = (const float*)a.in[13]; const float* wkv = (const float*)a.in[14]; const float* wo = (const float*)a.in[15];
    const float* g_moe = (const float*)a.in[16]; const float* rgw = (const float*)a.in[17]; const float* rgb = (const float*)a.in[18];
    const float* rew = (const float*)a.in[19]; const float* reb = (const float*)a.in[20];
    const float* wg = (const float*)a.in[21]; const float* wu = (const float*)a.in[22]; const float* wd = (const float*)a.in[23]; const float* g_fin = (const float*)a.in[24];
    float* out = a.out;
    float* WrT = (float*)(ws + WS_WRT);
    bf16* WtIn = (bf16*)(ws + WS_WIN); bf16* WtOut = (bf16*)(ws + WS_WOUT); bf16* WtQ = (bf16*)(ws + WS_WQ); bf16* WtKV = (bf16*)(ws + WS_WKV); bf16* WtO = (bf16*)(ws + WS_WO);
    bf16* XN = (bf16*)(ws + WS_XN); bf16* MN = (bf16*)(ws + WS_MN); float* COS = (float*)(ws + WS_COS); float* SIN = (float*)(ws + WS_SIN);
    bf16* PROJ = (bf16*)(ws + WS_PROJ); bf16* RET = (bf16*)(ws + WS_RET); bf16* MIX = (bf16*)(ws + WS_MIX); float* H = (float*)(ws + WS_H);
    bf16* QX = (bf16*)(ws + WS_QX); bf16* KX = (bf16*)(ws + WS_KVX); bf16* VT = KX + (size_t)NMEM * XW; bf16* OX = (bf16*)(ws + WS_OX);
    int* EID = (int*)(ws + WS_EID); float* GATE = (float*)(ws + WS_EID + 65536);
    bf16* HACT = (bf16*)(ws + WS_HACT); bf16* Y = (bf16*)(ws + WS_Y);

    for (int u = tid; u < (LDS_BYTES - LDSCTL_OFF) / 4; u += NT) ((LAS unsigned*)(lds + LDSCTL_OFF))[u] = 0u;
    __syncthreads();
    volatile LAS unsigned* MISC = (volatile LAS unsigned*)(lds + MISC_OFF);
    XcdBarrier bar = xcd_barrier_post((unsigned*)(ws + WS_CTL) + CW_BAR, MISC + 8);
    const int gw = bid * NWAVES + wave, NGW = G * NWAVES, gtid = bid * NT + tid, NGT = G * NT;

#ifndef SK_P0
    {
        LAS float* scr = (LAS float*)(lds + RING_OFF + wave * 16384);
        constexpr int I_IN = (D / 64) * (INC / 32), I_OUT = (D / 64) * (D / 32), I_Q = (D / 64) * (XW / 32), I_KV = (D / 64) * (2 * XW / 32), I_O = (XW / 64) * (D / 32);
        constexpr int NITEMS = I_IN + I_OUT + I_Q + I_KV + I_O;
        for (int it = gw; it < NITEMS; it += NGW) {
            int r = it;
            if (r < I_IN) { p0_transpose_item(w_in, D, INC, WtIn, scr, r, lane); continue; } r -= I_IN;
            if (r < I_OUT) { p0_transpose_item(w_out, D, D, WtOut, scr, r, lane); continue; } r -= I_OUT;
            if (r < I_Q) { p0_transpose_item(wq, D, XW, WtQ, scr, r, lane); continue; } r -= I_Q;
            if (r < I_KV) { p0_transpose_item(wkv, D, 2 * XW, WtKV, scr, r, lane); continue; } r -= I_KV;
            p0_transpose_item(wo, XW, D, WtO, scr, r, lane);
        }
        for (int i = gtid; i < 72 * D; i += NGT) { const int j = i >> 12, k = i & (D - 1); WrT[i] = j < 8 ? rgw[(size_t)k * 8 + j] : rew[(size_t)k * 64 + (j - 8)]; }
        for (int m = gw; m < NTOK; m += NGW) rms_row_to_bf16(x + (size_t)m * D, g_mix, XN + (size_t)m * D, lane);
        for (int m = gw; m < NMEM; m += NGW) rms_row_to_bf16(mem + (size_t)m * D, g_mem, MN + (size_t)m * D, lane);
        for (int i = gtid; i < NTOK * 128; i += NGT) { const int j = i & 127, row = i >> 7; const float inv = powf(10000.0f, -(float)(2 * j) / 256.0f); const float ang = (float)pos[row] * inv; COS[i] = cosf(ang); SIN[i] = sinf(ang); }
    }
    xcd_barrier(bar);

#endif
#ifndef SK_P1
    {   pg8::Gemm g{XN, WtIn, NTOK, INC, D}; pg8::StaticOrder S; S.init(NTOK, INC, G, bid);
        pg8::EpiProj E{PROJ, COS, SIN};
        pg8::gemm_phase<pg8::EpiProj, pg8::StaticOrder, PG8_ALIGN, PG8_SP2>(lds + RING_OFF, g, S, E); }
    xcd_barrier(bar);

#endif
#ifndef SK_P2
    for (int vb = bid; vb < NB * RH * 8; vb += G) {
        const int es = vb & 7, h = (vb >> 3) & 7, b = vb >> 6, dg = tid & 15, el = tid >> 4, e = es * 32 + el;
        const float gamma = 1.0f - exp2f(-5.0f - (float)h);
        float st[16];
#pragma unroll
        for (int i = 0; i < 16; ++i) st[i] = 0.f;
        for (int t = 0; t < SEQ; ++t) {
            const size_t row = (size_t)b * SEQ + t; const bf16* pr = PROJ + row * INC + h * RDH;
            const v4u qa = *(const v4u*)(pr + dg * 16), qb = *(const v4u*)(pr + dg * 16 + 8), ka = *(const v4u*)(pr + RW + dg * 16), kb = *(const v4u*)(pr + RW + dg * 16 + 8);
            const float vv = bf2f(pr[2 * RW + e]); float part = 0.f;
#define RSTEP(i, qw, kw) { st[2 * (i)] = gamma * st[2 * (i)] + bflo(kw) * vv; part += bflo(qw) * st[2 * (i)]; st[2 * (i) + 1] = gamma * st[2 * (i) + 1] + bfhi(kw) * vv; part += bfhi(qw) * st[2 * (i) + 1]; }
            RSTEP(0, qa.x, ka.x) RSTEP(1, qa.y, ka.y) RSTEP(2, qa.z, ka.z) RSTEP(3, qa.w, ka.w) RSTEP(4, qb.x, kb.x) RSTEP(5, qb.y, kb.y) RSTEP(6, qb.z, kb.z) RSTEP(7, qb.w, kb.w)
#undef RSTEP
            part += __shfl_xor(part, 1); part += __shfl_xor(part, 2); part += __shfl_xor(part, 4); part += __shfl_xor(part, 8);
            if (dg == 0) RET[row * RW + h * RDH + e] = (bf16)f2bf(part);
        }
    }
    xcd_barrier(bar);

#endif
#ifndef SK_P3
    for (int it = gw; it < NTOK * RH; it += NGW) {
        const int h = it & 7; const size_t row = it >> 3;
        const v2u rv = *(const v2u*)(RET + row * RW + h * RDH + lane * 4);
        float v0 = bflo(rv.x), v1 = bfhi(rv.x), v2 = bflo(rv.y), v3 = bfhi(rv.y);
        const float mu = wave_sum((v0 + v1) + (v2 + v3)) * (1.f / 256.f);
        v0 -= mu; v1 -= mu; v2 -= mu; v3 -= mu;
        const float rs = rsqrtf(wave_sum((v0 * v0 + v1 * v1) + (v2 * v2 + v3 * v3)) * (1.f / 256.f) + EPS);
        const int c = h * RDH + lane * 4; const f32x4 rg = *(const f32x4*)(ret_g + c);
        const v2u gv = *(const v2u*)(PROJ + row * INC + 3 * RW + c);
        v2u o; o.x = pk2(bflo(gv.x) * (v0 * rs * rg.x), bfhi(gv.x) * (v1 * rs * rg.y)); o.y = pk2(bflo(gv.y) * (v2 * rs * rg.z), bfhi(gv.y) * (v3 * rs * rg.w));
        *(v2u*)(MIX + row * D + c) = o;
    }
    for (int un = bid; un < NB * (SEQ / CHK) * GG; un += G) {
        const int g = un & 7, n = (un >> 3) & 15, b = un >> 7; const size_t row0 = (size_t)b * SEQ + n * CHK;
        LAS bf16* vt = (LAS bf16*)(lds + RING_OFF);
        LAS float* stat = (LAS float*)(lds + AUX_OFF);
        __syncthreads();
        for (int rr = 0; rr < 16; ++rr) { const int r = wave * 16 + rr; const bf16* p = PROJ + (row0 + r) * INC + 5 * RW + lane * 8;
            float xv[32]; float s = 0.f;
#pragma unroll
            for (int i = 0; i < 4; ++i) { const v4u w = *(const v4u*)(p + 512 * i); xv[8 * i + 0] = bflo(w.x); xv[8 * i + 1] = bfhi(w.x); xv[8 * i + 2] = bflo(w.y); xv[8 * i + 3] = bfhi(w.y); xv[8 * i + 4] = bflo(w.z); xv[8 * i + 5] = bfhi(w.z); xv[8 * i + 6] = bflo(w.w); xv[8 * i + 7] = bfhi(w.w); }
#pragma unroll
            for (int i = 0; i < 32; ++i) s += xv[i];
            const float mu = wave_sum(s) * (1.f / GMW); float q = 0.f;
#pragma unroll
            for (int i = 0; i < 32; ++i) { const float d = xv[i] - mu; q += d * d; }
            const float rs = rsqrtf(wave_sum(q) * (1.f / GMW) + EPS);
            if (lane == 0) { stat[r] = mu; stat[128 + r] = rs; } }
        __syncthreads();
        { const int c = tid & 255, half = tid >> 8; const float lg = ln_g[g * GCG + c], lb = ln_b[g * GCG + c];
          for (int s = half; s < CHK; s += 2) { const float xv = bf2f(PROJ[(row0 + s) * INC + 5 * RW + g * GCG + c]); vt[s * 256 + c] = (bf16)f2bf((xv - stat[s]) * stat[128 + s] * lg + lb); } }
        __syncthreads();
        { const int c = tid & 255, half = tid >> 8;
          for (int i = 0; i < 64; ++i) { const int t = 2 * i + half; const float* w = gm_ws + ((size_t)g * CHK + t) * CHK; float acc = 0.f;
              for (int s = 0; s <= t; ++s) acc += w[s] * bf2f(vt[s * 256 + c]);
              const float uu = bf2f(PROJ[(row0 + t) * INC + 4 * RW + g * GCG + c]);
              MIX[(row0 + t) * D + RW + g * GCG + c] = (bf16)f2bf(uu * (acc + gm_bs[g * CHK + t])); } }
    }
    xcd_barrier(bar);

#endif
#ifndef SK_P4
    {   pg8::Gemm g{MIX, WtOut, NTOK, D, D}; pg8::StaticOrder S; S.init(NTOK, D, G, bid);
        pg8::EpiResid E{x, H, D};
        pg8::gemm_phase<pg8::EpiResid, pg8::StaticOrder, PG8_ALIGN, PG8_SP2>(lds + RING_OFF, g, S, E); }
    xcd_barrier(bar);
#endif
#ifndef SK_P4b
    for (int m = gw; m < NTOK; m += NGW) rms_row_to_bf16(H + (size_t)m * D, g_xa, XN + (size_t)m * D, lane);
    xcd_barrier(bar);
#endif
#ifndef SK_P5
    {   pg8::Gemm g{XN, WtQ, NTOK, XW, D}; pg8::StaticOrder S; S.init(NTOK, XW, G, bid);
        pg8::EpiBf16<0> E{QX, XW, nullptr, 0, 0, 1.f};
        pg8::gemm_phase<pg8::EpiBf16<0>, pg8::StaticOrder, PG8_ALIGN, PG8_SP2>(lds + RING_OFF, g, S, E); }
    {   pg8::Gemm g{MN, WtKV, NMEM, XW, D}; pg8::StaticOrder S; S.init(NMEM, XW, G, (bid + G - 128) % G);
        pg8::EpiBf16<0> E{KX, XW, nullptr, 0, 0, 1.f};
        pg8::gemm_phase<pg8::EpiBf16<0>, pg8::StaticOrder, PG8_ALIGN, PG8_SP2>(lds + RING_OFF, g, S, E); }
    {   pg8::Gemm g{WtKV + (size_t)XW * D, MN, XW, NMEM, D}; pg8::StaticOrder S; S.init(XW, NMEM, G, (bid + G - 144) % G);
        pg8::EpiBf16<0> E{VT, NMEM, nullptr, 0, 0, 1.f};
        pg8::gemm_phase<pg8::EpiBf16<0>, pg8::StaticOrder, PG8_ALIGN, PG8_SP2>(lds + RING_OFF, g, S, E); }
    xcd_barrier(bar);
#endif
#ifndef SK_P6
    {   LAS float* pq = (LAS float*)(lds + RING_OFF + wave * 2048);
        for (int it = gw; it < NTOK * XH; it += NGW) {
            const int h = it & 3; const size_t row = it >> 2; const int b = (int)(row / SEQ);
            { const v2u qv = *(const v2u*)(QX + row * XW + h * XDH + lane * 4); pq[lane * 4 + 0] = bflo(qv.x); pq[lane * 4 + 1] = bfhi(qv.x); pq[lane * 4 + 2] = bflo(qv.y); pq[lane * 4 + 3] = bfhi(qv.y); }
            LDS_WAIT(); asm volatile("" ::: "memory");
            float sc[4];
#pragma unroll
            for (int mi = 0; mi < 4; ++mi) { const int m = lane + 64 * mi; const bf16* kr = KX + ((size_t)b * MEML + m) * XW + h * XDH; float acc = 0.f;
                for (int d8 = 0; d8 < 32; ++d8) { const v4u kw = *(const v4u*)(kr + d8 * 8); const LAS float* qq = pq + d8 * 8;
                    acc += qq[0] * bflo(kw.x) + qq[1] * bfhi(kw.x) + qq[2] * bflo(kw.y) + qq[3] * bfhi(kw.y) + qq[4] * bflo(kw.z) + qq[5] * bfhi(kw.z) + qq[6] * bflo(kw.w) + qq[7] * bfhi(kw.w); }
                sc[mi] = acc * 0.0625f; }
            float mx = fmaxf(fmaxf(sc[0], sc[1]), fmaxf(sc[2], sc[3]));
#pragma unroll
            for (int o = 1; o < 64; o <<= 1) mx = fmaxf(mx, __shfl_xor(mx, o));
            float ex[4], es = 0.f;
#pragma unroll
            for (int mi = 0; mi < 4; ++mi) { ex[mi] = __expf(sc[mi] - mx); es += ex[mi]; }
            const float inv = 1.0f / wave_sum(es);
#pragma unroll
            for (int mi = 0; mi < 4; ++mi) pq[256 + lane + 64 * mi] = ex[mi] * inv;
            LDS_WAIT(); asm volatile("" ::: "memory");
            float od[4];
#pragma unroll
            for (int di = 0; di < 4; ++di) { const int d = lane * 4 + di; const bf16* vr = VT + ((size_t)h * XDH + d) * NMEM + b * MEML; float acc = 0.f;
                for (int m8 = 0; m8 < 32; ++m8) { const v4u vw = *(const v4u*)(vr + m8 * 8); const LAS float* pp = pq + 256 + m8 * 8;
                    acc += pp[0] * bflo(vw.x) + pp[1] * bfhi(vw.x) + pp[2] * bflo(vw.y) + pp[3] * bfhi(vw.y) + pp[4] * bflo(vw.z) + pp[5] * bfhi(vw.z) + pp[6] * bflo(vw.w) + pp[7] * bfhi(vw.w); }
                od[di] = acc; }
            v2u o; o.x = pk2(od[0], od[1]); o.y = pk2(od[2], od[3]); *(v2u*)(OX + row * XW + h * XDH + lane * 4) = o;
            LDS_WAIT(); asm volatile("" ::: "memory");
        }
    }
    xcd_barrier(bar);
#endif
#ifndef SK_P7
    {   pg8::Gemm g{OX, WtO, NTOK, D, XW}; pg8::StaticOrder S; S.init(NTOK, D, G, bid);
        pg8::EpiResid E{H, H, D};
        pg8::gemm_phase<pg8::EpiResid, pg8::StaticOrder, PG8_ALIGN, PG8_SP2>(lds + RING_OFF, g, S, E); }
    xcd_barrier(bar);
#endif
#ifndef SK_P7b
    for (int m = gw; m < NTOK; m += NGW) {
        const f32x4* xr = (const f32x4*)(H + (size_t)m * D) + lane; f32x4 v[16]; float ss = 0.f;
#pragma unroll
        for (int j = 0; j < 16; ++j) { v[j] = xr[64 * j]; ss += (v[j].x * v[j].x + v[j].y * v[j].y) + (v[j].z * v[j].z + v[j].w * v[j].w); }
        const float rs = rsqrtf(wave_sum(ss) * (1.f / D) + EPS);
        const f32x4* gr = (const f32x4*)g_moe + lane; v2u* o8 = (v2u*)(XN + (size_t)m * D) + lane;
#pragma unroll
        for (int j = 0; j < 16; ++j) { const f32x4 gg = gr[64 * j]; v[j] = v[j] * rs * gg; v2u o; o.x = pk2(v[j].x, v[j].y); o.y = pk2(v[j].z, v[j].w); o8[64 * j] = o; }
        int gi = 0; float gm = -3.0e38f, den = 0.f;
#pragma unroll 1
        for (int j = 0; j < 8; ++j) { const f32x4* wr_ = (const f32x4*)(WrT + (size_t)j * D) + lane; float acc = 0.f;
#pragma unroll
            for (int q = 0; q < 16; ++q) { const f32x4 w = wr_[64 * q]; acc += (v[q].x * w.x + v[q].y * w.y) + (v[q].z * w.z + v[q].w * w.w); }
            const float l = wave_sum(acc) + rgb[j];
            if (l > gm) { den = den * __expf(gm - l) + 1.0f; gm = l; gi = j; } else den += __expf(l - gm); }
        const float ggate = 1.0f / den;
        int i0 = 0, i1 = 0; float v0 = -3.0e38f, v1 = -3.0e38f;
#pragma unroll 1
        for (int p = 0; p < 8; ++p) { const f32x4* wr_ = (const f32x4*)(WrT + (size_t)(8 + gi * 8 + p) * D) + lane; float acc = 0.f;
#pragma unroll
            for (int q = 0; q < 16; ++q) { const f32x4 w = wr_[64 * q]; acc += (v[q].x * w.x + v[q].y * w.y) + (v[q].z * w.z + v[q].w * w.w); }
            const float l = wave_sum(acc) + reb[gi * 8 + p];
            if (l > v0) { v1 = v0; i1 = i0; v0 = l; i0 = p; } else if (l > v1) { v1 = l; i1 = p; } }
        const float e1 = __expf(v1 - v0), g0 = 1.0f / (1.0f + e1), g1 = e1 / (1.0f + e1);
        if (lane == 0) { EID[2 * m] = gi * 8 + i0; EID[2 * m + 1] = gi * 8 + i1; GATE[2 * m] = g0 * ggate; GATE[2 * m + 1] = g1 * ggate; }
    }
    xcd_barrier(bar);
#endif
#ifndef SK_P9
    {   LAS int* list = (LAS int*)(lds + RING_OFF); LAS int* sc = (LAS int*)(lds + AUX_OFF);
        LAS float* As = (LAS float*)(lds + RING_OFF + 32768); LAS float* Bg = As + 16 * 132; LAS float* Bu = Bg + 16 * 68;
        const int tx = tid & 15, ty = tid >> 4;
        for (int un = bid; un < NE * 8; un += G) {
            const int e = un >> 3, ct = un & 7; int off; __syncthreads();
            const int cnt = build_list(EID, e, list, sc, tid, off);
            const float* Wg = wg + (size_t)e * D * FF + ct * 64; const float* Wu = wu + (size_t)e * D * FF + ct * 64;
            for (int row0 = 0; row0 < cnt; row0 += 128) {
                float ag[4][4], au[4][4];
#pragma unroll
                for (int i = 0; i < 4; ++i)
#pragma unroll
                    for (int j = 0; j < 4; ++j) { ag[i][j] = 0.f; au[i][j] = 0.f; }
                for (int k0 = 0; k0 < D; k0 += 16) {
                    __syncthreads();
#pragma unroll
                    for (int i = 0; i < 4; ++i) { const int el_ = tid + i * NT, r = el_ >> 4, kk = el_ & 15, gr = row0 + r; float v = 0.f;
                        if (gr < cnt) v = bf2f(XN[(size_t)(list[gr] >> 1) * D + k0 + kk]);
                        As[kk * 132 + r] = v; }
#pragma unroll
                    for (int i = 0; i < 2; ++i) { const int el_ = tid + i * NT, kk = el_ >> 6, n = el_ & 63; Bg[kk * 68 + n] = Wg[(size_t)(k0 + kk) * FF + n]; Bu[kk * 68 + n] = Wu[(size_t)(k0 + kk) * FF + n]; }
                    __syncthreads();
#pragma unroll 2
                    for (int kk = 0; kk < 16; ++kk) { float av[4], bg[4], bu[4];
#pragma unroll
                        for (int i = 0; i < 4; ++i) { av[i] = As[kk * 132 + ty * 4 + i]; bg[i] = Bg[kk * 68 + tx * 4 + i]; bu[i] = Bu[kk * 68 + tx * 4 + i]; }
#pragma unroll
                        for (int i = 0; i < 4; ++i)
#pragma unroll
                            for (int j = 0; j < 4; ++j) { ag[i][j] += av[i] * bg[j]; au[i][j] += av[i] * bu[j]; } }
                }
#pragma unroll
                for (int i = 0; i < 4; ++i) { const int gr = row0 + ty * 4 + i;
                    if (gr < cnt) { v2u o; o.x = pk2(silu_f(ag[i][0]) * au[i][0], silu_f(ag[i][1]) * au[i][1]); o.y = pk2(silu_f(ag[i][2]) * au[i][2], silu_f(ag[i][3]) * au[i][3]);
                        *(v2u*)(HACT + (size_t)(off + gr) * FF + ct * 64 + tx * 4) = o; } }
            }
        }
    }
    xcd_barrier(bar);
#endif
#ifndef SK_P10
    {   LAS int* list = (LAS int*)(lds + RING_OFF); LAS int* sc = (LAS int*)(lds + AUX_OFF);
        LAS float* As = (LAS float*)(lds + RING_OFF + 32768); LAS float* Bs = As + 16 * 132;
        const int tx = tid & 15, ty = tid >> 4;
        for (int un = bid; un < NE * 16; un += G) {
            const int e = un >> 4, c4 = un & 15; int off; __syncthreads();
            const int cnt = build_list(EID, e, list, sc, tid, off);
            for (int sub = 0; sub < 4; ++sub) {
                const int col0 = c4 * 256 + sub * 64; const float* Wd = wd + (size_t)e * FF * D + col0;
                for (int row0 = 0; row0 < cnt; row0 += 128) {
                    float acc[4][4];
#pragma unroll
                    for (int i = 0; i < 4; ++i)
#pragma unroll
                        for (int j = 0; j < 4; ++j) acc[i][j] = 0.f;
                    for (int k0 = 0; k0 < FF; k0 += 16) {
                        __syncthreads();
#pragma unroll
                        for (int i = 0; i < 4; ++i) { const int el_ = tid + i * NT, r = el_ >> 4, kk = el_ & 15, gr = row0 + r; float v = 0.f;
                            if (gr < cnt) v = bf2f(HACT[(size_t)(off + gr) * FF + k0 + kk]);
                            As[kk * 132 + r] = v; }
#pragma unroll
                        for (int i = 0; i < 2; ++i) { const int el_ = tid + i * NT, kk = el_ >> 6, n = el_ & 63; Bs[kk * 68 + n] = Wd[(size_t)(k0 + kk) * D + n]; }
                        __syncthreads();
#pragma unroll 2
                        for (int kk = 0; kk < 16; ++kk) { float av[4], bv[4];
#pragma unroll
                            for (int i = 0; i < 4; ++i) { av[i] = As[kk * 132 + ty * 4 + i]; bv[i] = Bs[kk * 68 + tx * 4 + i]; }
#pragma unroll
                            for (int i = 0; i < 4; ++i)
#pragma unroll
                                for (int j = 0; j < 4; ++j) acc[i][j] += av[i] * bv[j]; }
                    }
#pragma unroll
                    for (int i = 0; i < 4; ++i) { const int gr = row0 + ty * 4 + i;
                        if (gr < cnt) { const int slot = list[gr]; const float gt = GATE[slot]; v2u o; o.x = pk2(gt * acc[i][0], gt * acc[i][1]); o.y = pk2(gt * acc[i][2], gt * acc[i][3]);
                            *(v2u*)(Y + (size_t)slot * D + col0 + tx * 4) = o; } }
                }
            }
        }
    }
    xcd_barrier(bar);
#endif
#ifndef SK_P11
    for (int m = gw; m < NTOK; m += NGW) {
        const f32x4* xr = (const f32x4*)(H + (size_t)m * D) + lane; const v2u* y0 = (const v2u*)(Y + (size_t)(2 * m) * D) + lane; const v2u* y1 = (const v2u*)(Y + (size_t)(2 * m + 1) * D) + lane;
        f32x4 v[16]; float ss = 0.f;
#pragma unroll
        for (int j = 0; j < 16; ++j) { const v2u a0 = y0[64 * j], a1 = y1[64 * j]; f32x4 t = xr[64 * j];
            t.x = (t.x + bflo(a0.x)) + bflo(a1.x); t.y = (t.y + bfhi(a0.x)) + bfhi(a1.x); t.z = (t.z + bflo(a0.y)) + bflo(a1.y); t.w = (t.w + bfhi(a0.y)) + bfhi(a1.y);
            v[j] = t; ss += (t.x * t.x + t.y * t.y) + (t.z * t.z + t.w * t.w); }
        const float rs = rsqrtf(wave_sum(ss) * (1.f / D) + EPS);
        const f32x4* gr = (const f32x4*)g_fin + lane; f32x4* orow = (f32x4*)(out + (size_t)m * D) + lane;
#pragma unroll
        for (int j = 0; j < 16; ++j) orow[64 * j] = v[j] * rs * gr[64 * j];
    }
#endif
}

extern "C" void kernel_launch(void* const* d_in, const int* in_sizes, int n_in, void* d_out, int out_size, void* d_ws, size_t ws_size, hipStream_t stream) {
    static int grid = 0;
    if (grid == 0) {
        if (n_in != 25 || out_size != NTOK * D || ws_size < WS_END) { fprintf(stderr, "kernel_launch: unexpected shapes (n_in %d out %d ws %zu)\n", n_in, out_size, ws_size); grid = -1; return; }
        int dev = 0, cus = 0, per_cu = 0;
        if (hipGetDevice(&dev) != hipSuccess || hipDeviceGetAttribute(&cus, hipDeviceAttributeMultiprocessorCount, dev) != hipSuccess) { grid = -1; return; }
        if (hipFuncSetAttribute((const void*)mk_fwd, hipFuncAttributeMaxDynamicSharedMemorySize, LDS_BYTES) != hipSuccess) { fprintf(stderr, "kernel_launch: hipFuncSetAttribute failed\n"); grid = -1; return; }
        if (hipOccupancyMaxActiveBlocksPerMultiprocessor(&per_cu, (const void*)mk_fwd, NWAVES * 64, LDS_BYTES) != hipSuccess || per_cu < 1) { fprintf(stderr, "kernel_launch: occupancy query reports %d blocks per CU\n", per_cu); }
        (void)hipGetLastError();
        grid = cus;
    }
    if (grid < 0) return;
    if (hipMemsetAsync((char*)d_ws + WS_CTL, 0, CTL_ZERO_BYTES, stream) != hipSuccess) return;
    Args a{};
    for (int i = 0; i < 25; ++i) a.in[i] = d_in[i];
    a.out = (float*)d_out; a.ws = (unsigned char*)d_ws;
    hipLaunchKernelGGL(mk_fwd, dim3(grid), dim3(NWAVES * 64), LDS_BYTES, stream, a);
}
```

```cpp
#include <hip/hip_runtime.h>
#include <cstdio>
#include <cstdint>

#ifndef PG8_SP2
#define PG8_SP2 true
#endif
#ifndef PG8_ALIGN
#define PG8_ALIGN true
#endif
constexpr int NWAVES = 8, NT = 512;
constexpr int D = 4096, NB = 4, SEQ = 2048, NTOK = NB * SEQ, MEML = 256, NMEM = NB * MEML;
constexpr int RW = 2048, GMW = 2048, INC = 12288, RH = 8, RDH = 256, GG = 8, GCG = 256, CHK = 128;
constexpr int XH = 4, XDH = 256, XW = 1024;
constexpr int NE = 64, FF = 512, NSLOT = NTOK * 2;
constexpr float EPS = 1e-6f;
constexpr size_t MiB = 1u << 20;
constexpr size_t WS_CTL = 0, CTL_ZERO_BYTES = 1 * MiB;
constexpr size_t WS_WRT = 1 * MiB;
constexpr size_t WS_WIN = 3 * MiB;
constexpr size_t WS_WOUT = 99 * MiB;
constexpr size_t WS_WQ = 131 * MiB;
constexpr size_t WS_WKV = 139 * MiB;
constexpr size_t WS_WO = 155 * MiB;
constexpr size_t WS_XN = 163 * MiB;
constexpr size_t WS_MN = 227 * MiB;
constexpr size_t WS_COS = 235 * MiB, WS_SIN = 239 * MiB;
constexpr size_t WS_PROJ = 243 * MiB;
constexpr size_t WS_RET = 435 * MiB;
constexpr size_t WS_MIX = 467 * MiB;
constexpr size_t WS_H = 531 * MiB;
constexpr size_t WS_QX = 659 * MiB;
constexpr size_t WS_KVX = 675 * MiB;
constexpr size_t WS_OX = 679 * MiB;
constexpr size_t WS_EID = 695 * MiB;
constexpr size_t WS_HACT = 696 * MiB;
constexpr size_t WS_Y = 712 * MiB;
constexpr size_t WS_END = 840 * MiB;
constexpr int CW_TMO = 0, CW_CODE = 1, CW_BAR = 4096;
constexpr int RING_OFF = 0, RING_BYTES = 131072;
constexpr int LDSCTL_OFF = RING_BYTES, MISC_OFF = LDSCTL_OFF + 320;
constexpr int AUX_OFF = LDSCTL_OFF + 1024;
constexpr int LIST_OFF = AUX_OFF, SC_OFF = LIST_OFF + 16384;
constexpr int LDS_BYTES = 163840;

#define GAS __attribute__((address_space(1)))
#define LAS __attribute__((address_space(3)))
typedef unsigned short bf16;
typedef unsigned v4u __attribute__((ext_vector_type(4)));
typedef unsigned v2u __attribute__((ext_vector_type(2)));
typedef float f32x4 __attribute__((ext_vector_type(4)));
typedef short bf16x8 __attribute__((ext_vector_type(8)));
typedef GAS unsigned gu32;
#define RLX_AGENT __ATOMIC_RELAXED, __HIP_MEMORY_SCOPE_AGENT
#define LDS_WAIT() asm volatile("s_waitcnt lgkmcnt(0)" ::: "memory")
#define VM_WAIT() asm volatile("s_waitcnt vmcnt(0)" ::: "memory")
__device__ __forceinline__ unsigned f2bf(float f) { unsigned u = __builtin_bit_cast(unsigned, f); return (u + 0x7fffu + ((u >> 16) & 1u)) >> 16; }
__device__ __forceinline__ unsigned pk2(float lo, float hi) { return f2bf(lo) | (f2bf(hi) << 16); }
__device__ __forceinline__ float bf2f(unsigned b) { return __builtin_bit_cast(float, b << 16); }
__device__ __forceinline__ float bflo(unsigned w) { return __builtin_bit_cast(float, w << 16); }
__device__ __forceinline__ float bfhi(unsigned w) { return __builtin_bit_cast(float, w & 0xffff0000u); }
__device__ __forceinline__ float wave_sum(float v) {
#pragma unroll
    for (int o = 1; o < 64; o <<= 1) v += __shfl_xor(v, o);
    return v;
}
__device__ __forceinline__ float fast_sigmoid(float x) { return __builtin_amdgcn_rcpf(1.0f + __builtin_amdgcn_exp2f(-1.4426950408889634f * x)); }
__device__ __forceinline__ float gelu_tanh_f(float x) { return x * fast_sigmoid(1.5957691216057308f * (x + 0.044715f * x * x * x)); }
__device__ __forceinline__ float silu_f(float x) { return x * fast_sigmoid(x); }
namespace pg8 {
#define PG8_LAS __attribute__((address_space(3)))
typedef unsigned short bf16_t;
typedef short bf16x8 __attribute__((ext_vector_type(8)));
typedef float f32x4 __attribute__((ext_vector_type(4)));
typedef unsigned u32x4 __attribute__((ext_vector_type(4)));
constexpr int BM = 256, BK = 64, HALF = 128, HTB = HALF * BK * 2  , STAGE_BYTES = 8 * HTB, NXCD = 8, WGM = 8;

__host__ __device__ __forceinline__ int lds_byte(int r, int c) { const int st = (r >> 4) * 2 + (c >> 5), rr = r & 15, cc = c & 31, ob = rr * 64 + cc * 2; return st * 1024 + (ob ^ (((ob >> 9) & 1) << 5)); }
__host__ __device__ __forceinline__ void stage_rc(int b, int& R, int& C) { const int st = b / 1024, sb = b % 1024, swz = sb ^ (((sb >> 9) & 1) << 5); R = (st >> 1) * 16 + swz / 64; C = (st & 1) * 32 + (swz % 64) / 2; }
__host__ __device__ __forceinline__ int perm32(int rho) { const int n = rho >> 4, i = rho & 15; return 8 * (i >> 2) + 4 * n + (i & 3); }

struct Unit { int pm, pn; };
struct Gemm { const bf16_t* A; const bf16_t* Bt; int M, N, K; };

struct StaticOrder {
    int nM, nN, nwg, G, c;
    __host__ __device__ void init(int M, int N, int G_, int c_) { nM = M / BM; nN = N / BM; nwg = nM * nN; G = G_; c = c_; }
    __host__ __device__ bool next(int i, Unit& u) const {
        const long L = (long)i * G + c; if (L >= nwg) return false;
        int wgid = (int)L; { const int q = nwg / NXCD, r = nwg % NXCD, xcd = wgid % NXCD, off = wgid / NXCD; wgid = (xcd < r ? xcd * (q + 1) : r * (q + 1) + (xcd - r) * q) + off; }
        const int nig = WGM * nN, gid = wgid / nig, fm = gid * WGM, gsz = (nM - fm) < WGM ? (nM - fm) : WGM;
        u.pm = fm + ((wgid % nig) % gsz); u.pn = (wgid % nig) / gsz; return true;
    }
    __device__ __forceinline__ void a_ready(const Unit&) const {}
    __device__ __forceinline__ void done(const Unit&) const {}
};

__device__ __forceinline__ unsigned cvt_pk_bf16(float lo, float hi) { unsigned r; asm volatile("v_cvt_pk_bf16_f32 %0, %1, %2" : "=v"(r) : "v"(lo), "v"(hi)); return r; }
typedef float f32x2 __attribute__((ext_vector_type(2)));
__device__ __forceinline__ f32x2 gelu_pk(f32x2 v) {
    const f32x2 av = __builtin_elementwise_abs(v), d = av * 0.2316418882f + 1.0f;
    f32x2 t; t.x = __builtin_amdgcn_rcpf(d.x); t.y = __builtin_amdgcn_rcpf(d.y);
    f32x2 q = t * 0.5307027145f + (-0.7265760135f); q = q * t + 0.7107068705f; q = q * t + (-0.142248368f); q = q * t + 0.127414796f; q = q * t;
    const f32x2 s = (v * v) * (-0.72134752044f);
    f32x2 e; e.x = __builtin_amdgcn_exp2f(s.x); e.y = __builtin_amdgcn_exp2f(s.y);
    const f32x2 m = v * (q * e), r = v - m;
    f32x2 o; o.x = v.x < 0.f ? m.x : r.x; o.y = v.y < 0.f ? m.y : r.y; return o;
}

template <int ACT  > struct EpiBf16 {
    static constexpr bool PERM = true, AFTER_DRAIN = false; static_assert(ACT == 0 || ACT == 1, "EpiBf16: ACT is 0 (none) or 1 (gelu_pk)");
    bf16_t* O; int ldc; const float* bias; int split_cols; size_t split_stride; float scale0;
    __device__ __forceinline__ void operator()(const f32x4 (&acc)[2][2][4][2], const Unit& u, int wr, int wc, int fr, int fq) const {
        const int row0 = u.pm * BM + wr * 64 + fr; int colt = u.pn * BM; bf16_t* base = O;
        float sc = 1.f; if (split_cols) { const int t = colt / split_cols; base += (size_t)t * split_stride; colt -= t * split_cols; if (t == 0) sc = scale0; }
        const int col0 = colt + wc * 32 + 8 * fq, bcol0 = u.pn * BM + wc * 32 + 8 * fq;
        f32x4 bv[2][2];
#pragma unroll
        for (int bj = 0; bj < 2; ++bj)
#pragma unroll
            for (int n = 0; n < 2; ++n) bv[bj][n] = bias ? *(const f32x4*)(bias + bcol0 + bj * HALF + 4 * n) : (f32x4){0.f, 0.f, 0.f, 0.f};
#pragma unroll
        for (int ai = 0; ai < 2; ++ai)
#pragma unroll
            for (int m = 0; m < 4; ++m) { bf16_t* rowp = base + (size_t)(row0 + ai * HALF + m * 16) * ldc + col0;
#pragma unroll
                for (int bj = 0; bj < 2; ++bj) { f32x4 v0 = acc[ai][bj][m][0] + bv[bj][0], v1 = acc[ai][bj][m][1] + bv[bj][1];
                    if (ACT == 1) { f32x2 a = gelu_pk((f32x2){v0[0], v0[1]}), b = gelu_pk((f32x2){v0[2], v0[3]}), c = gelu_pk((f32x2){v1[0], v1[1]}), d = gelu_pk((f32x2){v1[2], v1[3]});
                        v0 = (f32x4){a.x, a.y, b.x, b.y}; v1 = (f32x4){c.x, c.y, d.x, d.y}; }
                    v0 = v0 * sc; v1 = v1 * sc; u32x4 w; w.x = cvt_pk_bf16(v0[0], v0[1]); w.y = cvt_pk_bf16(v0[2], v0[3]); w.z = cvt_pk_bf16(v1[0], v1[1]); w.w = cvt_pk_bf16(v1[2], v1[3]);
                    *(u32x4*)(rowp + bj * HALF) = w; } }
    }
};

struct EpiProj {
    static constexpr bool PERM = true, AFTER_DRAIN = false;
    bf16_t* O; const float* cs; const float* sn;
    __device__ __forceinline__ void operator()(const f32x4 (&acc)[2][2][4][2], const Unit& u, int wr, int wc, int fr, int fq) const {
        const int sec = u.pn >> 3;
        const int row0 = u.pm * BM + wr * 64 + fr, j0 = wc * 32 + 8 * fq, col0 = u.pn * BM + j0;
#pragma unroll
        for (int ai = 0; ai < 2; ++ai)
#pragma unroll
            for (int m = 0; m < 4; ++m) {
                const int row = row0 + ai * HALF + m * 16;
                f32x4 a0 = acc[ai][0][m][0], a1 = acc[ai][0][m][1], b0 = acc[ai][1][m][0], b1 = acc[ai][1][m][1];
                if (sec < 2) {
                    const float* cp = cs + (size_t)row * 128 + j0; const float* sp = sn + (size_t)row * 128 + j0;
                    const f32x4 c0 = *(const f32x4*)cp, c1 = *(const f32x4*)(cp + 4), s0 = *(const f32x4*)sp, s1 = *(const f32x4*)(sp + 4);
                    const float sc = sec ? 0.0625f : 1.0f;
                    const f32x4 t0 = (a0 * c0 - b0 * s0) * sc, t1 = (a1 * c1 - b1 * s1) * sc;
                    b0 = (a0 * s0 + b0 * c0) * sc; b1 = (a1 * s1 + b1 * c1) * sc; a0 = t0; a1 = t1;
                } else if (sec == 3) {
#pragma unroll
                    for (int j = 0; j < 4; ++j) { a0[j] = silu_f(a0[j]); a1[j] = silu_f(a1[j]); b0[j] = silu_f(b0[j]); b1[j] = silu_f(b1[j]); }
                } else if (sec >= 4) {
#pragma unroll
                    for (int j = 0; j < 4; ++j) { a0[j] = gelu_tanh_f(a0[j]); a1[j] = gelu_tanh_f(a1[j]); b0[j] = gelu_tanh_f(b0[j]); b1[j] = gelu_tanh_f(b1[j]); }
                }
                bf16_t* rowp = O + (size_t)row * 12288 + col0;
                u32x4 w; w.x = cvt_pk_bf16(a0[0], a0[1]); w.y = cvt_pk_bf16(a0[2], a0[3]); w.z = cvt_pk_bf16(a1[0], a1[1]); w.w = cvt_pk_bf16(a1[2], a1[3]);
                *(u32x4*)rowp = w;
                w.x = cvt_pk_bf16(b0[0], b0[1]); w.y = cvt_pk_bf16(b0[2], b0[3]); w.z = cvt_pk_bf16(b1[0], b1[1]); w.w = cvt_pk_bf16(b1[2], b1[3]);
                *(u32x4*)(rowp + HALF) = w;
            }
    }
};
struct EpiResid {
    static constexpr bool PERM = false, AFTER_DRAIN = false;
    const float* base; float* out; int ldc;
    __device__ __forceinline__ void operator()(const f32x4 (&acc)[2][2][4][2], const Unit& u, int wr, int wc, int fr, int fq) const {
        const int row0 = u.pm * BM + wr * 64 + fr, col0 = u.pn * BM + wc * 32 + 4 * fq;
#pragma unroll
        for (int ai = 0; ai < 2; ++ai)
#pragma unroll
            for (int m = 0; m < 4; ++m) { const size_t off = (size_t)(row0 + ai * HALF + m * 16) * ldc + col0;
#pragma unroll
                for (int bj = 0; bj < 2; ++bj)
#pragma unroll
                    for (int n = 0; n < 2; ++n) { const f32x4 bs = *(const f32x4*)(base + off + bj * HALF + n * 16); *(f32x4*)(out + off + bj * HALF + n * 16) = bs + acc[ai][bj][m][n]; } }
    }
};
template <class Epi, class Sched, bool ALIGN_EPI = false, bool SP2 = false>
__device__ __forceinline__ void gemm_phase(PG8_LAS unsigned char* lds, const Gemm g, const Sched& S, const Epi& E) {
    const int tid = threadIdx.x, wid = __builtin_amdgcn_readfirstlane(tid >> 6), lane = tid & 63, wr = wid >> 2, wc = wid & 3, fr = lane & 15, fq = lane >> 4;
    const int K = g.K, nt = K / BK;
    unsigned voffA[2], voffB[2];
#pragma unroll
    for (int i = 0; i < 2; ++i) { int R, C; stage_rc(tid * 16 + i * 8192, R, C); const int Rb = Epi::PERM ? ((R & ~31) + perm32(R & 31)) : R;
        voffA[i] = (unsigned)(R * K + C) * 2u; voffB[i] = (unsigned)(Rb * K + C) * 2u; }
    const size_t kstep = (size_t)(BK * 2);
    const size_t hstep = (size_t)HALF * K * 2;
    const size_t tstep = 2 * hstep;
    const unsigned ldsw = (unsigned)wid * 1024u;
    const int aoff = lds_byte(wr * 64 + fr, fq * 8), boff = lds_byte(wc * 32 + fr, fq * 8);
#define PG8_SA(b, h) (((b) * 2 + (h)) * HTB)
#define PG8_SB(b, h) ((4 + (b) * 2 + (h)) * HTB)
#define PG8_STAGE(bufoff, gbase, voff) do { _Pragma("unroll") for (int _i = 0; _i < 2; ++_i) \
        __builtin_amdgcn_global_load_lds((const unsigned*)((const char*)(gbase) + (voff)[_i]), (PG8_LAS unsigned*)(lds + (bufoff) + ldsw + _i * 8192), 16, 0, 0); } while (0)
#define PG8_LDA(dst, b, h) do { _Pragma("unroll") for (int m = 0; m < 4; ++m) _Pragma("unroll") for (int k = 0; k < 2; ++k) dst[m][k] = *(const PG8_LAS bf16x8*)(lds + PG8_SA(b, h) + aoff + m * 2048 + k * 1024); } while (0)
#define PG8_LDB(dst, b, h) do { _Pragma("unroll") for (int n = 0; n < 2; ++n) _Pragma("unroll") for (int k = 0; k < 2; ++k) dst[n][k] = *(const PG8_LAS bf16x8*)(lds + PG8_SB(b, h) + boff + n * 2048 + k * 1024); } while (0)
#define PG8_MMA(ai, bj, At, Bt) do { __builtin_amdgcn_s_setprio(1); _Pragma("unroll") for (int m = 0; m < 4; ++m) _Pragma("unroll") for (int n = 0; n < 2; ++n) _Pragma("unroll") for (int k = 0; k < 2; ++k) \
        acc[ai][bj][m][n] = __builtin_amdgcn_mfma_f32_16x16x32_bf16(Bt[n][k], At[m][k], acc[ai][bj][m][n], 0, 0, 0); __builtin_amdgcn_s_setprio(0); } while (0)
#define PG8_WAIT_V(n) asm volatile("s_waitcnt vmcnt(" #n ")" ::: "memory")
#define PG8_WAIT_L(n) asm volatile("s_waitcnt lgkmcnt(" #n ")" ::: "memory")
#define PG8_BAR __builtin_amdgcn_s_barrier()
#define PG8_SCHED __builtin_amdgcn_sched_barrier(0)
    Unit cur, nxt; int ui = 0;
    if (!S.next(0, cur)) return;
    f32x4 acc[2][2][4][2];
#pragma unroll
    for (int a = 0; a < 2; ++a)
#pragma unroll
        for (int b = 0; b < 2; ++b)
#pragma unroll
            for (int m = 0; m < 4; ++m)
#pragma unroll
                for (int n = 0; n < 2; ++n) acc[a][b][m][n] = (f32x4){0.f, 0.f, 0.f, 0.f};
    bf16x8 At[4][2], B0[2][2], B1[2][2];
    const char* cA = (const char*)g.A + (size_t)cur.pm * tstep; const char* cB = (const char*)g.Bt + (size_t)cur.pn * tstep;
    S.a_ready(cur);
    if constexpr (SP2) {
        PG8_STAGE(PG8_SB(0, 0), cB, voffB); PG8_STAGE(PG8_SB(0, 1), cB + hstep, voffB); PG8_STAGE(PG8_SA(0, 0), cA, voffA); PG8_STAGE(PG8_SA(0, 1), cA + hstep, voffA);
        if (wr == 1) PG8_BAR;
        PG8_WAIT_V(2); PG8_BAR;
        PG8_STAGE(PG8_SB(1, 0), cB + kstep, voffB); PG8_STAGE(PG8_SA(1, 0), cA + kstep, voffA); PG8_STAGE(PG8_SB(1, 1), cB + hstep + kstep, voffB);
        PG8_WAIT_V(6); PG8_BAR;
    } else {
        PG8_STAGE(PG8_SB(0, 0), cB, voffB); PG8_STAGE(PG8_SA(0, 0), cA, voffA); PG8_STAGE(PG8_SB(0, 1), cB + hstep, voffB); PG8_STAGE(PG8_SA(0, 1), cA + hstep, voffA);
        if (wr == 1) PG8_BAR;
        PG8_WAIT_V(4); PG8_BAR;
        PG8_STAGE(PG8_SB(1, 0), cB + kstep, voffB); PG8_STAGE(PG8_SA(1, 0), cA + kstep, voffA); PG8_STAGE(PG8_SB(1, 1), cB + hstep + kstep, voffB);
        PG8_WAIT_V(6); PG8_BAR;
    }
    for (;;) {
        const bool has_next = S.next(ui + 1, nxt);
        const char* nA = has_next ? (const char*)g.A + (size_t)nxt.pm * tstep : cA; const char* nB = has_next ? (const char*)g.Bt + (size_t)nxt.pn * tstep : cB;
        for (int t = 0; t < nt; t += 2) {
            const bool last = (t == nt - 2);
            const char* a1 = cA + (size_t)(t + 1) * kstep;
            const char* a2 = last ? nA : cA + (size_t)(t + 2) * kstep; const char* b2 = last ? nB : cB + (size_t)(t + 2) * kstep;
            const char* a3 = a2 + kstep; const char* b3 = b2 + kstep;
            if (last && has_next) S.a_ready(nxt);
            if constexpr (SP2) {
            PG8_LDB(B0, 0, 0); PG8_LDB(B1, 0, 1); PG8_SCHED; PG8_LDA(At, 0, 0); PG8_STAGE(PG8_SA(1, 1), a1 + hstep, voffA);
            PG8_WAIT_V(8); PG8_WAIT_L(0); PG8_BAR; PG8_MMA(0, 0, At, B0); PG8_MMA(0, 1, At, B1); PG8_BAR; PG8_SCHED;
            PG8_LDA(At, 0, 1); PG8_STAGE(PG8_SB(0, 0), b2, voffB); PG8_STAGE(PG8_SB(0, 1), b2 + hstep, voffB); PG8_STAGE(PG8_SA(0, 0), a2, voffA);
            PG8_WAIT_V(8); PG8_WAIT_L(0); PG8_BAR; PG8_MMA(1, 0, At, B0); PG8_MMA(1, 1, At, B1); PG8_BAR; PG8_SCHED;
            PG8_LDB(B0, 1, 0); PG8_LDB(B1, 1, 1); PG8_SCHED; PG8_LDA(At, 1, 0); PG8_STAGE(PG8_SA(0, 1), a2 + hstep, voffA);
            PG8_WAIT_V(8); PG8_WAIT_L(0); PG8_BAR; PG8_MMA(0, 0, At, B0); PG8_MMA(0, 1, At, B1); PG8_BAR; PG8_SCHED;
            PG8_LDA(At, 1, 1); PG8_STAGE(PG8_SB(1, 0), b3, voffB); PG8_STAGE(PG8_SB(1, 1), b3 + hstep, voffB); PG8_STAGE(PG8_SA(1, 0), a3, voffA);
            PG8_WAIT_V(8); PG8_WAIT_L(0); PG8_BAR; PG8_MMA(1, 0, At, B0); PG8_MMA(1, 1, At, B1); PG8_BAR; PG8_SCHED;
            } else {
            PG8_LDB(B0, 0, 0); PG8_SCHED; PG8_LDA(At, 0, 0); PG8_STAGE(PG8_SA(1, 1), a1 + hstep, voffA);
            PG8_WAIT_L(8); PG8_BAR; PG8_WAIT_L(0); PG8_MMA(0, 0, At, B0); PG8_BAR; PG8_SCHED;
            PG8_LDB(B1, 0, 1); PG8_STAGE(PG8_SB(0, 0), b2, voffB);
            PG8_BAR; PG8_WAIT_L(0); PG8_MMA(0, 1, At, B1); PG8_BAR;
            PG8_LDA(At, 0, 1); PG8_STAGE(PG8_SA(0, 0), a2, voffA);
            PG8_BAR; PG8_WAIT_L(0); PG8_MMA(1, 0, At, B0); PG8_BAR; PG8_SCHED;
            PG8_STAGE(PG8_SB(0, 1), b2 + hstep, voffB);
            PG8_WAIT_V(6); PG8_BAR; PG8_MMA(1, 1, At, B1); PG8_BAR;
            PG8_LDB(B0, 1, 0); PG8_SCHED; PG8_LDA(At, 1, 0); PG8_STAGE(PG8_SA(0, 1), a2 + hstep, voffA);
            PG8_WAIT_L(8); PG8_BAR; PG8_WAIT_L(0); PG8_MMA(0, 0, At, B0); PG8_BAR; PG8_SCHED;
            PG8_LDB(B1, 1, 1); PG8_STAGE(PG8_SB(1, 0), b3, voffB);
            PG8_BAR; PG8_WAIT_L(0); PG8_MMA(0, 1, At, B1); PG8_BAR;
            PG8_LDA(At, 1, 1); PG8_STAGE(PG8_SA(1, 0), a3, voffA);
            PG8_BAR; PG8_WAIT_L(0); PG8_MMA(1, 0, At, B0); PG8_BAR; PG8_SCHED;
            PG8_STAGE(PG8_SB(1, 1), b3 + hstep, voffB);
            PG8_WAIT_V(6); PG8_BAR; PG8_MMA(1, 1, At, B1); PG8_BAR;
            }
        }
        if constexpr (ALIGN_EPI) { if (wr == 0) PG8_BAR; }
        if constexpr (!Epi::AFTER_DRAIN) { E(acc, cur, wr, wc, fr, fq); S.done(cur); }
        if (!has_next) break;
#pragma unroll
        for (int a = 0; a < 2; ++a)
#pragma unroll
            for (int b = 0; b < 2; ++b)
#pragma unroll
                for (int m = 0; m < 4; ++m)
#pragma unroll
                    for (int n = 0; n < 2; ++n) acc[a][b][m][n] = (f32x4){0.f, 0.f, 0.f, 0.f};
        cur = nxt; cA = nA; cB = nB; ++ui;
        if constexpr (ALIGN_EPI) { if (wr == 1) PG8_BAR; }
    }
    PG8_WAIT_V(0);
    if constexpr (!ALIGN_EPI) { if (wr == 0) PG8_BAR; }
    PG8_BAR;
    if constexpr (Epi::AFTER_DRAIN) { E.fused(acc, cur, wr, wc, fr, fq, lds, wid, lane); S.done(cur); }
#undef PG8_SA
#undef PG8_SB
#undef PG8_STAGE
#undef PG8_LDA
#undef PG8_LDB
#undef PG8_MMA
#undef PG8_WAIT_V
#undef PG8_WAIT_L
#undef PG8_BAR
#undef PG8_SCHED
}
}
#define XB_TMO      128
#define XB_XCNT(j)  (256  + 64 * (j))
#define XB_XSUB(j)  (1280 + 64 * (j))
#define XB_XGEN(j)  (2304 + 64 * (j))
#define XB_TOP      3328
#define XB_TOPGEN   3392
#define XCD_BAR_WORDS 3456
#define XB_SPIN_CAP (1u << 18)

__device__ __forceinline__ unsigned xb_ld(unsigned* p)              { return __hip_atomic_load(p, __ATOMIC_RELAXED, __HIP_MEMORY_SCOPE_AGENT); }
__device__ __forceinline__ unsigned xb_add(unsigned* p, unsigned v) { return __hip_atomic_fetch_add(p, v, __ATOMIC_RELAXED, __HIP_MEMORY_SCOPE_AGENT); }
__device__ __forceinline__ unsigned xb_xcc_id() { return (unsigned)__builtin_amdgcn_s_getreg((3 << 11) | 20) & 0xFu; }
#define XB_SPIN(cond, bar) do { unsigned _sp = 0; while (cond) { __builtin_amdgcn_s_sleep(1); \
    if ((++_sp & 255u) == 0u) { if (xb_ld(&(bar)[XB_TMO])) break; if (_sp > XB_SPIN_CAP) { atomicAdd(&(bar)[XB_TMO], 1u); break; } } } } while (0)

struct XcdBarrier {
    unsigned* bar; unsigned x;
    volatile LAS unsigned* st;
};

__device__ __forceinline__ XcdBarrier xcd_barrier_post(unsigned* bar, volatile LAS unsigned* st) {
    XcdBarrier b; b.bar = bar; b.x = xb_xcc_id(); b.st = st;
    if (threadIdx.x == 0) (void)xb_add(&bar[XB_XCNT(b.x)], 1u);
    return b;
}
__device__ __forceinline__ void xcd_barrier_complete(unsigned* bar, unsigned x, unsigned& nloc, unsigned& nx) {
    const unsigned G = gridDim.x * gridDim.y * gridDim.z;
    unsigned sum, cnt, mine, sp = 0u;
    for (;;) {
        sum = 0u; cnt = 0u; mine = 0u;
#pragma unroll
        for (unsigned j = 0; j < 16; ++j) { const unsigned c = xb_ld(&bar[XB_XCNT(j)]); sum += c; cnt += (c > 0u) ? 1u : 0u; mine = (j == x) ? c : mine; }
        if (sum == G) break;
        __builtin_amdgcn_s_sleep(1);
        if ((++sp & 255u) == 0u) { if (xb_ld(&bar[XB_TMO])) break; if (sp > XB_SPIN_CAP) { atomicAdd(&bar[XB_TMO], 1u); break; } }
    }
    nloc = mine > 0u ? mine : 1u; nx = cnt > 0u ? cnt : 1u;
}

__device__ __forceinline__ void xcd_barrier(const XcdBarrier& b) {
    asm volatile("s_waitcnt vmcnt(0)" ::: "memory");
    __syncthreads();
    if (threadIdx.x == 0) {
        unsigned* bar = b.bar;
        __builtin_amdgcn_s_waitcnt(0);
        unsigned nloc = b.st[0], nx = b.st[1];
        if (nloc == 0u) { xcd_barrier_complete(bar, b.x, nloc, nx); b.st[0] = nloc; b.st[1] = nx; }
        const unsigned old = xb_add(&bar[XB_XSUB(b.x)], 1u);
        const unsigned gen = old / nloc;
        if (old + 1u == (gen + 1u) * nloc) {
            __builtin_amdgcn_fence(__ATOMIC_RELEASE, "agent");
            asm volatile("s_waitcnt vmcnt(0)" ::: "memory");
            const unsigned og = xb_add(&bar[XB_TOP], 1u);
            const unsigned tg = og / nx;
            if (og + 1u == (tg + 1u) * nx) xb_add(&bar[XB_TOPGEN], 1u);
            else XB_SPIN(xb_ld(&bar[XB_TOPGEN]) == tg, bar);
            __builtin_amdgcn_fence(__ATOMIC_ACQUIRE, "agent");
            xb_add(&bar[XB_XGEN(b.x)], 1u);
            asm volatile("s_waitcnt vmcnt(0)" ::: "memory");
        } else {
            XB_SPIN(xb_ld(&bar[XB_XGEN(b.x)]) == gen, bar);
            __builtin_amdgcn_fence(__ATOMIC_ACQUIRE, "agent");
            asm volatile("s_waitcnt vmcnt(0)" ::: "memory");
        }
    }
    __syncthreads();
}


__device__ __forceinline__ void p0_transpose_item(const float* W, int K, int N, bf16* WT, LAS float* scr, int item, int lane) {
    const int nblk = N / 32, kb = item / nblk, nb = item % nblk, k0 = 64 * kb, n0 = 32 * nb;
#pragma unroll 8
    for (int i = 0; i < 32; ++i) { const int kk = 2 * i + (lane >> 5); scr[kk * 33 + (lane & 31)] = W[(size_t)(k0 + kk) * N + n0 + (lane & 31)]; }
    LDS_WAIT(); asm volatile("" ::: "memory");
    const int c = lane & 7;
#pragma unroll
    for (int j = 0; j < 4; ++j) { const int n = (lane >> 3) + 8 * j; const LAS float* s = scr + (8 * c) * 33 + n;
        v4u o; o.x = pk2(s[0 * 33], s[1 * 33]); o.y = pk2(s[2 * 33], s[3 * 33]); o.z = pk2(s[4 * 33], s[5 * 33]); o.w = pk2(s[6 * 33], s[7 * 33]);
        *(v4u*)(WT + (size_t)(n0 + n) * K + k0 + 8 * c) = o; }
    LDS_WAIT(); asm volatile("" ::: "memory");
}
__device__ __forceinline__ void rms_row_to_bf16(const float* xrow, const float* g, bf16* orow, int lane) {
    const f32x4* xr = (const f32x4*)xrow + lane; f32x4 v[16]; float ss = 0.f;
#pragma unroll
    for (int j = 0; j < 16; ++j) { v[j] = xr[64 * j]; ss += (v[j].x * v[j].x + v[j].y * v[j].y) + (v[j].z * v[j].z + v[j].w * v[j].w); }
    const float rs = rsqrtf(wave_sum(ss) * (1.f / D) + EPS);
    const f32x4* gr = (const f32x4*)g + lane; v2u* o8 = (v2u*)orow + lane;
#pragma unroll
    for (int j = 0; j < 16; ++j) { const f32x4 gg = gr[64 * j]; v2u o; o.x = pk2(v[j].x * rs * gg.x, v[j].y * rs * gg.y); o.y = pk2(v[j].z * rs * gg.z, v[j].w * rs * gg.w); o8[64 * j] = o; }
}
__device__ __forceinline__ int block_excl_scan(int v, LAS int* sc, int tid, int& tot) {
    const int lane = tid & 63, w = tid >> 6; int x = v;
#pragma unroll
    for (int o = 1; o < 64; o <<= 1) { const int y = __shfl_up(x, o); if (lane >= o) x += y; }
    __syncthreads();
    if (lane == 63) sc[w] = x;
    __syncthreads();
    int base = 0, t = 0;
#pragma unroll
    for (int i = 0; i < 8; ++i) { const int s = sc[i]; if (i < w) base += s; t += s; }
    tot = t; return base + x - v;
}
__device__ __forceinline__ int build_list(const int* eid, int e, LAS int* list, LAS int* sc, int tid, int& off) {
    const int4* p = (const int4*)(eid + 32 * tid); unsigned mask = 0u; int cm = 0, cl = 0;
#pragma unroll
    for (int i = 0; i < 8; ++i) { const int4 v = p[i];
        if (v.x == e) { mask |= 1u << (4 * i); ++cm; } if (v.y == e) { mask |= 2u << (4 * i); ++cm; } if (v.z == e) { mask |= 4u << (4 * i); ++cm; } if (v.w == e) { mask |= 8u << (4 * i); ++cm; }
        cl += (v.x < e) + (v.y < e) + (v.z < e) + (v.w < e); }
    int tot; int pos = block_excl_scan(cm, sc, tid, tot);
    int tl; (void)block_excl_scan(cl, sc + 8, tid, tl); off = tl;
    while (mask) { const int b = __builtin_ctz(mask); mask &= mask - 1u; list[pos++] = 32 * tid + b; }
    __syncthreads();
    return tot;
}


__device__ __forceinline__ int build_list16(const int* eid, int e, LAS unsigned short* list, LAS int* sc, int tid, int& off) {
    const int4* p = (const int4*)(eid + 32 * tid); unsigned mask = 0u; int cm = 0, cl = 0;
#pragma unroll
    for (int i = 0; i < 8; ++i) { const int4 v = p[i];
        if (v.x == e) { mask |= 1u << (4 * i); ++cm; } if (v.y == e) { mask |= 2u << (4 * i); ++cm; } if (v.z == e) { mask |= 4u << (4 * i); ++cm; } if (v.w == e) { mask |= 8u << (4 * i); ++cm; }
        cl += (v.x < e) + (v.y < e) + (v.z < e) + (v.w < e); }
    int tot; int pos = block_excl_scan(cm, sc, tid, tot);
    int tl; (void)block_excl_scan(cl, sc + 8, tid, tl); off = tl;
    while (mask) { const int b = __builtin_ctz(mask); mask &= mask - 1u; list[pos++] = (unsigned short)(32 * tid + b); }
    __syncthreads();
    return tot;
}
__device__ __forceinline__ unsigned cvtpk(float lo, float hi) { unsigned r; asm("v_cvt_pk_bf16_f32 %0, %1, %2" : "=v"(r) : "v"(lo), "v"(hi)); return r; }
typedef float f32x2g __attribute__((ext_vector_type(2)));
__device__ __forceinline__ void moe_kloop(LAS unsigned char* lds, int tid, int wave, int lane, const bf16* Asrc, const unsigned (&aoff)[6], const float* bsrc, int ldb, int K, int nsl, f32x4 (&acc)[3][8]) {
    const int fr = lane & 15, fq = lane >> 4, swz = fr & 7, kc_a = tid & 7, ra = tid >> 3, n2 = tid & 63, kc_b = wave;
    const unsigned a_wr = (unsigned)(ra * 128 + ((kc_a ^ (ra & 7)) << 4));
    const unsigned b_wr0 = 49152u + (unsigned)((2 * n2) * 128 + ((kc_b ^ ((2 * n2) & 7)) << 4)), b_wr1 = 49152u + (unsigned)((2 * n2 + 1) * 128 + ((kc_b ^ ((2 * n2 + 1) & 7)) << 4));
    const unsigned a_rd = (unsigned)((wave * 16 + fr) * 128), b_rd = 49152u + (unsigned)(fr * 128);
#pragma unroll
    for (int sl = 0; sl < 3; ++sl)
#pragma unroll
        for (int nt = 0; nt < 8; ++nt) acc[sl][nt] = (f32x4){0.f, 0.f, 0.f, 0.f};
    v4u areg[6]; f32x2g breg[8];
#define MOE_LOAD(k0) do { _Pragma("unroll") for (int i_ = 0; i_ < 6; ++i_) areg[i_] = *(const v4u*)(Asrc + aoff[i_] + (k0)); \
        _Pragma("unroll") for (int i_ = 0; i_ < 8; ++i_) breg[i_] = __builtin_nontemporal_load((const f32x2g*)(bsrc + (size_t)((k0) + i_) * ldb)); } while (0)
#define MOE_STORE(bo) do { _Pragma("unroll") for (int i_ = 0; i_ < 6; ++i_) *(LAS v4u*)(lds + (bo) + a_wr + i_ * 8192) = areg[i_]; \
        v4u w_; w_.x = cvtpk(breg[0].x, breg[1].x); w_.y = cvtpk(breg[2].x, breg[3].x); w_.z = cvtpk(breg[4].x, breg[5].x); w_.w = cvtpk(breg[6].x, breg[7].x); *(LAS v4u*)(lds + (bo) + b_wr0) = w_; \
        w_.x = cvtpk(breg[0].y, breg[1].y); w_.y = cvtpk(breg[2].y, breg[3].y); w_.z = cvtpk(breg[4].y, breg[5].y); w_.w = cvtpk(breg[6].y, breg[7].y); *(LAS v4u*)(lds + (bo) + b_wr1) = w_; } while (0)
#define MOE_COMPUTE(bo) do { _Pragma("unroll 1") for (int ks_ = 0; ks_ < 2; ++ks_) { const unsigned xk_ = (unsigned)(((4 * ks_ + fq) ^ swz) << 4); \
        _Pragma("unroll") for (int hf_ = 0; hf_ < 2; ++hf_) { bf16x8 bfr_[4]; \
        _Pragma("unroll") for (int nt_ = 0; nt_ < 4; ++nt_) bfr_[nt_] = *(const LAS bf16x8*)(lds + (bo) + b_rd + (hf_ * 4 + nt_) * 2048 + xk_); \
        _Pragma("unroll") for (int sl_ = 0; sl_ < 3; ++sl_) if (sl_ < nsl) { const bf16x8 af_ = *(const LAS bf16x8*)(lds + (bo) + a_rd + sl_ * 16384 + xk_); \
            _Pragma("unroll") for (int nt_ = 0; nt_ < 4; ++nt_) acc[sl_][hf_ * 4 + nt_] = __builtin_amdgcn_mfma_f32_16x16x32_bf16(bfr_[nt_], af_, acc[sl_][hf_ * 4 + nt_], 0, 0, 0); } } } } while (0)
    __syncthreads();
    MOE_LOAD(0); MOE_STORE(0u); __syncthreads();
    const int S = K >> 6;
    for (int s = 0; s < S; ++s) {
        const unsigned cur = (unsigned)(s & 1) * 65536u, nxt = 65536u - cur;
        if (s + 1 < S) MOE_LOAD((s + 1) * 64);
        MOE_COMPUTE(cur);
        if (s + 1 < S) MOE_STORE(nxt);
        __syncthreads();
    }
#undef MOE_LOAD
#undef MOE_STORE
#undef MOE_COMPUTE
}

struct Args { const void* in[25]; float* out; unsigned char* ws; };
__global__ void __launch_bounds__(NWAVES * 64, 2) mk_fwd(Args a) {
    extern __shared__ __attribute__((aligned(16))) unsigned char lds_raw[];
    LAS unsigned char* lds = (LAS unsigned char*)lds_raw;
    const int tid = threadIdx.x, lane = tid & 63, wave = __builtin_amdgcn_readfirstlane(tid >> 6);
    const int G = gridDim.x, bid = blockIdx.x;
    unsigned char* ws = a.ws;
    gu32* ctl = (gu32*)(ws + WS_CTL);
    const float* x = (const float*)a.in[0]; const float* mem = (const float*)a.in[1]; const int* pos = (const int*)a.in[2];
    const float* g_mix = (const float*)a.in[3]; const float* w_in = (const float*)a.in[4]; const float* ret_g = (const float*)a.in[5];
    const float* ln_g = (const float*)a.in[6]; const float* ln_b = (const float*)a.in[7]; const float* gm_ws = (const float*)a.in[8]; const float* gm_bs = (const float*)a.in[9];
    const float* w_out = (const float*)a.in[10]; const float* g_xa = (const float*)a.in[11]; const float* g_mem = (const float*)a.in[12];
    const float* wq = (const float*)a.in[13]; const float* wkv = (const float*)a.in[14]; const float* wo = (const float*)a.in[15];
    const float* g_moe = (const float*)a.in[16]; const float* rgw = (const float*)a.in[17]; const float* rgb = (const float*)a.in[18];
    const float* rew = (const float*)a.in[19]; const float* reb = (const float*)a.in[20];
    const float* wg = (const float*)a.in[21]; const float* wu = (const float*)a.in[22]; const float* wd = (const float*)a.in[23]; const float* g_fin = (const float*)a.in[24];
    float* out = a.out;
    float* WrT = (float*)(ws + WS_WRT);
    bf16* WtIn = (bf16*)(ws + WS_WIN); bf16* WtOut = (bf16*)(ws + WS_WOUT); bf16* WtQ = (bf16*)(ws + WS_WQ); bf16* WtKV = (bf16*)(ws + WS_WKV); bf16* WtO = (bf16*)(ws + WS_WO);
    bf16* XN = (bf16*)(ws + WS_XN); bf16* MN = (bf16*)(ws + WS_MN); float* COS = (float*)(ws + WS_COS); float* SIN = (float*)(ws + WS_SIN);
    bf16* PROJ = (bf16*)(ws + WS_PROJ); bf16* RET = (bf16*)(ws + WS_RET); bf16* MIX = (bf16*)(ws + WS_MIX); float* H = (float*)(ws + WS_H);
    bf16* QX = (bf16*)(ws + WS_QX); bf16* KX = (bf16*)(ws + WS_KVX); bf16* VT = KX + (size_t)NMEM * XW; bf16* OX = (bf16*)(ws + WS_OX);
    int* EID = (int*)(ws + WS_EID); float* GATE = (float*)(ws + WS_EID + 65536); int* SLOTS = (int*)(ws + WS_EID + 131072); int* OFFCNT = (int*)(ws + WS_EID + 196608);
    bf16* HACT = (bf16*)(ws + WS_HACT); bf16* Y = (bf16*)(ws + WS_Y);

    for (int u = tid; u < (LDS_BYTES - LDSCTL_OFF) / 4; u += NT) ((LAS unsigned*)(lds + LDSCTL_OFF))[u] = 0u;
    __syncthreads();
    volatile LAS unsigned* MISC = (volatile LAS unsigned*)(lds + MISC_OFF);
    XcdBarrier bar = xcd_barrier_post((unsigned*)(ws + WS_CTL) + CW_BAR, MISC + 8);
    const int gw = bid * NWAVES + wave, NGW = G * NWAVES, gtid = bid * NT + tid, NGT = G * NT;

#ifndef SK_P0
    {
        LAS float* scr = (LAS float*)(lds + RING_OFF + wave * 16384);
        constexpr int I_IN = (D / 64) * (INC / 32), I_OUT = (D / 64) * (D / 32), I_Q = (D / 64) * (XW / 32), I_KV = (D / 64) * (2 * XW / 32), I_O = (XW / 64) * (D / 32);
        constexpr int NITEMS = I_IN + I_OUT + I_Q + I_KV + I_O;
        for (int it = gw; it < NITEMS; it += NGW) {
            int r = it;
            if (r < I_IN) { p0_transpose_item(w_in, D, INC, WtIn, scr, r, lane); continue; } r -= I_IN;
            if (r < I_OUT) { p0_transpose_item(w_out, D, D, WtOut, scr, r, lane); continue; } r -= I_OUT;
            if (r < I_Q) { p0_transpose_item(wq, D, XW, WtQ, scr, r, lane); continue; } r -= I_Q;
            if (r < I_KV) { p0_transpose_item(wkv, D, 2 * XW, WtKV, scr, r, lane); continue; } r -= I_KV;
            p0_transpose_item(wo, XW, D, WtO, scr, r, lane);
        }
        for (int i = gtid; i < 72 * D; i += NGT) { const int j = i >> 12, k = i & (D - 1); WrT[i] = j < 8 ? rgw[(size_t)k * 8 + j] : rew[(size_t)k * 64 + (j - 8)]; }
        for (int m = gw; m < NTOK; m += NGW) rms_row_to_bf16(x + (size_t)m * D, g_mix, XN + (size_t)m * D, lane);
        for (int m = gw; m < NMEM; m += NGW) rms_row_to_bf16(mem + (size_t)m * D, g_mem, MN + (size_t)m * D, lane);
        for (int i = gtid; i < NTOK * 128; i += NGT) { const int j = i & 127, row = i >> 7; const float inv = powf(10000.0f, -(float)(2 * j) / 256.0f); const float ang = (float)pos[row] * inv; COS[i] = cosf(ang); SIN[i] = sinf(ang); }
    }
    xcd_barrier(bar);

#endif
#ifndef SK_P1
    {   pg8::Gemm g{XN, WtIn, NTOK, INC, D}; pg8::StaticOrder S; S.init(NTOK, INC, G, bid);
        pg8::EpiProj E{PROJ, COS, SIN};
        pg8::gemm_phase<pg8::EpiProj, pg8::StaticOrder, PG8_ALIGN, PG8_SP2>(lds + RING_OFF, g, S, E); }
    xcd_barrier(bar);

#endif
#ifndef SK_P2
    for (int vb = bid; vb < NB * RH * 8; vb += G) {
        const int es = vb & 7, h = (vb >> 3) & 7, b = vb >> 6, dg = tid & 15, el = tid >> 4, e = es * 32 + el;
        const float gamma = 1.0f - exp2f(-5.0f - (float)h);
        float st[16];
#pragma unroll
        for (int i = 0; i < 16; ++i) st[i] = 0.f;
        for (int t = 0; t < SEQ; ++t) {
            const size_t row = (size_t)b * SEQ + t; const bf16* pr = PROJ + row * INC + h * RDH;
            const v4u qa = *(const v4u*)(pr + dg * 16), qb = *(const v4u*)(pr + dg * 16 + 8), ka = *(const v4u*)(pr + RW + dg * 16), kb = *(const v4u*)(pr + RW + dg * 16 + 8);
            const float vv = bf2f(pr[2 * RW + e]); float part = 0.f;
#define RSTEP(i, qw, kw) { st[2 * (i)] = gamma * st[2 * (i)] + bflo(kw) * vv; part += bflo(qw) * st[2 * (i)]; st[2 * (i) + 1] = gamma * st[2 * (i) + 1] + bfhi(kw) * vv; part += bfhi(qw) * st[2 * (i) + 1]; }
            RSTEP(0, qa.x, ka.x) RSTEP(1, qa.y, ka.y) RSTEP(2, qa.z, ka.z) RSTEP(3, qa.w, ka.w) RSTEP(4, qb.x, kb.x) RSTEP(5, qb.y, kb.y) RSTEP(6, qb.z, kb.z) RSTEP(7, qb.w, kb.w)
#undef RSTEP
            part += __shfl_xor(part, 1); part += __shfl_xor(part, 2); part += __shfl_xor(part, 4); part += __shfl_xor(part, 8);
            if (dg == 0) RET[row * RW + h * RDH + e] = (bf16)f2bf(part);
        }
    }
    xcd_barrier(bar);

#endif
#ifndef SK_P3
    for (int it = gw; it < NTOK * RH; it += NGW) {
        const int h = it & 7; const size_t row = it >> 3;
        const v2u rv = *(const v2u*)(RET + row * RW + h * RDH + lane * 4);
        float v0 = bflo(rv.x), v1 = bfhi(rv.x), v2 = bflo(rv.y), v3 = bfhi(rv.y);
        const float mu = wave_sum((v0 + v1) + (v2 + v3)) * (1.f / 256.f);
        v0 -= mu; v1 -= mu; v2 -= mu; v3 -= mu;
        const float rs = rsqrtf(wave_sum((v0 * v0 + v1 * v1) + (v2 * v2 + v3 * v3)) * (1.f / 256.f) + EPS);
        const int c = h * RDH + lane * 4; const f32x4 rg = *(const f32x4*)(ret_g + c);
        const v2u gv = *(const v2u*)(PROJ + row * INC + 3 * RW + c);
        v2u o; o.x = pk2(bflo(gv.x) * (v0 * rs * rg.x), bfhi(gv.x) * (v1 * rs * rg.y)); o.y = pk2(bflo(gv.y) * (v2 * rs * rg.z), bfhi(gv.y) * (v3 * rs * rg.w));
        *(v2u*)(MIX + row * D + c) = o;
    }
    for (int un = bid; un < NB * (SEQ / CHK) * GG; un += G) {
        const int g = un & 7, n = (un >> 3) & 15, b = un >> 7; const size_t row0 = (size_t)b * SEQ + n * CHK;
        LAS bf16* vt = (LAS bf16*)(lds + RING_OFF);
        LAS float* stat = (LAS float*)(lds + AUX_OFF);
        __syncthreads();
        for (int rr = 0; rr < 16; ++rr) { const int r = wave * 16 + rr; const bf16* p = PROJ + (row0 + r) * INC + 5 * RW + lane * 8;
            float xv[32]; float s = 0.f;
#pragma unroll
            for (int i = 0; i < 4; ++i) { const v4u w = *(const v4u*)(p + 512 * i); xv[8 * i + 0] = bflo(w.x); xv[8 * i + 1] = bfhi(w.x); xv[8 * i + 2] = bflo(w.y); xv[8 * i + 3] = bfhi(w.y); xv[8 * i + 4] = bflo(w.z); xv[8 * i + 5] = bfhi(w.z); xv[8 * i + 6] = bflo(w.w); xv[8 * i + 7] = bfhi(w.w); }
#pragma unroll
            for (int i = 0; i < 32; ++i) s += xv[i];
            const float mu = wave_sum(s) * (1.f / GMW); float q = 0.f;
#pragma unroll
            for (int i = 0; i < 32; ++i) { const float d = xv[i] - mu; q += d * d; }
            const float rs = rsqrtf(wave_sum(q) * (1.f / GMW) + EPS);
            if (lane == 0) { stat[r] = mu; stat[128 + r] = rs; } }
        __syncthreads();
        { const int c = tid & 255, half = tid >> 8; const float lg = ln_g[g * GCG + c], lb = ln_b[g * GCG + c];
          for (int s = half; s < CHK; s += 2) { const float xv = bf2f(PROJ[(row0 + s) * INC + 5 * RW + g * GCG + c]); vt[s * 256 + c] = (bf16)f2bf((xv - stat[s]) * stat[128 + s] * lg + lb); } }
        __syncthreads();
        { const int c = tid & 255, half = tid >> 8;
          for (int i = 0; i < 64; ++i) { const int t = 2 * i + half; const float* w = gm_ws + ((size_t)g * CHK + t) * CHK; float acc = 0.f;
              for (int s = 0; s <= t; ++s) acc += w[s] * bf2f(vt[s * 256 + c]);
              const float uu = bf2f(PROJ[(row0 + t) * INC + 4 * RW + g * GCG + c]);
              MIX[(row0 + t) * D + RW + g * GCG + c] = (bf16)f2bf(uu * (acc + gm_bs[g * CHK + t])); } }
    }
    xcd_barrier(bar);

#endif
#ifndef SK_P4
    {   pg8::Gemm g{MIX, WtOut, NTOK, D, D}; pg8::StaticOrder S; S.init(NTOK, D, G, bid);
        pg8::EpiResid E{x, H, D};
        pg8::gemm_phase<pg8::EpiResid, pg8::StaticOrder, PG8_ALIGN, PG8_SP2>(lds + RING_OFF, g, S, E); }
    xcd_barrier(bar);
#endif
#ifndef SK_P4b
    for (int m = gw; m < NTOK; m += NGW) rms_row_to_bf16(H + (size_t)m * D, g_xa, XN + (size_t)m * D, lane);
    xcd_barrier(bar);
#endif
#ifndef SK_P5
    {   pg8::Gemm g{XN, WtQ, NTOK, XW, D}; pg8::StaticOrder S; S.init(NTOK, XW, G, bid);
        pg8::EpiBf16<0> E{QX, XW, nullptr, 0, 0, 1.f};
        pg8::gemm_phase<pg8::EpiBf16<0>, pg8::StaticOrder, PG8_ALIGN, PG8_SP2>(lds + RING_OFF, g, S, E); }
    {   pg8::Gemm g{MN, WtKV, NMEM, XW, D}; pg8::StaticOrder S; S.init(NMEM, XW, G, (bid + G - 128) % G);
        pg8::EpiBf16<0> E{KX, XW, nullptr, 0, 0, 1.f};
        pg8::gemm_phase<pg8::EpiBf16<0>, pg8::StaticOrder, PG8_ALIGN, PG8_SP2>(lds + RING_OFF, g, S, E); }
    {   pg8::Gemm g{WtKV + (size_t)XW * D, MN, XW, NMEM, D}; pg8::StaticOrder S; S.init(XW, NMEM, G, (bid + G - 144) % G);
        pg8::EpiBf16<0> E{VT, NMEM, nullptr, 0, 0, 1.f};
        pg8::gemm_phase<pg8::EpiBf16<0>, pg8::StaticOrder, PG8_ALIGN, PG8_SP2>(lds + RING_OFF, g, S, E); }
    xcd_barrier(bar);
#endif
#ifndef SK_P6
    {   LAS float* pq = (LAS float*)(lds + RING_OFF + wave * 2048);
        for (int it = gw; it < NTOK * XH; it += NGW) {
            const int h = it & 3; const size_t row = it >> 2; const int b = (int)(row / SEQ);
            { const v2u qv = *(const v2u*)(QX + row * XW + h * XDH + lane * 4); pq[lane * 4 + 0] = bflo(qv.x); pq[lane * 4 + 1] = bfhi(qv.x); pq[lane * 4 + 2] = bflo(qv.y); pq[lane * 4 + 3] = bfhi(qv.y); }
            LDS_WAIT(); asm volatile("" ::: "memory");
            float sc[4];
#pragma unroll
            for (int mi = 0; mi < 4; ++mi) { const int m = lane + 64 * mi; const bf16* kr = KX + ((size_t)b * MEML + m) * XW + h * XDH; float acc = 0.f;
                for (int d8 = 0; d8 < 32; ++d8) { const v4u kw = *(const v4u*)(kr + d8 * 8); const LAS float* qq = pq + d8 * 8;
                    acc += qq[0] * bflo(kw.x) + qq[1] * bfhi(kw.x) + qq[2] * bflo(kw.y) + qq[3] * bfhi(kw.y) + qq[4] * bflo(kw.z) + qq[5] * bfhi(kw.z) + qq[6] * bflo(kw.w) + qq[7] * bfhi(kw.w); }
                sc[mi] = acc * 0.0625f; }
            float mx = fmaxf(fmaxf(sc[0], sc[1]), fmaxf(sc[2], sc[3]));
#pragma unroll
            for (int o = 1; o < 64; o <<= 1) mx = fmaxf(mx, __shfl_xor(mx, o));
            float ex[4], es = 0.f;
#pragma unroll
            for (int mi = 0; mi < 4; ++mi) { ex[mi] = __expf(sc[mi] - mx); es += ex[mi]; }
            const float inv = 1.0f / wave_sum(es);
#pragma unroll
            for (int mi = 0; mi < 4; ++mi) pq[256 + lane + 64 * mi] = ex[mi] * inv;
            LDS_WAIT(); asm volatile("" ::: "memory");
            float od[4];
#pragma unroll
            for (int di = 0; di < 4; ++di) { const int d = lane * 4 + di; const bf16* vr = VT + ((size_t)h * XDH + d) * NMEM + b * MEML; float acc = 0.f;
                for (int m8 = 0; m8 < 32; ++m8) { const v4u vw = *(const v4u*)(vr + m8 * 8); const LAS float* pp = pq + 256 + m8 * 8;
                    acc += pp[0] * bflo(vw.x) + pp[1] * bfhi(vw.x) + pp[2] * bflo(vw.y) + pp[3] * bfhi(vw.y) + pp[4] * bflo(vw.z) + pp[5] * bfhi(vw.z) + pp[6] * bflo(vw.w) + pp[7] * bfhi(vw.w); }
                od[di] = acc; }
            v2u o; o.x = pk2(od[0], od[1]); o.y = pk2(od[2], od[3]); *(v2u*)(OX + row * XW + h * XDH + lane * 4) = o;
            LDS_WAIT(); asm volatile("" ::: "memory");
        }
    }
    xcd_barrier(bar);
#endif
#ifndef SK_P7
    {   pg8::Gemm g{OX, WtO, NTOK, D, XW}; pg8::StaticOrder S; S.init(NTOK, D, G, bid);
        pg8::EpiResid E{H, H, D};
        pg8::gemm_phase<pg8::EpiResid, pg8::StaticOrder, PG8_ALIGN, PG8_SP2>(lds + RING_OFF, g, S, E); }
    xcd_barrier(bar);
#endif
#ifndef SK_P7b
    for (int m = gw; m < NTOK; m += NGW) {
        const f32x4* xr = (const f32x4*)(H + (size_t)m * D) + lane; f32x4 v[16]; float ss = 0.f;
#pragma unroll
        for (int j = 0; j < 16; ++j) { v[j] = xr[64 * j]; ss += (v[j].x * v[j].x + v[j].y * v[j].y) + (v[j].z * v[j].z + v[j].w * v[j].w); }
        const float rs = rsqrtf(wave_sum(ss) * (1.f / D) + EPS);
        const f32x4* gr = (const f32x4*)g_moe + lane; v2u* o8 = (v2u*)(XN + (size_t)m * D) + lane;
#pragma unroll
        for (int j = 0; j < 16; ++j) { const f32x4 gg = gr[64 * j]; v[j] = v[j] * rs * gg; v2u o; o.x = pk2(v[j].x, v[j].y); o.y = pk2(v[j].z, v[j].w); o8[64 * j] = o; }
        int gi = 0; float gm = -3.0e38f, den = 0.f;
#pragma unroll 1
        for (int j = 0; j < 8; ++j) { const f32x4* wr_ = (const f32x4*)(WrT + (size_t)j * D) + lane; float acc = 0.f;
#pragma unroll
            for (int q = 0; q < 16; ++q) { const f32x4 w = wr_[64 * q]; acc += (v[q].x * w.x + v[q].y * w.y) + (v[q].z * w.z + v[q].w * w.w); }
            const float l = wave_sum(acc) + rgb[j];
            if (l > gm) { den = den * __expf(gm - l) + 1.0f; gm = l; gi = j; } else den += __expf(l - gm); }
        const float ggate = 1.0f / den;
        int i0 = 0, i1 = 0; float v0 = -3.0e38f, v1 = -3.0e38f;
#pragma unroll 1
        for (int p = 0; p < 8; ++p) { const f32x4* wr_ = (const f32x4*)(WrT + (size_t)(8 + gi * 8 + p) * D) + lane; float acc = 0.f;
#pragma unroll
            for (int q = 0; q < 16; ++q) { const f32x4 w = wr_[64 * q]; acc += (v[q].x * w.x + v[q].y * w.y) + (v[q].z * w.z + v[q].w * w.w); }
            const float l = wave_sum(acc) + reb[gi * 8 + p];
            if (l > v0) { v1 = v0; i1 = i0; v0 = l; i0 = p; } else if (l > v1) { v1 = l; i1 = p; } }
        const float e1 = __expf(v1 - v0), g0 = 1.0f / (1.0f + e1), g1 = e1 / (1.0f + e1);
        if (lane == 0) { EID[2 * m] = gi * 8 + i0; EID[2 * m + 1] = gi * 8 + i1; GATE[2 * m] = g0 * ggate; GATE[2 * m + 1] = g1 * ggate; }
    }
    xcd_barrier(bar);
#endif
#ifndef SK_P9
    {   LAS unsigned short* list = (LAS unsigned short*)(lds + LIST_OFF); LAS int* sc = (LAS int*)(lds + SC_OFF);
        for (int ui = 0; ; ++ui) {
            int un; if (G == 256) { if (ui >= 2) break; const int xcd = bid & 7, i = bid >> 3; un = ((xcd * 8 + ui * 4 + (i >> 3)) << 3) | (i & 7); } else { un = bid + ui * G; if (un >= NE * 8) break; }
            const int e = un >> 3, hs = un & 7; int off; __syncthreads();
            const int cnt = build_list16(EID, e, list, sc, tid, off);
            if (hs == 0) { for (int r = tid; r < cnt; r += NT) SLOTS[off + r] = (int)list[r]; if (tid == 0) { OFFCNT[2 * e] = off; OFFCNT[2 * e + 1] = cnt; } }
            const float* bsrc = ((tid & 63) < 32 ? wg : wu) + (size_t)e * D * FF + (size_t)(8 * wave) * FF + hs * 64 + ((2 * (tid & 63)) & 63);
            for (int row0 = 0; row0 < cnt; row0 += 384) {
                const int nrow = min(cnt - row0, 384), nmt = (nrow + 15) >> 4, nsl = max(0, (nmt - wave + 7) >> 3);
                unsigned aoff[6];
#pragma unroll
                for (int i = 0; i < 6; ++i) { const int r = min(row0 + (tid >> 3) + 64 * i, cnt - 1); aoff[i] = (unsigned)(list[r] >> 1) * (unsigned)D + (unsigned)((tid & 7) * 8); }
                f32x4 acc[3][8];
                moe_kloop(lds, tid, wave, lane, XN, aoff, bsrc, FF, D, nsl, acc);
                const int fr = lane & 15, fq = lane >> 4;
#pragma unroll
                for (int sl = 0; sl < 3; ++sl) if (sl < nsl) { const int r = row0 + (wave + 8 * sl) * 16 + fr;
                    if (r < cnt) { bf16* hp = HACT + (size_t)(off + r) * FF + hs * 64 + 4 * fq;
#pragma unroll
                        for (int nt = 0; nt < 4; ++nt) { const f32x4 gv = acc[sl][nt], uv = acc[sl][nt + 4]; v2u o; o.x = pk2(silu_f(gv[0]) * uv[0], silu_f(gv[1]) * uv[1]); o.y = pk2(silu_f(gv[2]) * uv[2], silu_f(gv[3]) * uv[3]);
                            *(v2u*)(hp + nt * 16) = o; } } }
            }
        }
    }
    xcd_barrier(bar);
    {   for (int ui = 0; ; ++ui) {
            int un; if (G == 256) { if (ui >= 2) break; const int xcd = bid & 7, i = bid >> 3; un = ((xcd * 8 + ui * 4 + (i >> 3)) << 3) | (i & 7); } else { un = bid + ui * G; if (un >= NE * 8) break; }
            const int e = un >> 3, c8 = un & 7; const int off = OFFCNT[2 * e], cnt = OFFCNT[2 * e + 1];
            for (int sub = 0; sub < 4; ++sub) {
                const int col0 = c8 * 512 + sub * 128;
                const float* bsrc = wd + (size_t)e * FF * D + (size_t)(8 * wave) * D + col0 + 2 * (tid & 63);
                for (int row0 = 0; row0 < cnt; row0 += 384) {
                    const int nrow = min(cnt - row0, 384), nmt = (nrow + 15) >> 4, nsl = max(0, (nmt - wave + 7) >> 3);
                    unsigned aoff[6];
#pragma unroll
                    for (int i = 0; i < 6; ++i) { const int r = min(row0 + (tid >> 3) + 64 * i, cnt - 1); aoff[i] = (unsigned)(off + r) * (unsigned)FF + (unsigned)((tid & 7) * 8); }
                    f32x4 acc[3][8];
                    moe_kloop(lds, tid, wave, lane, HACT, aoff, bsrc, D, FF, nsl, acc);
                    const int fr = lane & 15, fq = lane >> 4;
#pragma unroll
                    for (int sl = 0; sl < 3; ++sl) if (sl < nsl) { const int r = row0 + (wave + 8 * sl) * 16 + fr;
                        if (r < cnt) { const int slot = SLOTS[off + r]; const float gt = GATE[slot]; bf16* yp = Y + (size_t)slot * D + col0 + 4 * fq;
#pragma unroll
                            for (int nt = 0; nt < 8; ++nt) { const f32x4 v = acc[sl][nt]; v2u o; o.x = pk2(gt * v[0], gt * v[1]); o.y = pk2(gt * v[2], gt * v[3]); *(v2u*)(yp + nt * 16) = o; } } }
                }
            }
        }
    }
    xcd_barrier(bar);
#endif
#ifndef SK_P11
    for (int m = gw; m < NTOK; m += NGW) {
        const f32x4* xr = (const f32x4*)(H + (size_t)m * D) + lane; const v2u* y0 = (const v2u*)(Y + (size_t)(2 * m) * D) + lane; const v2u* y1 = (const v2u*)(Y + (size_t)(2 * m + 1) * D) + lane;
        f32x4 v[16]; float ss = 0.f;
#pragma unroll
        for (int j = 0; j < 16; ++j) { const v2u a0 = y0[64 * j], a1 = y1[64 * j]; f32x4 t = xr[64 * j];
            t.x = (t.x + bflo(a0.x)) + bflo(a1.x); t.y = (t.y + bfhi(a0.x)) + bfhi(a1.x); t.z = (t.z + bflo(a0.y)) + bflo(a1.y); t.w = (t.w + bfhi(a0.y)) + bfhi(a1.y);
            v[j] = t; ss += (t.x * t.x + t.y * t.y) + (t.z * t.z + t.w * t.w); }
        const float rs = rsqrtf(wave_sum(ss) * (1.f / D) + EPS);
        const f32x4* gr = (const f32x4*)g_fin + lane; f32x4* orow = (f32x4*)(out + (size_t)m * D) + lane;
#pragma unroll
        for (int j = 0; j < 16; ++j) orow[64 * j] = v[j] * rs * gr[64 * j];
    }
#endif
}

extern "C" void kernel_launch(void* const* d_in, const int* in_sizes, int n_in, void* d_out, int out_size, void* d_ws, size_t ws_size, hipStream_t stream) {
    static int grid = 0;
    if (grid == 0) {
        if (n_in != 25 || out_size != NTOK * D || ws_size < WS_END) { fprintf(stderr, "kernel_launch: unexpected shapes (n_in %d out %d ws %zu)\n", n_in, out_size, ws_size); grid = -1; return; }
        int dev = 0, cus = 0, per_cu = 0;
        if (hipGetDevice(&dev) != hipSuccess || hipDeviceGetAttribute(&cus, hipDeviceAttributeMultiprocessorCount, dev) != hipSuccess) { grid = -1; return; }
        if (hipFuncSetAttribute((const void*)mk_fwd, hipFuncAttributeMaxDynamicSharedMemorySize, LDS_BYTES) != hipSuccess) { fprintf(stderr, "kernel_launch: hipFuncSetAttribute failed\n"); grid = -1; return; }
        if (hipOccupancyMaxActiveBlocksPerMultiprocessor(&per_cu, (const void*)mk_fwd, NWAVES * 64, LDS_BYTES) != hipSuccess || per_cu < 1) { fprintf(stderr, "kernel_launch: occupancy query reports %d blocks per CU\n", per_cu); }
        (void)hipGetLastError();
        grid = cus;
    }
    if (grid < 0) return;
    if (hipMemsetAsync((char*)d_ws + WS_CTL, 0, CTL_ZERO_BYTES, stream) != hipSuccess) return;
    Args a{};
    for (int i = 0; i < 25; ++i) a.in[i] = d_in[i];
    a.out = (float*)d_out; a.ws = (unsigned char*)d_ws;
    hipLaunchKernelGGL(mk_fwd, dim3(grid), dim3(NWAVES * 64), LDS_BYTES, stream, a);
}
```

```cpp
#include <hip/hip_runtime.h>
#include <cstdio>
#include <cstdint>

#ifndef PG8_SP2
#define PG8_SP2 true
#endif
#ifndef PG8_ALIGN
#define PG8_ALIGN true
#endif
constexpr int NWAVES = 8, NT = 512;
constexpr int D = 4096, NB = 4, SEQ = 2048, NTOK = NB * SEQ, MEML = 256, NMEM = NB * MEML;
constexpr int RW = 2048, GMW = 2048, INC = 12288, RH = 8, RDH = 256, GG = 8, GCG = 256, CHK = 128;
constexpr int XH = 4, XDH = 256, XW = 1024;
constexpr int NE = 64, FF = 512, NSLOT = NTOK * 2;
constexpr float EPS = 1e-6f;
constexpr size_t MiB = 1u << 20;
constexpr size_t WS_CTL = 0, CTL_ZERO_BYTES = 1 * MiB;
constexpr size_t WS_WRT = 1 * MiB;
constexpr size_t WS_WIN = 3 * MiB;
constexpr size_t WS_WOUT = 99 * MiB;
constexpr size_t WS_WQ = 131 * MiB;
constexpr size_t WS_WKV = 139 * MiB;
constexpr size_t WS_WO = 155 * MiB;
constexpr size_t WS_XN = 163 * MiB;
constexpr size_t WS_MN = 227 * MiB;
constexpr size_t WS_COS = 235 * MiB, WS_SIN = 239 * MiB;
constexpr size_t WS_PROJ = 243 * MiB;
constexpr size_t WS_RET = 435 * MiB;
constexpr size_t WS_MIX = 467 * MiB;
constexpr size_t WS_H = 531 * MiB;
constexpr size_t WS_QX = 659 * MiB;
constexpr size_t WS_KVX = 675 * MiB;
constexpr size_t WS_OX = 679 * MiB;
constexpr size_t WS_EID = 695 * MiB;
constexpr size_t WS_HACT = 696 * MiB;
constexpr size_t WS_Y = 712 * MiB;
constexpr size_t WS_END = 840 * MiB;
constexpr int CW_TMO = 0, CW_CODE = 1, CW_BAR = 4096;
constexpr int RING_OFF = 0, RING_BYTES = 131072;
constexpr int LDSCTL_OFF = RING_BYTES, MISC_OFF = LDSCTL_OFF + 320;
constexpr int AUX_OFF = LDSCTL_OFF + 1024;
constexpr int LIST_OFF = AUX_OFF, SC_OFF = LIST_OFF + 16384;
constexpr int LDS_BYTES = 163840;

#define GAS __attribute__((address_space(1)))
#define LAS __attribute__((address_space(3)))
typedef unsigned short bf16;
typedef unsigned v4u __attribute__((ext_vector_type(4)));
typedef unsigned v2u __attribute__((ext_vector_type(2)));
typedef float f32x4 __attribute__((ext_vector_type(4)));
typedef short bf16x8 __attribute__((ext_vector_type(8)));
typedef GAS unsigned gu32;
#define RLX_AGENT __ATOMIC_RELAXED, __HIP_MEMORY_SCOPE_AGENT
#define LDS_WAIT() asm volatile("s_waitcnt lgkmcnt(0)" ::: "memory")
#define VM_WAIT() asm volatile("s_waitcnt vmcnt(0)" ::: "memory")
__device__ __forceinline__ unsigned f2bf(float f) { unsigned u = __builtin_bit_cast(unsigned, f); return (u + 0x7fffu + ((u >> 16) & 1u)) >> 16; }
__device__ __forceinline__ unsigned pk2(float lo, float hi) { return f2bf(lo) | (f2bf(hi) << 16); }
__device__ __forceinline__ float bf2f(unsigned b) { return __builtin_bit_cast(float, b << 16); }
__device__ __forceinline__ float bflo(unsigned w) { return __builtin_bit_cast(float, w << 16); }
__device__ __forceinline__ float bfhi(unsigned w) { return __builtin_bit_cast(float, w & 0xffff0000u); }
__device__ __forceinline__ float wave_sum(float v) {
#pragma unroll
    for (int o = 1; o < 64; o <<= 1) v += __shfl_xor(v, o);
    return v;
}
__device__ __forceinline__ float fast_sigmoid(float x) { return __builtin_amdgcn_rcpf(1.0f + __builtin_amdgcn_exp2f(-1.4426950408889634f * x)); }
__device__ __forceinline__ float gelu_tanh_f(float x) { return x * fast_sigmoid(1.5957691216057308f * (x + 0.044715f * x * x * x)); }
__device__ __forceinline__ float silu_f(float x) { return x * fast_sigmoid(x); }
namespace pg8 {
#define PG8_LAS __attribute__((address_space(3)))
typedef unsigned short bf16_t;
typedef short bf16x8 __attribute__((ext_vector_type(8)));
typedef float f32x4 __attribute__((ext_vector_type(4)));
typedef unsigned u32x4 __attribute__((ext_vector_type(4)));
constexpr int BM = 256, BK = 64, HALF = 128, HTB = HALF * BK * 2  , STAGE_BYTES = 8 * HTB, NXCD = 8, WGM = 8;

__host__ __device__ __forceinline__ int lds_byte(int r, int c) { const int st = (r >> 4) * 2 + (c >> 5), rr = r & 15, cc = c & 31, ob = rr * 64 + cc * 2; return st * 1024 + (ob ^ (((ob >> 9) & 1) << 5)); }
__host__ __device__ __forceinline__ void stage_rc(int b, int& R, int& C) { const int st = b / 1024, sb = b % 1024, swz = sb ^ (((sb >> 9) & 1) << 5); R = (st >> 1) * 16 + swz / 64; C = (st & 1) * 32 + (swz % 64) / 2; }
__host__ __device__ __forceinline__ int perm32(int rho) { const int n = rho >> 4, i = rho & 15; return 8 * (i >> 2) + 4 * n + (i & 3); }

struct Unit { int pm, pn; };
struct Gemm { const bf16_t* A; const bf16_t* Bt; int M, N, K; };

struct StaticOrder {
    int nM, nN, nwg, G, c;
    __host__ __device__ void init(int M, int N, int G_, int c_) { nM = M / BM; nN = N / BM; nwg = nM * nN; G = G_; c = c_; }
    __host__ __device__ bool next(int i, Unit& u) const {
        const long L = (long)i * G + c; if (L >= nwg) return false;
        int wgid = (int)L; { const int q = nwg / NXCD, r = nwg % NXCD, xcd = wgid % NXCD, off = wgid / NXCD; wgid = (xcd < r ? xcd * (q + 1) : r * (q + 1) + (xcd - r) * q) + off; }
        const int nig = WGM * nN, gid = wgid / nig, fm = gid * WGM, gsz = (nM - fm) < WGM ? (nM - fm) : WGM;
        u.pm = fm + ((wgid % nig) % gsz); u.pn = (wgid % nig) / gsz; return true;
    }
    __device__ __forceinline__ void a_ready(const Unit&) const {}
    __device__ __forceinline__ void done(const Unit&) const {}
};

__device__ __forceinline__ unsigned cvt_pk_bf16(float lo, float hi) { unsigned r; asm volatile("v_cvt_pk_bf16_f32 %0, %1, %2" : "=v"(r) : "v"(lo), "v"(hi)); return r; }
typedef float f32x2 __attribute__((ext_vector_type(2)));
__device__ __forceinline__ f32x2 gelu_pk(f32x2 v) {
    const f32x2 av = __builtin_elementwise_abs(v), d = av * 0.2316418882f + 1.0f;
    f32x2 t; t.x = __builtin_amdgcn_rcpf(d.x); t.y = __builtin_amdgcn_rcpf(d.y);
    f32x2 q = t * 0.5307027145f + (-0.7265760135f); q = q * t + 0.7107068705f; q = q * t + (-0.142248368f); q = q * t + 0.127414796f; q = q * t;
    const f32x2 s = (v * v) * (-0.72134752044f);
    f32x2 e; e.x = __builtin_amdgcn_exp2f(s.x); e.y = __builtin_amdgcn_exp2f(s.y);
    const f32x2 m = v * (q * e), r = v - m;
    f32x2 o; o.x = v.x < 0.f ? m.x : r.x; o.y = v.y < 0.f ? m.y : r.y; return o;
}

template <int ACT  > struct EpiBf16 {
    static constexpr bool PERM = true, AFTER_DRAIN = false; static_assert(ACT == 0 || ACT == 1, "EpiBf16: ACT is 0 (none) or 1 (gelu_pk)");
    bf16_t* O; int ldc; const float* bias; int split_cols; size_t split_stride; float scale0;
    __device__ __forceinline__ void operator()(const f32x4 (&acc)[2][2][4][2], const Unit& u, int wr, int wc, int fr, int fq) const {
        const int row0 = u.pm * BM + wr * 64 + fr; int colt = u.pn * BM; bf16_t* base = O;
        float sc = 1.f; if (split_cols) { const int t = colt / split_cols; base += (size_t)t * split_stride; colt -= t * split_cols; if (t == 0) sc = scale0; }
        const int col0 = colt + wc * 32 + 8 * fq, bcol0 = u.pn * BM + wc * 32 + 8 * fq;
        f32x4 bv[2][2];
#pragma unroll
        for (int bj = 0; bj < 2; ++bj)
#pragma unroll
            for (int n = 0; n < 2; ++n) bv[bj][n] = bias ? *(const f32x4*)(bias + bcol0 + bj * HALF + 4 * n) : (f32x4){0.f, 0.f, 0.f, 0.f};
#pragma unroll
        for (int ai = 0; ai < 2; ++ai)
#pragma unroll
            for (int m = 0; m < 4; ++m) { bf16_t* rowp = base + (size_t)(row0 + ai * HALF + m * 16) * ldc + col0;
#pragma unroll
                for (int bj = 0; bj < 2; ++bj) { f32x4 v0 = acc[ai][bj][m][0] + bv[bj][0], v1 = acc[ai][bj][m][1] + bv[bj][1];
                    if (ACT == 1) { f32x2 a = gelu_pk((f32x2){v0[0], v0[1]}), b = gelu_pk((f32x2){v0[2], v0[3]}), c = gelu_pk((f32x2){v1[0], v1[1]}), d = gelu_pk((f32x2){v1[2], v1[3]});
                        v0 = (f32x4){a.x, a.y, b.x, b.y}; v1 = (f32x4){c.x, c.y, d.x, d.y}; }
                    v0 = v0 * sc; v1 = v1 * sc; u32x4 w; w.x = cvt_pk_bf16(v0[0], v0[1]); w.y = cvt_pk_bf16(v0[2], v0[3]); w.z = cvt_pk_bf16(v1[0], v1[1]); w.w = cvt_pk_bf16(v1[2], v1[3]);
                    *(u32x4*)(rowp + bj * HALF) = w; } }
    }
};

struct EpiProj {
    static constexpr bool PERM = true, AFTER_DRAIN = false;
    bf16_t* O; const float* cs; const float* sn;
    __device__ __forceinline__ void operator()(const f32x4 (&acc)[2][2][4][2], const Unit& u, int wr, int wc, int fr, int fq) const {
        const int sec = u.pn >> 3;
        const int row0 = u.pm * BM + wr * 64 + fr, j0 = wc * 32 + 8 * fq, col0 = u.pn * BM + j0;
#pragma unroll
        for (int ai = 0; ai < 2; ++ai)
#pragma unroll
            for (int m = 0; m < 4; ++m) {
                const int row = row0 + ai * HALF + m * 16;
                f32x4 a0 = acc[ai][0][m][0], a1 = acc[ai][0][m][1], b0 = acc[ai][1][m][0], b1 = acc[ai][1][m][1];
                if (sec < 2) {
                    const float* cp = cs + (size_t)row * 128 + j0; const float* sp = sn + (size_t)row * 128 + j0;
                    const f32x4 c0 = *(const f32x4*)cp, c1 = *(const f32x4*)(cp + 4), s0 = *(const f32x4*)sp, s1 = *(const f32x4*)(sp + 4);
                    const float sc = sec ? 0.0625f : 1.0f;
                    const f32x4 t0 = (a0 * c0 - b0 * s0) * sc, t1 = (a1 * c1 - b1 * s1) * sc;
                    b0 = (a0 * s0 + b0 * c0) * sc; b1 = (a1 * s1 + b1 * c1) * sc; a0 = t0; a1 = t1;
                } else if (sec == 3) {
#pragma unroll
                    for (int j = 0; j < 4; ++j) { a0[j] = silu_f(a0[j]); a1[j] = silu_f(a1[j]); b0[j] = silu_f(b0[j]); b1[j] = silu_f(b1[j]); }
                } else if (sec >= 4) {
#pragma unroll
                    for (int j = 0; j < 4; ++j) { a0[j] = gelu_tanh_f(a0[j]); a1[j] = gelu_tanh_f(a1[j]); b0[j] = gelu_tanh_f(b0[j]); b1[j] = gelu_tanh_f(b1[j]); }
                }
                bf16_t* rowp = O + (size_t)row * 12288 + col0;
                u32x4 w; w.x = cvt_pk_bf16(a0[0], a0[1]); w.y = cvt_pk_bf16(a0[2], a0[3]); w.z = cvt_pk_bf16(a1[0], a1[1]); w.w = cvt_pk_bf16(a1[2], a1[3]);
                *(u32x4*)rowp = w;
                w.x = cvt_pk_bf16(b0[0], b0[1]); w.y = cvt_pk_bf16(b0[2], b0[3]); w.z = cvt_pk_bf16(b1[0], b1[1]); w.w = cvt_pk_bf16(b1[2], b1[3]);
                *(u32x4*)(rowp + HALF) = w;
            }
    }
};
struct EpiResid {
    static constexpr bool PERM = false, AFTER_DRAIN = false;
    const float* base; float* out; int ldc;
    __device__ __forceinline__ void operator()(const f32x4 (&acc)[2][2][4][2], const Unit& u, int wr, int wc, int fr, int fq) const {
        const int row0 = u.pm * BM + wr * 64 + fr, col0 = u.pn * BM + wc * 32 + 4 * fq;
#pragma unroll
        for (int ai = 0; ai < 2; ++ai)
#pragma unroll
            for (int m = 0; m < 4; ++m) { const size_t off = (size_t)(row0 + ai * HALF + m * 16) * ldc + col0;
#pragma unroll
                for (int bj = 0; bj < 2; ++bj)
#pragma unroll
                    for (int n = 0; n < 2; ++n) { const f32x4 bs = *(const f32x4*)(base + off + bj * HALF + n * 16); *(f32x4*)(out + off + bj * HALF + n * 16) = bs + acc[ai][bj][m][n]; } }
    }
};
template <class Epi, class Sched, bool ALIGN_EPI = false, bool SP2 = false>
__device__ __forceinline__ void gemm_phase(PG8_LAS unsigned char* lds, const Gemm g, const Sched& S, const Epi& E) {
    int tid = threadIdx.x; asm volatile("" : "+v"(tid));
    const int wid = __builtin_amdgcn_readfirstlane(tid >> 6), lane = tid & 63, wr = wid >> 2, wc = wid & 3, fr = lane & 15, fq = lane >> 4;
    const int K = g.K, nt = K / BK;
    unsigned voffA[2], voffB[2];
#pragma unroll
    for (int i = 0; i < 2; ++i) { int R, C; stage_rc(tid * 16 + i * 8192, R, C); const int Rb = Epi::PERM ? ((R & ~31) + perm32(R & 31)) : R;
        voffA[i] = (unsigned)(R * K + C) * 2u; voffB[i] = (unsigned)(Rb * K + C) * 2u; }
    const size_t kstep = (size_t)(BK * 2);
    const size_t hstep = (size_t)HALF * K * 2;
    const size_t tstep = 2 * hstep;
    const unsigned ldsw = (unsigned)wid * 1024u;
    const int aoff = lds_byte(wr * 64 + fr, fq * 8), boff = lds_byte(wc * 32 + fr, fq * 8);
#define PG8_SA(b, h) (((b) * 2 + (h)) * HTB)
#define PG8_SB(b, h) ((4 + (b) * 2 + (h)) * HTB)
#define PG8_STAGE(bufoff, gbase, voff) do { _Pragma("unroll") for (int _i = 0; _i < 2; ++_i) \
        __builtin_amdgcn_global_load_lds((const unsigned*)((const char*)(gbase) + (voff)[_i]), (PG8_LAS unsigned*)(lds + (bufoff) + ldsw + _i * 8192), 16, 0, 0); } while (0)
#define PG8_LDA(dst, b, h) do { _Pragma("unroll") for (int m = 0; m < 4; ++m) _Pragma("unroll") for (int k = 0; k < 2; ++k) dst[m][k] = *(const PG8_LAS bf16x8*)(lds + PG8_SA(b, h) + aoff + m * 2048 + k * 1024); } while (0)
#define PG8_LDB(dst, b, h) do { _Pragma("unroll") for (int n = 0; n < 2; ++n) _Pragma("unroll") for (int k = 0; k < 2; ++k) dst[n][k] = *(const PG8_LAS bf16x8*)(lds + PG8_SB(b, h) + boff + n * 2048 + k * 1024); } while (0)
#define PG8_MMA(ai, bj, At, Bt) do { __builtin_amdgcn_s_setprio(1); _Pragma("unroll") for (int m = 0; m < 4; ++m) _Pragma("unroll") for (int n = 0; n < 2; ++n) _Pragma("unroll") for (int k = 0; k < 2; ++k) \
        acc[ai][bj][m][n] = __builtin_amdgcn_mfma_f32_16x16x32_bf16(Bt[n][k], At[m][k], acc[ai][bj][m][n], 0, 0, 0); __builtin_amdgcn_s_setprio(0); } while (0)
#define PG8_WAIT_V(n) asm volatile("s_waitcnt vmcnt(" #n ")" ::: "memory")
#define PG8_WAIT_L(n) asm volatile("s_waitcnt lgkmcnt(" #n ")" ::: "memory")
#define PG8_BAR __builtin_amdgcn_s_barrier()
#define PG8_SCHED __builtin_amdgcn_sched_barrier(0)
    Unit cur, nxt; int ui = 0;
    if (!S.next(0, cur)) return;
    f32x4 acc[2][2][4][2];
#pragma unroll
    for (int a = 0; a < 2; ++a)
#pragma unroll
        for (int b = 0; b < 2; ++b)
#pragma unroll
            for (int m = 0; m < 4; ++m)
#pragma unroll
                for (int n = 0; n < 2; ++n) acc[a][b][m][n] = (f32x4){0.f, 0.f, 0.f, 0.f};
    bf16x8 At[4][2], B0[2][2], B1[2][2];
    const char* cA = (const char*)g.A + (size_t)cur.pm * tstep; const char* cB = (const char*)g.Bt + (size_t)cur.pn * tstep;
    S.a_ready(cur);
    if constexpr (SP2) {
        PG8_STAGE(PG8_SB(0, 0), cB, voffB); PG8_STAGE(PG8_SB(0, 1), cB + hstep, voffB); PG8_STAGE(PG8_SA(0, 0), cA, voffA); PG8_STAGE(PG8_SA(0, 1), cA + hstep, voffA);
        if (wr == 1) PG8_BAR;
        PG8_WAIT_V(2); PG8_BAR;
        PG8_STAGE(PG8_SB(1, 0), cB + kstep, voffB); PG8_STAGE(PG8_SA(1, 0), cA + kstep, voffA); PG8_STAGE(PG8_SB(1, 1), cB + hstep + kstep, voffB);
        PG8_WAIT_V(6); PG8_BAR;
    } else {
        PG8_STAGE(PG8_SB(0, 0), cB, voffB); PG8_STAGE(PG8_SA(0, 0), cA, voffA); PG8_STAGE(PG8_SB(0, 1), cB + hstep, voffB); PG8_STAGE(PG8_SA(0, 1), cA + hstep, voffA);
        if (wr == 1) PG8_BAR;
        PG8_WAIT_V(4); PG8_BAR;
        PG8_STAGE(PG8_SB(1, 0), cB + kstep, voffB); PG8_STAGE(PG8_SA(1, 0), cA + kstep, voffA); PG8_STAGE(PG8_SB(1, 1), cB + hstep + kstep, voffB);
        PG8_WAIT_V(6); PG8_BAR;
    }
    for (;;) {
        const bool has_next = S.next(ui + 1, nxt);
        const char* nA = has_next ? (const char*)g.A + (size_t)nxt.pm * tstep : cA; const char* nB = has_next ? (const char*)g.Bt + (size_t)nxt.pn * tstep : cB;
        for (int t = 0; t < nt; t += 2) {
            const bool last = (t == nt - 2);
            const char* a1 = cA + (size_t)(t + 1) * kstep;
            const char* a2 = last ? nA : cA + (size_t)(t + 2) * kstep; const char* b2 = last ? nB : cB + (size_t)(t + 2) * kstep;
            const char* a3 = a2 + kstep; const char* b3 = b2 + kstep;
            if (last && has_next) S.a_ready(nxt);
            if constexpr (SP2) {
            PG8_LDB(B0, 0, 0); PG8_LDB(B1, 0, 1); PG8_SCHED; PG8_LDA(At, 0, 0); PG8_STAGE(PG8_SA(1, 1), a1 + hstep, voffA);
            PG8_WAIT_V(8); PG8_WAIT_L(0); PG8_BAR; PG8_MMA(0, 0, At, B0); PG8_MMA(0, 1, At, B1); PG8_BAR; PG8_SCHED;
            PG8_LDA(At, 0, 1); PG8_STAGE(PG8_SB(0, 0), b2, voffB); PG8_STAGE(PG8_SB(0, 1), b2 + hstep, voffB); PG8_STAGE(PG8_SA(0, 0), a2, voffA);
            PG8_WAIT_V(8); PG8_WAIT_L(0); PG8_BAR; PG8_MMA(1, 0, At, B0); PG8_MMA(1, 1, At, B1); PG8_BAR; PG8_SCHED;
            PG8_LDB(B0, 1, 0); PG8_LDB(B1, 1, 1); PG8_SCHED; PG8_LDA(At, 1, 0); PG8_STAGE(PG8_SA(0, 1), a2 + hstep, voffA);
            PG8_WAIT_V(8); PG8_WAIT_L(0); PG8_BAR; PG8_MMA(0, 0, At, B0); PG8_MMA(0, 1, At, B1); PG8_BAR; PG8_SCHED;
            PG8_LDA(At, 1, 1); PG8_STAGE(PG8_SB(1, 0), b3, voffB); PG8_STAGE(PG8_SB(1, 1), b3 + hstep, voffB); PG8_STAGE(PG8_SA(1, 0), a3, voffA);
            PG8_WAIT_V(8); PG8_WAIT_L(0); PG8_BAR; PG8_MMA(1, 0, At, B0); PG8_MMA(1, 1, At, B1); PG8_BAR; PG8_SCHED;
            } else {
            PG8_LDB(B0, 0, 0); PG8_SCHED; PG8_LDA(At, 0, 0); PG8_STAGE(PG8_SA(1, 1), a1 + hstep, voffA);
            PG8_WAIT_L(8); PG8_BAR; PG8_WAIT_L(0); PG8_MMA(0, 0, At, B0); PG8_BAR; PG8_SCHED;
            PG8_LDB(B1, 0, 1); PG8_STAGE(PG8_SB(0, 0), b2, voffB);
            PG8_BAR; PG8_WAIT_L(0); PG8_MMA(0, 1, At, B1); PG8_BAR;
            PG8_LDA(At, 0, 1); PG8_STAGE(PG8_SA(0, 0), a2, voffA);
            PG8_BAR; PG8_WAIT_L(0); PG8_MMA(1, 0, At, B0); PG8_BAR; PG8_SCHED;
            PG8_STAGE(PG8_SB(0, 1), b2 + hstep, voffB);
            PG8_WAIT_V(6); PG8_BAR; PG8_MMA(1, 1, At, B1); PG8_BAR;
            PG8_LDB(B0, 1, 0); PG8_SCHED; PG8_LDA(At, 1, 0); PG8_STAGE(PG8_SA(0, 1), a2 + hstep, voffA);
            PG8_WAIT_L(8); PG8_BAR; PG8_WAIT_L(0); PG8_MMA(0, 0, At, B0); PG8_BAR; PG8_SCHED;
            PG8_LDB(B1, 1, 1); PG8_STAGE(PG8_SB(1, 0), b3, voffB);
            PG8_BAR; PG8_WAIT_L(0); PG8_MMA(0, 1, At, B1); PG8_BAR;
            PG8_LDA(At, 1, 1); PG8_STAGE(PG8_SA(1, 0), a3, voffA);
            PG8_BAR; PG8_WAIT_L(0); PG8_MMA(1, 0, At, B0); PG8_BAR; PG8_SCHED;
            PG8_STAGE(PG8_SB(1, 1), b3 + hstep, voffB);
            PG8_WAIT_V(6); PG8_BAR; PG8_MMA(1, 1, At, B1); PG8_BAR;
            }
        }
        if constexpr (ALIGN_EPI) { if (wr == 0) PG8_BAR; }
        if constexpr (!Epi::AFTER_DRAIN) { E(acc, cur, wr, wc, fr, fq); S.done(cur); }
        if (!has_next) break;
#pragma unroll
        for (int a = 0; a < 2; ++a)
#pragma unroll
            for (int b = 0; b < 2; ++b)
#pragma unroll
                for (int m = 0; m < 4; ++m)
#pragma unroll
                    for (int n = 0; n < 2; ++n) acc[a][b][m][n] = (f32x4){0.f, 0.f, 0.f, 0.f};
        cur = nxt; cA = nA; cB = nB; ++ui;
        if constexpr (ALIGN_EPI) { if (wr == 1) PG8_BAR; }
    }
    PG8_WAIT_V(0);
    if constexpr (!ALIGN_EPI) { if (wr == 0) PG8_BAR; }
    PG8_BAR;
    if constexpr (Epi::AFTER_DRAIN) { E.fused(acc, cur, wr, wc, fr, fq, lds, wid, lane); S.done(cur); }
#undef PG8_SA
#undef PG8_SB
#undef PG8_STAGE
#undef PG8_LDA
#undef PG8_LDB
#undef PG8_MMA
#undef PG8_WAIT_V
#undef PG8_WAIT_L
#undef PG8_BAR
#undef PG8_SCHED
}
}
#define XB_TMO      128
#define XB_XCNT(j)  (256  + 64 * (j))
#define XB_XSUB(j)  (1280 + 64 * (j))
#define XB_XGEN(j)  (2304 + 64 * (j))
#define XB_TOP      3328
#define XB_TOPGEN   3392
#define XCD_BAR_WORDS 3456
#define XB_SPIN_CAP (1u << 18)

__device__ __forceinline__ unsigned xb_ld(unsigned* p)              { return __hip_atomic_load(p, __ATOMIC_RELAXED, __HIP_MEMORY_SCOPE_AGENT); }
__device__ __forceinline__ unsigned xb_add(unsigned* p, unsigned v) { return __hip_atomic_fetch_add(p, v, __ATOMIC_RELAXED, __HIP_MEMORY_SCOPE_AGENT); }
__device__ __forceinline__ unsigned xb_xcc_id() { return (unsigned)__builtin_amdgcn_s_getreg((3 << 11) | 20) & 0xFu; }
#define XB_SPIN(cond, bar) do { unsigned _sp = 0; while (cond) { __builtin_amdgcn_s_sleep(1); \
    if ((++_sp & 255u) == 0u) { if (xb_ld(&(bar)[XB_TMO])) break; if (_sp > XB_SPIN_CAP) { atomicAdd(&(bar)[XB_TMO], 1u); break; } } } } while (0)

struct XcdBarrier {
    unsigned* bar; unsigned x;
    volatile LAS unsigned* st;
};

__device__ __forceinline__ XcdBarrier xcd_barrier_post(unsigned* bar, volatile LAS unsigned* st) {
    XcdBarrier b; b.bar = bar; b.x = xb_xcc_id(); b.st = st;
    if (threadIdx.x == 0) (void)xb_add(&bar[XB_XCNT(b.x)], 1u);
    return b;
}
__device__ __forceinline__ void xcd_barrier_complete(unsigned* bar, unsigned x, unsigned& nloc, unsigned& nx) {
    const unsigned G = gridDim.x * gridDim.y * gridDim.z;
    unsigned sum, cnt, mine, sp = 0u;
    for (;;) {
        sum = 0u; cnt = 0u; mine = 0u;
#pragma unroll
        for (unsigned j = 0; j < 16; ++j) { const unsigned c = xb_ld(&bar[XB_XCNT(j)]); sum += c; cnt += (c > 0u) ? 1u : 0u; mine = (j == x) ? c : mine; }
        if (sum == G) break;
        __builtin_amdgcn_s_sleep(1);
        if ((++sp & 255u) == 0u) { if (xb_ld(&bar[XB_TMO])) break; if (sp > XB_SPIN_CAP) { atomicAdd(&bar[XB_TMO], 1u); break; } }
    }
    nloc = mine > 0u ? mine : 1u; nx = cnt > 0u ? cnt : 1u;
}

__device__ __forceinline__ void xcd_barrier(const XcdBarrier& b) {
    asm volatile("s_waitcnt vmcnt(0)" ::: "memory");
    __syncthreads();
    if (threadIdx.x == 0) {
        unsigned* bar = b.bar;
        __builtin_amdgcn_s_waitcnt(0);
        unsigned nloc = b.st[0], nx = b.st[1];
        if (nloc == 0u) { xcd_barrier_complete(bar, b.x, nloc, nx); b.st[0] = nloc; b.st[1] = nx; }
        const unsigned old = xb_add(&bar[XB_XSUB(b.x)], 1u);
        const unsigned gen = old / nloc;
        if (old + 1u == (gen + 1u) * nloc) {
            __builtin_amdgcn_fence(__ATOMIC_RELEASE, "agent");
            asm volatile("s_waitcnt vmcnt(0)" ::: "memory");
            const unsigned og = xb_add(&bar[XB_TOP], 1u);
            const unsigned tg = og / nx;
            if (og + 1u == (tg + 1u) * nx) xb_add(&bar[XB_TOPGEN], 1u);
            else XB_SPIN(xb_ld(&bar[XB_TOPGEN]) == tg, bar);
            __builtin_amdgcn_fence(__ATOMIC_ACQUIRE, "agent");
            xb_add(&bar[XB_XGEN(b.x)], 1u);
            asm volatile("s_waitcnt vmcnt(0)" ::: "memory");
        } else {
            XB_SPIN(xb_ld(&bar[XB_XGEN(b.x)]) == gen, bar);
            __builtin_amdgcn_fence(__ATOMIC_ACQUIRE, "agent");
            asm volatile("s_waitcnt vmcnt(0)" ::: "memory");
        }
    }
    __syncthreads();
}


__device__ __forceinline__ void p0_transpose_item(const float* W, int K, int N, bf16* WT, LAS float* scr, int item, int lane) {
    const int nblk = N / 32, kb = item / nblk, nb = item % nblk, k0 = 64 * kb, n0 = 32 * nb;
#pragma unroll 8
    for (int i = 0; i < 32; ++i) { const int kk = 2 * i + (lane >> 5); scr[kk * 33 + (lane & 31)] = W[(size_t)(k0 + kk) * N + n0 + (lane & 31)]; }
    LDS_WAIT(); asm volatile("" ::: "memory");
    const int c = lane & 7;
#pragma unroll
    for (int j = 0; j < 4; ++j) { const int n = (lane >> 3) + 8 * j; const LAS float* s = scr + (8 * c) * 33 + n;
        v4u o; o.x = pk2(s[0 * 33], s[1 * 33]); o.y = pk2(s[2 * 33], s[3 * 33]); o.z = pk2(s[4 * 33], s[5 * 33]); o.w = pk2(s[6 * 33], s[7 * 33]);
        *(v4u*)(WT + (size_t)(n0 + n) * K + k0 + 8 * c) = o; }
    LDS_WAIT(); asm volatile("" ::: "memory");
}
__device__ __forceinline__ void rms_row_to_bf16(const float* xrow, const float* g, bf16* orow, int lane) {
    const f32x4* xr = (const f32x4*)xrow + lane; f32x4 v[16]; float ss = 0.f;
#pragma unroll
    for (int j = 0; j < 16; ++j) { v[j] = xr[64 * j]; ss += (v[j].x * v[j].x + v[j].y * v[j].y) + (v[j].z * v[j].z + v[j].w * v[j].w); }
    const float rs = rsqrtf(wave_sum(ss) * (1.f / D) + EPS);
    const f32x4* gr = (const f32x4*)g + lane; v2u* o8 = (v2u*)orow + lane;
#pragma unroll
    for (int j = 0; j < 16; ++j) { const f32x4 gg = gr[64 * j]; v2u o; o.x = pk2(v[j].x * rs * gg.x, v[j].y * rs * gg.y); o.y = pk2(v[j].z * rs * gg.z, v[j].w * rs * gg.w); o8[64 * j] = o; }
}
__device__ __forceinline__ int block_excl_scan(int v, LAS int* sc, int tid, int& tot) {
    const int lane = tid & 63, w = tid >> 6; int x = v;
#pragma unroll
    for (int o = 1; o < 64; o <<= 1) { const int y = __shfl_up(x, o); if (lane >= o) x += y; }
    __syncthreads();
    if (lane == 63) sc[w] = x;
    __syncthreads();
    int base = 0, t = 0;
#pragma unroll
    for (int i = 0; i < 8; ++i) { const int s = sc[i]; if (i < w) base += s; t += s; }
    tot = t; return base + x - v;
}
__device__ __forceinline__ int build_list(const int* eid, int e, LAS int* list, LAS int* sc, int tid, int& off) {
    const int4* p = (const int4*)(eid + 32 * tid); unsigned mask = 0u; int cm = 0, cl = 0;
#pragma unroll
    for (int i = 0; i < 8; ++i) { const int4 v = p[i];
        if (v.x == e) { mask |= 1u << (4 * i); ++cm; } if (v.y == e) { mask |= 2u << (4 * i); ++cm; } if (v.z == e) { mask |= 4u << (4 * i); ++cm; } if (v.w == e) { mask |= 8u << (4 * i); ++cm; }
        cl += (v.x < e) + (v.y < e) + (v.z < e) + (v.w < e); }
    int tot; int pos = block_excl_scan(cm, sc, tid, tot);
    int tl; (void)block_excl_scan(cl, sc + 8, tid, tl); off = tl;
    while (mask) { const int b = __builtin_ctz(mask); mask &= mask - 1u; list[pos++] = 32 * tid + b; }
    __syncthreads();
    return tot;
}


__device__ __forceinline__ int build_list16(const int* eid, int e, LAS unsigned short* list, LAS int* sc, int tid, int& off) {
    const int4* p = (const int4*)(eid + 32 * tid); unsigned mask = 0u; int cm = 0, cl = 0;
#pragma unroll
    for (int i = 0; i < 8; ++i) { const int4 v = p[i];
        if (v.x == e) { mask |= 1u << (4 * i); ++cm; } if (v.y == e) { mask |= 2u << (4 * i); ++cm; } if (v.z == e) { mask |= 4u << (4 * i); ++cm; } if (v.w == e) { mask |= 8u << (4 * i); ++cm; }
        cl += (v.x < e) + (v.y < e) + (v.z < e) + (v.w < e); }
    int tot; int pos = block_excl_scan(cm, sc, tid, tot);
    int tl; (void)block_excl_scan(cl, sc + 8, tid, tl); off = tl;
    while (mask) { const int b = __builtin_ctz(mask); mask &= mask - 1u; list[pos++] = (unsigned short)(32 * tid + b); }
    __syncthreads();
    return tot;
}
__device__ __forceinline__ unsigned cvtpk(float lo, float hi) { unsigned r; asm("v_cvt_pk_bf16_f32 %0, %1, %2" : "=v"(r) : "v"(lo), "v"(hi)); return r; }
typedef float f32x2g __attribute__((ext_vector_type(2)));
typedef short s16x4 __attribute__((ext_vector_type(4)));
__device__ __forceinline__ void moe_kloop(LAS unsigned char* lds, int tid, int wave, int lane, const bf16* Asrc, const unsigned (&aoff)[6], const float* bsrc, int ldb, int K, int nsl, f32x4 (&acc)[3][8]) {
    const int fr = lane & 15, fq = lane >> 4, swz = fr & 7, kc_a = tid & 7, ra = tid >> 3, n2 = tid & 63, kc_b = wave;
    const unsigned a_wr = (unsigned)(ra * 128 + ((kc_a ^ (ra & 7)) << 4));
    const unsigned b_wr0 = 49152u + (unsigned)((2 * n2) * 128 + ((kc_b ^ ((2 * n2) & 7)) << 4)), b_wr1 = 49152u + (unsigned)((2 * n2 + 1) * 128 + ((kc_b ^ ((2 * n2 + 1) & 7)) << 4));
    const unsigned a_rd = (unsigned)((wave * 16 + fr) * 128), b_rd = 49152u + (unsigned)(fr * 128);
#pragma unroll
    for (int sl = 0; sl < 3; ++sl)
#pragma unroll
        for (int nt = 0; nt < 8; ++nt) acc[sl][nt] = (f32x4){0.f, 0.f, 0.f, 0.f};
    v4u areg[6]; f32x2g breg[8];
#define MOE_LOAD(k0) do { _Pragma("unroll") for (int i_ = 0; i_ < 6; ++i_) areg[i_] = *(const v4u*)(Asrc + aoff[i_] + (k0)); \
        _Pragma("unroll") for (int i_ = 0; i_ < 8; ++i_) breg[i_] = __builtin_nontemporal_load((const f32x2g*)(bsrc + (size_t)((k0) + i_) * ldb)); } while (0)
#define MOE_STORE(bo) do { _Pragma("unroll") for (int i_ = 0; i_ < 6; ++i_) *(LAS v4u*)(lds + (bo) + a_wr + i_ * 8192) = areg[i_]; \
        v4u w_; w_.x = cvtpk(breg[0].x, breg[1].x); w_.y = cvtpk(breg[2].x, breg[3].x); w_.z = cvtpk(breg[4].x, breg[5].x); w_.w = cvtpk(breg[6].x, breg[7].x); *(LAS v4u*)(lds + (bo) + b_wr0) = w_; \
        w_.x = cvtpk(breg[0].y, breg[1].y); w_.y = cvtpk(breg[2].y, breg[3].y); w_.z = cvtpk(breg[4].y, breg[5].y); w_.w = cvtpk(breg[6].y, breg[7].y); *(LAS v4u*)(lds + (bo) + b_wr1) = w_; } while (0)
#define MOE_COMPUTE(bo) do { _Pragma("unroll 1") for (int ks_ = 0; ks_ < 2; ++ks_) { const unsigned xk_ = (unsigned)(((4 * ks_ + fq) ^ swz) << 4); \
        _Pragma("unroll") for (int hf_ = 0; hf_ < 2; ++hf_) { bf16x8 bfr_[4]; \
        _Pragma("unroll") for (int nt_ = 0; nt_ < 4; ++nt_) bfr_[nt_] = *(const LAS bf16x8*)(lds + (bo) + b_rd + (hf_ * 4 + nt_) * 2048 + xk_); \
        _Pragma("unroll") for (int sl_ = 0; sl_ < 3; ++sl_) if (sl_ < nsl) { const bf16x8 af_ = *(const LAS bf16x8*)(lds + (bo) + a_rd + sl_ * 16384 + xk_); \
            _Pragma("unroll") for (int nt_ = 0; nt_ < 4; ++nt_) acc[sl_][hf_ * 4 + nt_] = __builtin_amdgcn_mfma_f32_16x16x32_bf16(bfr_[nt_], af_, acc[sl_][hf_ * 4 + nt_], 0, 0, 0); } } } } while (0)
    __syncthreads();
    MOE_LOAD(0); MOE_STORE(0u); __syncthreads();
    const int S = K >> 6;
    for (int s = 0; s < S; ++s) {
        const unsigned cur = (unsigned)(s & 1) * 65536u, nxt = 65536u - cur;
        if (s + 1 < S) MOE_LOAD((s + 1) * 64);
        MOE_COMPUTE(cur);
        if (s + 1 < S) MOE_STORE(nxt);
        __syncthreads();
    }
#undef MOE_LOAD
#undef MOE_STORE
#undef MOE_COMPUTE
}

struct Args { const void* in[25]; float* out; unsigned char* ws; };
#define PTRS() const __attribute__((address_space(4))) Args* K_ = (const __attribute__((address_space(4))) Args*)__builtin_amdgcn_kernarg_segment_ptr(); asm volatile("" : "+s"(K_)); \
    int tid = threadIdx.x; asm volatile("" : "+v"(tid)); const int lane = tid & 63, wave = __builtin_amdgcn_readfirstlane(tid >> 6); \
    const int G = gridDim.x, bid = blockIdx.x, gw = bid * NWAVES + wave, NGW = G * NWAVES, gtid = bid * NT + tid, NGT = G * NT; (void)lane; (void)gw; (void)NGW; (void)gtid; (void)NGT; \
    unsigned char* ws = K_->ws; \
    const float* x = (const float*)K_->in[0]; const float* mem = (const float*)K_->in[1]; const int* pos = (const int*)K_->in[2]; \
    const float* g_mix = (const float*)K_->in[3]; const float* w_in = (const float*)K_->in[4]; const float* ret_g = (const float*)K_->in[5]; \
    const float* ln_g = (const float*)K_->in[6]; const float* ln_b = (const float*)K_->in[7]; const float* gm_ws = (const float*)K_->in[8]; const float* gm_bs = (const float*)K_->in[9]; \
    const float* w_out = (const float*)K_->in[10]; const float* g_xa = (const float*)K_->in[11]; const float* g_mem = (const float*)K_->in[12]; \
    const float* wq = (const float*)K_->in[13]; const float* wkv = (const float*)K_->in[14]; const float* wo = (const float*)K_->in[15]; \
    const float* g_moe = (const float*)K_->in[16]; const float* rgw = (const float*)K_->in[17]; const float* rgb = (const float*)K_->in[18]; \
    const float* rew = (const float*)K_->in[19]; const float* reb = (const float*)K_->in[20]; \
    const float* wg = (const float*)K_->in[21]; const float* wu = (const float*)K_->in[22]; const float* wd = (const float*)K_->in[23]; const float* g_fin = (const float*)K_->in[24]; \
    float* out = K_->out; \
    float* WrT = (float*)(ws + WS_WRT); \
    bf16* WtIn = (bf16*)(ws + WS_WIN); bf16* WtOut = (bf16*)(ws + WS_WOUT); bf16* WtQ = (bf16*)(ws + WS_WQ); bf16* WtKV = (bf16*)(ws + WS_WKV); bf16* WtO = (bf16*)(ws + WS_WO); \
    bf16* XN = (bf16*)(ws + WS_XN); bf16* MN = (bf16*)(ws + WS_MN); float* COS = (float*)(ws + WS_COS); float* SIN = (float*)(ws + WS_SIN); \
    bf16* PROJ = (bf16*)(ws + WS_PROJ); bf16* RET = (bf16*)(ws + WS_RET); bf16* MIX = (bf16*)(ws + WS_MIX); float* H = (float*)(ws + WS_H); \
    bf16* QX = (bf16*)(ws + WS_QX); bf16* KX = (bf16*)(ws + WS_KVX); bf16* VT = KX + (size_t)NMEM * XW; bf16* OX = (bf16*)(ws + WS_OX); \
    int* EID = (int*)(ws + WS_EID); float* GATE = (float*)(ws + WS_EID + 65536); int* SLOTS = (int*)(ws + WS_EID + 131072); int* OFFCNT = (int*)(ws + WS_EID + 196608); \
    bf16* HACT = (bf16*)(ws + WS_HACT); bf16* Y = (bf16*)(ws + WS_Y);
__global__ void __launch_bounds__(NWAVES * 64, 2) mk_fwd(Args a) {
    extern __shared__ __attribute__((aligned(16))) unsigned char lds_raw[];
    LAS unsigned char* lds = (LAS unsigned char*)lds_raw;
    const int tid0 = threadIdx.x;
    for (int u = tid0; u < (LDS_BYTES - LDSCTL_OFF) / 4; u += NT) ((LAS unsigned*)(lds + LDSCTL_OFF))[u] = 0u;
    __syncthreads();
    volatile LAS unsigned* MISC = (volatile LAS unsigned*)(lds + MISC_OFF);
    XcdBarrier bar; { PTRS(); bar = xcd_barrier_post((unsigned*)(ws + WS_CTL) + CW_BAR, MISC + 8); }

#ifndef SK_P0
    { PTRS();
    {
        LAS float* scr = (LAS float*)(lds + RING_OFF + wave * 16384);
        constexpr int I_IN = (D / 64) * (INC / 32), I_OUT = (D / 64) * (D / 32), I_Q = (D / 64) * (XW / 32), I_KV = (D / 64) * (2 * XW / 32), I_O = (XW / 64) * (D / 32);
        constexpr int NITEMS = I_IN + I_OUT + I_Q + I_KV + I_O;
        for (int it = gw; it < NITEMS; it += NGW) {
            int r = it;
            if (r < I_IN) { p0_transpose_item(w_in, D, INC, WtIn, scr, r, lane); continue; } r -= I_IN;
            if (r < I_OUT) { p0_transpose_item(w_out, D, D, WtOut, scr, r, lane); continue; } r -= I_OUT;
            if (r < I_Q) { p0_transpose_item(wq, D, XW, WtQ, scr, r, lane); continue; } r -= I_Q;
            if (r < I_KV) { p0_transpose_item(wkv, D, 2 * XW, WtKV, scr, r, lane); continue; } r -= I_KV;
            p0_transpose_item(wo, XW, D, WtO, scr, r, lane);
        }
        for (int i = gtid; i < 72 * D; i += NGT) { const int j = i >> 12, k = i & (D - 1); WrT[i] = j < 8 ? rgw[(size_t)k * 8 + j] : rew[(size_t)k * 64 + (j - 8)]; }
        for (int m = gw; m < NTOK; m += NGW) rms_row_to_bf16(x + (size_t)m * D, g_mix, XN + (size_t)m * D, lane);
        for (int m = gw; m < NMEM; m += NGW) rms_row_to_bf16(mem + (size_t)m * D, g_mem, MN + (size_t)m * D, lane);
        for (int i = gtid; i < NTOK * 128; i += NGT) { const int j = i & 127, row = i >> 7; const float inv = powf(10000.0f, -(float)(2 * j) / 256.0f); const float ang = (float)pos[row] * inv; COS[i] = cosf(ang); SIN[i] = sinf(ang); }
    }
    xcd_barrier(bar);

    }
#endif
#ifndef SK_P1
    { PTRS();
    {   pg8::Gemm g{XN, WtIn, NTOK, INC, D}; pg8::StaticOrder S; S.init(NTOK, INC, G, bid);
        pg8::EpiProj E{PROJ, COS, SIN};
        pg8::gemm_phase<pg8::EpiProj, pg8::StaticOrder, PG8_ALIGN, PG8_SP2>(lds + RING_OFF, g, S, E); }
    xcd_barrier(bar);

    }
#endif
#ifndef SK_P2
    { PTRS();
    {
        constexpr int KT_OFF = 0, VT_OFF = 65536, VS_OFF = VT_OFF + 8704, ST_OFF = VS_OFF + 8704;
        const int fr = lane & 15, fq = lane >> 4, qt = wave < 4 ? wave : 11 - wave;
        const int kswz = ((fr & 3) << 2) | ((fr >> 2) & 3);
        for (int ui = 0; ; ++ui) {
            int vb; if (G == 256) { if (ui >= 1) break; vb = (((bid & 7) * 4 + (bid >> 6)) << 3) | ((bid >> 3) & 7); } else { vb = bid + ui * G; if (vb >= NB * RH * 8) break; }
            const int es = vb & 7, h = (vb >> 3) & 7, b = vb >> 6;
            const float l2g = log2f(1.0f - exp2f(-5.0f - (float)h));
            float An[8], Br[4], rsc[4];
#pragma unroll
            for (int nt = 0; nt < 8; ++nt) An[nt] = exp2f(16.0f * (float)(qt - nt) * l2g);
#pragma unroll
            for (int r = 0; r < 4; ++r) { Br[r] = exp2f((float)(fr - 4 * fq - r) * l2g); rsc[r] = exp2f((float)(16 * qt + 4 * fq + r + 1) * l2g); }
            const float cdec = exp2f(128.0f * l2g);
            const float vsc0 = exp2f((float)(127 - (tid >> 3)) * l2g), vsc1 = exp2f((float)(127 - 64 - (tid >> 3)) * l2g);
            f32x4 st[2][2];
#pragma unroll
            for (int et = 0; et < 2; ++et)
#pragma unroll
                for (int dt = 0; dt < 2; ++dt) st[et][dt] = (f32x4){0.f, 0.f, 0.f, 0.f};
            __syncthreads();
            { const v4u z = {0u, 0u, 0u, 0u}; *(LAS v4u*)(lds + ST_OFF + tid * 32) = z; *(LAS v4u*)(lds + ST_OFF + tid * 32 + 16) = z; }
            for (int c = 0; c < SEQ / CHK; ++c) {
                const size_t tok0 = (size_t)b * SEQ + (size_t)c * CHK;
                {
                    const int ch32 = tid & 31, rb = tid >> 5; const bf16* src = PROJ + (tok0 + rb) * INC + RW + h * RDH + ch32 * 8;
                    const unsigned woff = (unsigned)((ch32 >> 4) * 32768 + 256 * rb + 16 * ((ch32 & 15) ^ (((rb & 3) << 2) | ((rb >> 2) & 3))));
                    v4u kv[8];
#pragma unroll
                    for (int i = 0; i < 8; ++i) kv[i] = *(const v4u*)(src + (size_t)(16 * i) * INC);
#pragma unroll
                    for (int i = 0; i < 8; ++i) *(LAS v4u*)(lds + KT_OFF + woff + i * 4096) = kv[i];
                }
                {
                    const int eg = tid & 7, tk = tid >> 3;
#pragma unroll
                    for (int i = 0; i < 2; ++i) { const v2u vv = *(const v2u*)(PROJ + (tok0 + tk + 64 * i) * INC + 2 * RW + h * RDH + es * 32 + eg * 4); const float sc = i ? vsc1 : vsc0;
                        LAS bf16* vt = (LAS bf16*)(lds + VT_OFF) + (4 * eg) * 136 + tk + 64 * i; LAS bf16* vs = (LAS bf16*)(lds + VS_OFF) + (4 * eg) * 136 + tk + 64 * i;
                        vt[0] = (bf16)(vv.x & 0xffffu); vt[136] = (bf16)(vv.x >> 16); vt[272] = (bf16)(vv.y & 0xffffu); vt[408] = (bf16)(vv.y >> 16);
                        vs[0] = (bf16)f2bf(bflo(vv.x) * sc); vs[136] = (bf16)f2bf(bfhi(vv.x) * sc); vs[272] = (bf16)f2bf(bflo(vv.y) * sc); vs[408] = (bf16)f2bf(bfhi(vv.y) * sc); }
                }
                bf16x8 qf[8];
                { const bf16* qsrc = PROJ + (tok0 + 16 * qt + fr) * INC + h * RDH + 8 * fq;
#pragma unroll
                  for (int s8 = 0; s8 < 8; ++s8) qf[s8] = *(const bf16x8*)(qsrc + 32 * s8); }
                __syncthreads();
                v4u pk[4];
#pragma unroll
                for (int s2 = 0; s2 < 4; ++s2) { v4u pw = {0u, 0u, 0u, 0u};
#pragma unroll
                    for (int hh = 0; hh < 2; ++hh) { const int nt = 2 * s2 + hh;
                        if (nt <= qt) { f32x4 a = {0.f, 0.f, 0.f, 0.f};
#pragma unroll
                            for (int s8 = 0; s8 < 8; ++s8) { const bf16x8 kf = *(const LAS bf16x8*)(lds + KT_OFF + (s8 >> 2) * 32768 + 256 * (16 * nt + fr) + 16 * ((4 * (s8 & 3) + fq) ^ kswz));
                                a = __builtin_amdgcn_mfma_f32_16x16x32_bf16(kf, qf[s8], a, 0, 0, 0); }
                            float p0 = a[0] * An[nt] * Br[0], p1 = a[1] * An[nt] * Br[1], p2 = a[2] * An[nt] * Br[2], p3 = a[3] * An[nt] * Br[3];
                            if (nt == qt) { const int dq = fr - 4 * fq; p0 = dq >= 0 ? p0 : 0.f; p1 = dq >= 1 ? p1 : 0.f; p2 = dq >= 2 ? p2 : 0.f; p3 = dq >= 3 ? p3 : 0.f; }
                            if (hh == 0) { pw.x = cvtpk(p0, p1); pw.y = cvtpk(p2, p3); } else { pw.z = cvtpk(p0, p1); pw.w = cvtpk(p2, p3); } } }
                    pk[s2] = pw; }
                f32x4 oi[2], oc[2];
#pragma unroll
                for (int et = 0; et < 2; ++et) { oi[et] = (f32x4){0.f, 0.f, 0.f, 0.f}; oc[et] = (f32x4){0.f, 0.f, 0.f, 0.f}; }
#pragma unroll
                for (int s2 = 0; s2 < 4; ++s2) if (2 * s2 <= qt) {
#pragma unroll
                    for (int et = 0; et < 2; ++et) { const LAS unsigned char* vp = lds + VT_OFF + (16 * et + fr) * 272 + (32 * s2 + 4 * fq) * 2;
                        const v2u lo = *(const LAS v2u*)vp, hi = *(const LAS v2u*)(vp + 32); const v4u vw = {lo.x, lo.y, hi.x, hi.y};
                        oi[et] = __builtin_amdgcn_mfma_f32_16x16x32_bf16(__builtin_bit_cast(bf16x8, pk[s2]), __builtin_bit_cast(bf16x8, vw), oi[et], 0, 0, 0); } }
#pragma unroll
                for (int s8 = 0; s8 < 8; ++s8)
#pragma unroll
                    for (int et = 0; et < 2; ++et) { const bf16x8 sf = *(const LAS bf16x8*)(lds + ST_OFF + (16 * et + fr) * 512 + (((4 * s8 + fq) ^ fr) << 4));
                        oc[et] = __builtin_amdgcn_mfma_f32_16x16x32_bf16(qf[s8], sf, oc[et], 0, 0, 0); }
#pragma unroll
                for (int et = 0; et < 2; ++et)
#pragma unroll
                    for (int r = 0; r < 4; ++r) RET[(tok0 + 16 * qt + 4 * fq + r) * RW + h * RDH + es * 32 + 16 * et + fr] = (bf16)f2bf(oi[et][r] + rsc[r] * oc[et][r]);
#pragma unroll
                for (int et = 0; et < 2; ++et)
#pragma unroll
                    for (int dt = 0; dt < 2; ++dt) st[et][dt] = st[et][dt] * cdec;
#pragma unroll
                for (int ks = 0; ks < 4; ++ks) { bf16x8 af[2];
#pragma unroll
                    for (int et = 0; et < 2; ++et) af[et] = *(const LAS bf16x8*)(lds + VS_OFF + (16 * et + fr) * 272 + 64 * ks + 16 * fq);
#pragma unroll
                    for (int dt = 0; dt < 2; ++dt) { const int cc = 2 * wave + dt, q_ = fr >> 2, p_ = fr & 3;
                        const int r0 = 32 * ks + 8 * fq + q_, r1 = r0 + 4;
                        const unsigned a0 = (unsigned)((cc >> 3) * 32768 + 256 * r0 + 16 * ((2 * (cc & 7) + (p_ >> 1)) ^ (((r0 & 3) << 2) | ((r0 >> 2) & 3))) + 8 * (p_ & 1));
                        const unsigned a1 = (unsigned)((cc >> 3) * 32768 + 256 * r1 + 16 * ((2 * (cc & 7) + (p_ >> 1)) ^ (((r1 & 3) << 2) | ((r1 >> 2) & 3))) + 8 * (p_ & 1));
                        const s16x4 t0 = __builtin_amdgcn_ds_read_tr16_b64_v4i16((LAS s16x4*)(lds + KT_OFF + a0)), t1 = __builtin_amdgcn_ds_read_tr16_b64_v4i16((LAS s16x4*)(lds + KT_OFF + a1));
                        const bf16x8 kf = __builtin_shufflevector(t0, t1, 0, 1, 2, 3, 4, 5, 6, 7);
#pragma unroll
                        for (int et = 0; et < 2; ++et) st[et][dt] = __builtin_amdgcn_mfma_f32_16x16x32_bf16(af[et], kf, st[et][dt], 0, 0, 0); } }
                __syncthreads();
#pragma unroll
                for (int et = 0; et < 2; ++et)
#pragma unroll
                    for (int dt = 0; dt < 2; ++dt)
#pragma unroll
                        for (int r = 0; r < 4; ++r) { const int e = 16 * et + 4 * fq + r, d = 32 * wave + 16 * dt + fr;
                            *(LAS bf16*)(lds + ST_OFF + e * 512 + ((((d >> 3) ^ (e & 15)) << 4) + (d & 7) * 2)) = (bf16)f2bf(st[et][dt][r]); }
            }
        }
    }
    xcd_barrier(bar);
    }
#endif

#ifndef SK_P3
    { PTRS();
    for (int it = gw; it < NTOK * RH; it += NGW) {
        const int h = it & 7; const size_t row = it >> 3;
        const v2u rv = *(const v2u*)(RET + row * RW + h * RDH + lane * 4);
        float v0 = bflo(rv.x), v1 = bfhi(rv.x), v2 = bflo(rv.y), v3 = bfhi(rv.y);
        const float mu = wave_sum((v0 + v1) + (v2 + v3)) * (1.f / 256.f);
        v0 -= mu; v1 -= mu; v2 -= mu; v3 -= mu;
        const float rs = rsqrtf(wave_sum((v0 * v0 + v1 * v1) + (v2 * v2 + v3 * v3)) * (1.f / 256.f) + EPS);
        const int c = h * RDH + lane * 4; const f32x4 rg = *(const f32x4*)(ret_g + c);
        const v2u gv = *(const v2u*)(PROJ + row * INC + 3 * RW + c);
        v2u o; o.x = pk2(bflo(gv.x) * (v0 * rs * rg.x), bfhi(gv.x) * (v1 * rs * rg.y)); o.y = pk2(bflo(gv.y) * (v2 * rs * rg.z), bfhi(gv.y) * (v3 * rs * rg.w));
        *(v2u*)(MIX + row * D + c) = o;
    }
    for (int un = bid; un < NB * (SEQ / CHK) * GG; un += G) {
        const int g = un & 7, n = (un >> 3) & 15, b = un >> 7; const size_t row0 = (size_t)b * SEQ + n * CHK;
        LAS bf16* vt = (LAS bf16*)(lds + RING_OFF);
        LAS float* stat = (LAS float*)(lds + AUX_OFF);
        __syncthreads();
        for (int rr = 0; rr < 16; ++rr) { const int r = wave * 16 + rr; const bf16* p = PROJ + (row0 + r) * INC + 5 * RW + lane * 8;
            float xv[32]; float s = 0.f;
#pragma unroll
            for (int i = 0; i < 4; ++i) { const v4u w = *(const v4u*)(p + 512 * i); xv[8 * i + 0] = bflo(w.x); xv[8 * i + 1] = bfhi(w.x); xv[8 * i + 2] = bflo(w.y); xv[8 * i + 3] = bfhi(w.y); xv[8 * i + 4] = bflo(w.z); xv[8 * i + 5] = bfhi(w.z); xv[8 * i + 6] = bflo(w.w); xv[8 * i + 7] = bfhi(w.w); }
#pragma unroll
            for (int i = 0; i < 32; ++i) s += xv[i];
            const float mu = wave_sum(s) * (1.f / GMW); float q = 0.f;
#pragma unroll
            for (int i = 0; i < 32; ++i) { const float d = xv[i] - mu; q += d * d; }
            const float rs = rsqrtf(wave_sum(q) * (1.f / GMW) + EPS);
            if (lane == 0) { stat[r] = mu; stat[128 + r] = rs; } }
        __syncthreads();
        { const int c = tid & 255, half = tid >> 8; const float lg = ln_g[g * GCG + c], lb = ln_b[g * GCG + c];
          for (int s = half; s < CHK; s += 2) { const float xv = bf2f(PROJ[(row0 + s) * INC + 5 * RW + g * GCG + c]); vt[s * 256 + c] = (bf16)f2bf((xv - stat[s]) * stat[128 + s] * lg + lb); } }
        __syncthreads();
        { const int c = tid & 255, half = tid >> 8;
          for (int i = 0; i < 64; ++i) { const int t = 2 * i + half; const float* w = gm_ws + ((size_t)g * CHK + t) * CHK; float acc = 0.f;
              for (int s = 0; s <= t; ++s) acc += w[s] * bf2f(vt[s * 256 + c]);
              const float uu = bf2f(PROJ[(row0 + t) * INC + 4 * RW + g * GCG + c]);
              MIX[(row0 + t) * D + RW + g * GCG + c] = (bf16)f2bf(uu * (acc + gm_bs[g * CHK + t])); } }
    }
    xcd_barrier(bar);

    }
#endif
#ifndef SK_P4
    { PTRS();
    {   pg8::Gemm g{MIX, WtOut, NTOK, D, D}; pg8::StaticOrder S; S.init(NTOK, D, G, bid);
        pg8::EpiResid E{x, H, D};
        pg8::gemm_phase<pg8::EpiResid, pg8::StaticOrder, PG8_ALIGN, PG8_SP2>(lds + RING_OFF, g, S, E); }
    xcd_barrier(bar);
    }
#endif
#ifndef SK_P4b
    { PTRS();
    for (int m = gw; m < NTOK; m += NGW) rms_row_to_bf16(H + (size_t)m * D, g_xa, XN + (size_t)m * D, lane);
    xcd_barrier(bar);
    }
#endif
#ifndef SK_P5
    { PTRS();
    {   pg8::Gemm g{XN, WtQ, NTOK, XW, D}; pg8::StaticOrder S; S.init(NTOK, XW, G, bid);
        pg8::EpiBf16<0> E{QX, XW, nullptr, 0, 0, 1.f};
        pg8::gemm_phase<pg8::EpiBf16<0>, pg8::StaticOrder, PG8_ALIGN, PG8_SP2>(lds + RING_OFF, g, S, E); }
    {   pg8::Gemm g{MN, WtKV, NMEM, XW, D}; pg8::StaticOrder S; S.init(NMEM, XW, G, (bid + G - 128) % G);
        pg8::EpiBf16<0> E{KX, XW, nullptr, 0, 0, 1.f};
        pg8::gemm_phase<pg8::EpiBf16<0>, pg8::StaticOrder, PG8_ALIGN, PG8_SP2>(lds + RING_OFF, g, S, E); }
    {   pg8::Gemm g{WtKV + (size_t)XW * D, MN, XW, NMEM, D}; pg8::StaticOrder S; S.init(XW, NMEM, G, (bid + G - 144) % G);
        pg8::EpiBf16<0> E{VT, NMEM, nullptr, 0, 0, 1.f};
        pg8::gemm_phase<pg8::EpiBf16<0>, pg8::StaticOrder, PG8_ALIGN, PG8_SP2>(lds + RING_OFF, g, S, E); }
    xcd_barrier(bar);
    }
#endif
#ifndef SK_P6
    { PTRS();
    {
        const int fr = lane & 15, fq = lane >> 4; const int kkey = (((fr >> 2) & 3) << 2) | (fr & 3);
        for (int ui = 0; ; ++ui) {
            int un; if (G == 256) { if (ui >= 1) break; un = ((((bid & 7) * 2 + (bid >> 7)) << 4) | ((bid >> 3) & 15)); } else { un = bid + ui * G; if (un >= NB * XH * 16) break; }
            const int qb = un & 15, h = (un >> 4) & 3, b = un >> 6; const size_t row0 = (size_t)b * SEQ + qb * 128;
            const int ch = tid & 31, rb = tid >> 5;
            __syncthreads();
            {   v4u kv[16]; const bf16* src = KX + ((size_t)b * MEML + rb) * XW + h * XDH + ch * 8;
#pragma unroll
                for (int i = 0; i < 16; ++i) kv[i] = *(const v4u*)(src + (size_t)(16 * i) * XW);
#pragma unroll
                for (int i = 0; i < 16; ++i) { const int m = rb + 16 * i; *(LAS v4u*)(lds + m * 512 + ((ch ^ ((((m >> 3) & 3) << 2) | (m & 3))) << 4)) = kv[i]; } }
            bf16x8 qf[8];
            { const bf16* qsrc = QX + (row0 + 16 * wave + fr) * XW + h * XDH + 8 * fq;
#pragma unroll
              for (int s8 = 0; s8 < 8; ++s8) qf[s8] = *(const bf16x8*)(qsrc + 32 * s8); }
            __syncthreads();
            f32x4 sa[16];
#pragma unroll
            for (int nt = 0; nt < 16; ++nt) { f32x4 a = {0.f, 0.f, 0.f, 0.f}; const int mrow = 32 * (nt >> 1) + 8 * (fr >> 2) + 4 * (nt & 1) + (fr & 3);
#pragma unroll
                for (int s8 = 0; s8 < 8; ++s8) { const bf16x8 kf = *(const LAS bf16x8*)(lds + mrow * 512 + (((4 * s8 + fq) ^ kkey) << 4)); a = __builtin_amdgcn_mfma_f32_16x16x32_bf16(kf, qf[s8], a, 0, 0, 0); }
                sa[nt] = a; if (nt & 1) asm volatile("" ::: "memory"); }
            float mx = sa[0][0];
#pragma unroll
            for (int nt = 0; nt < 16; ++nt) mx = fmaxf(fmaxf(fmaxf(mx, sa[nt][0]), fmaxf(sa[nt][1], sa[nt][2])), sa[nt][3]);
            mx = fmaxf(mx, __shfl_xor(mx, 16)); mx = fmaxf(mx, __shfl_xor(mx, 32));
            float sum = 0.f; const float cs = 0.0625f * 1.4426950408889634f;
#pragma unroll
            for (int nt = 0; nt < 16; ++nt)
#pragma unroll
                for (int r = 0; r < 4; ++r) { const float e = __builtin_amdgcn_exp2f((sa[nt][r] - mx) * cs); sa[nt][r] = e; sum += e; }
            sum += __shfl_xor(sum, 16); sum += __shfl_xor(sum, 32);
            const float inv = 1.0f / sum;
            v4u pf[8];
#pragma unroll
            for (int s8 = 0; s8 < 8; ++s8) { v4u w; w.x = cvtpk(sa[2 * s8][0] * inv, sa[2 * s8][1] * inv); w.y = cvtpk(sa[2 * s8][2] * inv, sa[2 * s8][3] * inv);
                w.z = cvtpk(sa[2 * s8 + 1][0] * inv, sa[2 * s8 + 1][1] * inv); w.w = cvtpk(sa[2 * s8 + 1][2] * inv, sa[2 * s8 + 1][3] * inv); pf[s8] = w; }
            asm volatile("" ::: "memory");
            v4u vreg[16];
            { const bf16* src = VT + ((size_t)h * XDH + rb) * NMEM + b * MEML + ch * 8;
#pragma unroll
              for (int i = 0; i < 16; ++i) vreg[i] = *(const v4u*)(src + (size_t)(16 * i) * NMEM); }
            __syncthreads();
#pragma unroll
            for (int i = 0; i < 16; ++i) { const int d = rb + 16 * i; *(LAS v4u*)(lds + d * 512 + ((ch ^ (d & 15)) << 4)) = vreg[i]; }
            __syncthreads();
            f32x4 o[16];
#pragma unroll
            for (int dt = 0; dt < 16; ++dt) o[dt] = (f32x4){0.f, 0.f, 0.f, 0.f};
#pragma unroll
            for (int s8 = 0; s8 < 8; ++s8)
#pragma unroll
                for (int dt = 0; dt < 16; ++dt) { const bf16x8 vf = *(const LAS bf16x8*)(lds + (16 * dt + fr) * 512 + (((4 * s8 + fq) ^ fr) << 4));
                    o[dt] = __builtin_amdgcn_mfma_f32_16x16x32_bf16(vf, __builtin_bit_cast(bf16x8, pf[s8]), o[dt], 0, 0, 0); if ((dt & 7) == 7) asm volatile("" ::: "memory"); }
            bf16* op = OX + (row0 + 16 * wave + fr) * XW + h * XDH + 4 * fq;
#pragma unroll
            for (int dt = 0; dt < 16; ++dt) { v2u w; w.x = cvtpk(o[dt][0], o[dt][1]); w.y = cvtpk(o[dt][2], o[dt][3]); *(v2u*)(op + 16 * dt) = w; }
        }
    }
    xcd_barrier(bar);
    }
#endif
#ifndef SK_P7
    { PTRS();
    {   pg8::Gemm g{OX, WtO, NTOK, D, XW}; pg8::StaticOrder S; S.init(NTOK, D, G, bid);
        pg8::EpiResid E{H, H, D};
        pg8::gemm_phase<pg8::EpiResid, pg8::StaticOrder, PG8_ALIGN, PG8_SP2>(lds + RING_OFF, g, S, E); }
    xcd_barrier(bar);
    }
#endif
#ifndef SK_P7b
    { PTRS();
    for (int m = gw; m < NTOK; m += NGW) {
        const f32x4* xr = (const f32x4*)(H + (size_t)m * D) + lane; f32x4 v[16]; float ss = 0.f;
#pragma unroll
        for (int j = 0; j < 16; ++j) { v[j] = xr[64 * j]; ss += (v[j].x * v[j].x + v[j].y * v[j].y) + (v[j].z * v[j].z + v[j].w * v[j].w); }
        const float rs = rsqrtf(wave_sum(ss) * (1.f / D) + EPS);
        const f32x4* gr = (const f32x4*)g_moe + lane; v2u* o8 = (v2u*)(XN + (size_t)m * D) + lane;
#pragma unroll
        for (int j = 0; j < 16; ++j) { const f32x4 gg = gr[64 * j]; v[j] = v[j] * rs * gg; v2u o; o.x = pk2(v[j].x, v[j].y); o.y = pk2(v[j].z, v[j].w); o8[64 * j] = o; }
        int gi = 0; float gm = -3.0e38f, den = 0.f;
#pragma unroll 1
        for (int j = 0; j < 8; ++j) { const f32x4* wr_ = (const f32x4*)(WrT + (size_t)j * D) + lane; float acc = 0.f;
#pragma unroll
            for (int q = 0; q < 16; ++q) { const f32x4 w = wr_[64 * q]; acc += (v[q].x * w.x + v[q].y * w.y) + (v[q].z * w.z + v[q].w * w.w); }
            const float l = wave_sum(acc) + rgb[j];
            if (l > gm) { den = den * __expf(gm - l) + 1.0f; gm = l; gi = j; } else den += __expf(l - gm); }
        const float ggate = 1.0f / den;
        int i0 = 0, i1 = 0; float v0 = -3.0e38f, v1 = -3.0e38f;
#pragma unroll 1
        for (int p = 0; p < 8; ++p) { const f32x4* wr_ = (const f32x4*)(WrT + (size_t)(8 + gi * 8 + p) * D) + lane; float acc = 0.f;
#pragma unroll
            for (int q = 0; q < 16; ++q) { const f32x4 w = wr_[64 * q]; acc += (v[q].x * w.x + v[q].y * w.y) + (v[q].z * w.z + v[q].w * w.w); }
            const float l = wave_sum(acc) + reb[gi * 8 + p];
            if (l > v0) { v1 = v0; i1 = i0; v0 = l; i0 = p; } else if (l > v1) { v1 = l; i1 = p; } }
        const float e1 = __expf(v1 - v0), g0 = 1.0f / (1.0f + e1), g1 = e1 / (1.0f + e1);
        if (lane == 0) { EID[2 * m] = gi * 8 + i0; EID[2 * m + 1] = gi * 8 + i1; GATE[2 * m] = g0 * ggate; GATE[2 * m + 1] = g1 * ggate; }
    }
    xcd_barrier(bar);
    }
#endif
#ifndef SK_P9
    { PTRS();
    {   LAS unsigned short* list = (LAS unsigned short*)(lds + LIST_OFF); LAS int* sc = (LAS int*)(lds + SC_OFF);
        for (int ui = 0; ; ++ui) {
            int un; if (G == 256) { if (ui >= 2) break; const int xcd = bid & 7, i = bid >> 3; un = ((xcd * 8 + ui * 4 + (i >> 3)) << 3) | (i & 7); } else { un = bid + ui * G; if (un >= NE * 8) break; }
            const int e = un >> 3, hs = un & 7; int off; __syncthreads();
            const int cnt = build_list16(EID, e, list, sc, tid, off);
            if (hs == 0) { for (int r = tid; r < cnt; r += NT) SLOTS[off + r] = (int)list[r]; if (tid == 0) { OFFCNT[2 * e] = off; OFFCNT[2 * e + 1] = cnt; } }
            const float* bsrc = ((tid & 63) < 32 ? wg : wu) + (size_t)e * D * FF + (size_t)(8 * wave) * FF + hs * 64 + ((2 * (tid & 63)) & 63);
            for (int row0 = 0; row0 < cnt; row0 += 384) {
                const int nrow = min(cnt - row0, 384), nmt = (nrow + 15) >> 4, nsl = max(0, (nmt - wave + 7) >> 3);
                unsigned aoff[6];
#pragma unroll
                for (int i = 0; i < 6; ++i) { const int r = min(row0 + (tid >> 3) + 64 * i, cnt - 1); aoff[i] = (unsigned)(list[r] >> 1) * (unsigned)D + (unsigned)((tid & 7) * 8); }
                f32x4 acc[3][8];
                moe_kloop(lds, tid, wave, lane, XN, aoff, bsrc, FF, D, nsl, acc);
                const int fr = lane & 15, fq = lane >> 4;
#pragma unroll
                for (int sl = 0; sl < 3; ++sl) if (sl < nsl) { const int r = row0 + (wave + 8 * sl) * 16 + fr;
                    if (r < cnt) { bf16* hp = HACT + (size_t)(off + r) * FF + hs * 64 + 4 * fq;
#pragma unroll
                        for (int nt = 0; nt < 4; ++nt) { const f32x4 gv = acc[sl][nt], uv = acc[sl][nt + 4]; v2u o; o.x = pk2(silu_f(gv[0]) * uv[0], silu_f(gv[1]) * uv[1]); o.y = pk2(silu_f(gv[2]) * uv[2], silu_f(gv[3]) * uv[3]);
                            *(v2u*)(hp + nt * 16) = o; } } }
            }
        }
    }
    xcd_barrier(bar);
    {   for (int ui = 0; ; ++ui) {
            int un; if (G == 256) { if (ui >= 2) break; const int xcd = bid & 7, i = bid >> 3; un = ((xcd * 8 + ui * 4 + (i >> 3)) << 3) | (i & 7); } else { un = bid + ui * G; if (un >= NE * 8) break; }
            const int e = un >> 3, c8 = un & 7; const int off = OFFCNT[2 * e], cnt = OFFCNT[2 * e + 1];
            for (int sub = 0; sub < 4; ++sub) {
                const int col0 = c8 * 512 + sub * 128;
                const float* bsrc = wd + (size_t)e * FF * D + (size_t)(8 * wave) * D + col0 + 2 * (tid & 63);
                for (int row0 = 0; row0 < cnt; row0 += 384) {
                    const int nrow = min(cnt - row0, 384), nmt = (nrow + 15) >> 4, nsl = max(0, (nmt - wave + 7) >> 3);
                    unsigned aoff[6];
#pragma unroll
                    for (int i = 0; i < 6; ++i) { const int r = min(row0 + (tid >> 3) + 64 * i, cnt - 1); aoff[i] = (unsigned)(off + r) * (unsigned)FF + (unsigned)((tid & 7) * 8); }
                    f32x4 acc[3][8];
                    moe_kloop(lds, tid, wave, lane, HACT, aoff, bsrc, D, FF, nsl, acc);
                    const int fr = lane & 15, fq = lane >> 4;
#pragma unroll
                    for (int sl = 0; sl < 3; ++sl) if (sl < nsl) { const int r = row0 + (wave + 8 * sl) * 16 + fr;
                        if (r < cnt) { const int slot = SLOTS[off + r]; const float gt = GATE[slot]; bf16* yp = Y + (size_t)slot * D + col0 + 4 * fq;
#pragma unroll
                            for (int nt = 0; nt < 8; ++nt) { const f32x4 v = acc[sl][nt]; v2u o; o.x = pk2(gt * v[0], gt * v[1]); o.y = pk2(gt * v[2], gt * v[3]); *(v2u*)(yp + nt * 16) = o; } } }
                }
            }
        }
    }
    xcd_barrier(bar);
    }
#endif
#ifndef SK_P11
    { PTRS();
    for (int m = gw; m < NTOK; m += NGW) {
        const f32x4* xr = (const f32x4*)(H + (size_t)m * D) + lane; const v2u* y0 = (const v2u*)(Y + (size_t)(2 * m) * D) + lane; const v2u* y1 = (const v2u*)(Y + (size_t)(2 * m + 1) * D) + lane;
        f32x4 v[16]; float ss = 0.f;
#pragma unroll
        for (int j = 0; j < 16; ++j) { const v2u a0 = y0[64 * j], a1 = y1[64 * j]; f32x4 t = xr[64 * j];
            t.x = (t.x + bflo(a0.x)) + bflo(a1.x); t.y = (t.y + bfhi(a0.x)) + bfhi(a1.x); t.z = (t.z + bflo(a0.y)) + bflo(a1.y); t.w = (t.w + bfhi(a0.y)) + bfhi(a1.y);
            v[j] = t; ss += (t.x * t.x + t.y * t.y) + (t.z * t.z + t.w * t.w); }
        const float rs = rsqrtf(wave_sum(ss) * (1.f / D) + EPS);
        const f32x4* gr = (const f32x4*)g_fin + lane; f32x4* orow = (f32x4*)(out + (size_t)m * D) + lane;
#pragma unroll
        for (int j = 0; j < 16; ++j) orow[64 * j] = v[j] * rs * gr[64 * j];
    }
    }
#endif
}

extern "C" void kernel_launch(void* const* d_in, const int* in_sizes, int n_in, void* d_out, int out_size, void* d_ws, size_t ws_size, hipStream_t stream) {
    static int grid = 0;
    if (grid == 0) {
        if (n_in != 25 || out_size != NTOK * D || ws_size < WS_END) { fprintf(stderr, "kernel_launch: unexpected shapes (n_in %d out %d ws %zu)\n", n_in, out_size, ws_size); grid = -1; return; }
        int dev = 0, cus = 0, per_cu = 0;
        if (hipGetDevice(&dev) != hipSuccess || hipDeviceGetAttribute(&cus, hipDeviceAttributeMultiprocessorCount, dev) != hipSuccess) { grid = -1; return; }
        if (hipFuncSetAttribute((const void*)mk_fwd, hipFuncAttributeMaxDynamicSharedMemorySize, LDS_BYTES) != hipSuccess) { fprintf(stderr, "kernel_launch: hipFuncSetAttribute failed\n"); grid = -1; return; }
        if (hipOccupancyMaxActiveBlocksPerMultiprocessor(&per_cu, (const void*)mk_fwd, NWAVES * 64, LDS_BYTES) != hipSuccess || per_cu < 1) { fprintf(stderr, "kernel_launch: occupancy query reports %d blocks per CU\n", per_cu); }
        (void)hipGetLastError();
        grid = cus;
    }
    if (grid < 0) return;
    if (hipMemsetAsync((char*)d_ws + WS_CTL, 0, CTL_ZERO_BYTES, stream) != hipSuccess) return;
    Args a{};
    for (int i = 0; i < 25; ++i) a.in[i] = d_in[i];
    a.out = (float*)d_out; a.ws = (unsigned char*)d_ws;
    hipLaunchKernelGGL(mk_fwd, dim3(grid), dim3(NWAVES * 64), LDS_BYTES, stream, a);
}
```

```cpp
#include <hip/hip_runtime.h>
#include <cstdio>
#include <cstdint>

#ifndef PG8_SP2
#define PG8_SP2 true
#endif
#ifndef PG8_ALIGN
#define PG8_ALIGN true
#endif
constexpr int NWAVES = 8, NT = 512;
constexpr int D = 4096, NB = 4, SEQ = 2048, NTOK = NB * SEQ, MEML = 256, NMEM = NB * MEML;
constexpr int RW = 2048, GMW = 2048, INC = 12288, RH = 8, RDH = 256, GG = 8, GCG = 256, CHK = 128;
constexpr int XH = 4, XDH = 256, XW = 1024;
constexpr int NE = 64, FF = 512, NSLOT = NTOK * 2;
constexpr float EPS = 1e-6f;
constexpr size_t MiB = 1u << 20;
constexpr size_t WS_CTL = 0, CTL_ZERO_BYTES = 1 * MiB;
constexpr size_t WS_WRT = 1 * MiB;
constexpr size_t WS_WIN = 3 * MiB;
constexpr size_t WS_WOUT = 99 * MiB;
constexpr size_t WS_WQ = 131 * MiB;
constexpr size_t WS_WKV = 139 * MiB;
constexpr size_t WS_WO = 155 * MiB;
constexpr size_t WS_XN = 163 * MiB;
constexpr size_t WS_MN = 227 * MiB;
constexpr size_t WS_COS = 235 * MiB, WS_SIN = 239 * MiB;
constexpr size_t WS_PROJ = 243 * MiB;
constexpr size_t WS_RET = 435 * MiB;
constexpr size_t WS_MIX = 467 * MiB;
constexpr size_t WS_H = 531 * MiB;
constexpr size_t WS_QX = 659 * MiB;
constexpr size_t WS_KVX = 675 * MiB;
constexpr size_t WS_OX = 679 * MiB;
constexpr size_t WS_EID = 695 * MiB;
constexpr size_t WS_HACT = 696 * MiB;
constexpr size_t WS_Y = 712 * MiB;
constexpr size_t WS_END = 840 * MiB;
constexpr int CW_TMO = 0, CW_CODE = 1, CW_BAR = 4096;
constexpr int RING_OFF = 0, RING_BYTES = 131072;
constexpr int LDSCTL_OFF = RING_BYTES, MISC_OFF = LDSCTL_OFF + 320;
constexpr int AUX_OFF = LDSCTL_OFF + 1024;
constexpr int LIST_OFF = AUX_OFF, SC_OFF = LIST_OFF + 16384;
constexpr int LDS_BYTES = 163840;

#define GAS __attribute__((address_space(1)))
#define LAS __attribute__((address_space(3)))
typedef unsigned short bf16;
typedef unsigned v4u __attribute__((ext_vector_type(4)));
typedef unsigned v2u __attribute__((ext_vector_type(2)));
typedef float f32x4 __attribute__((ext_vector_type(4)));
typedef short bf16x8 __attribute__((ext_vector_type(8)));
typedef GAS unsigned gu32;
#define RLX_AGENT __ATOMIC_RELAXED, __HIP_MEMORY_SCOPE_AGENT
#define LDS_WAIT() asm volatile("s_waitcnt lgkmcnt(0)" ::: "memory")
#define VM_WAIT() asm volatile("s_waitcnt vmcnt(0)" ::: "memory")
__device__ __forceinline__ unsigned f2bf(float f) { unsigned u = __builtin_bit_cast(unsigned, f); return (u + 0x7fffu + ((u >> 16) & 1u)) >> 16; }
__device__ __forceinline__ unsigned pk2(float lo, float hi) { return f2bf(lo) | (f2bf(hi) << 16); }
__device__ __forceinline__ float bf2f(unsigned b) { return __builtin_bit_cast(float, b << 16); }
__device__ __forceinline__ float bflo(unsigned w) { return __builtin_bit_cast(float, w << 16); }
__device__ __forceinline__ float bfhi(unsigned w) { return __builtin_bit_cast(float, w & 0xffff0000u); }
__device__ __forceinline__ float wave_sum(float v) {
#pragma unroll
    for (int o = 1; o < 64; o <<= 1) v += __shfl_xor(v, o);
    return v;
}
__device__ __forceinline__ float fast_sigmoid(float x) { return __builtin_amdgcn_rcpf(1.0f + __builtin_amdgcn_exp2f(-1.4426950408889634f * x)); }
__device__ __forceinline__ float gelu_tanh_f(float x) { return x * fast_sigmoid(1.5957691216057308f * (x + 0.044715f * x * x * x)); }
__device__ __forceinline__ float silu_f(float x) { return x * fast_sigmoid(x); }
namespace pg8 {
#define PG8_LAS __attribute__((address_space(3)))
typedef unsigned short bf16_t;
typedef short bf16x8 __attribute__((ext_vector_type(8)));
typedef float f32x4 __attribute__((ext_vector_type(4)));
typedef unsigned u32x4 __attribute__((ext_vector_type(4)));
constexpr int BM = 256, BK = 64, HALF = 128, HTB = HALF * BK * 2  , STAGE_BYTES = 8 * HTB, NXCD = 8, WGM = 8;

__host__ __device__ __forceinline__ int lds_byte(int r, int c) { const int st = (r >> 4) * 2 + (c >> 5), rr = r & 15, cc = c & 31, ob = rr * 64 + cc * 2; return st * 1024 + (ob ^ (((ob >> 9) & 1) << 5)); }
__host__ __device__ __forceinline__ void stage_rc(int b, int& R, int& C) { const int st = b / 1024, sb = b % 1024, swz = sb ^ (((sb >> 9) & 1) << 5); R = (st >> 1) * 16 + swz / 64; C = (st & 1) * 32 + (swz % 64) / 2; }
__host__ __device__ __forceinline__ int perm32(int rho) { const int n = rho >> 4, i = rho & 15; return 8 * (i >> 2) + 4 * n + (i & 3); }

struct Unit { int pm, pn; };
struct Gemm { const bf16_t* A; const bf16_t* Bt; int M, N, K; };

struct StaticOrder {
    int nM, nN, nwg, G, c;
    __host__ __device__ void init(int M, int N, int G_, int c_) { nM = M / BM; nN = N / BM; nwg = nM * nN; G = G_; c = c_; }
    __host__ __device__ bool next(int i, Unit& u) const {
        const long L = (long)i * G + c; if (L >= nwg) return false;
        int wgid = (int)L; { const int q = nwg / NXCD, r = nwg % NXCD, xcd = wgid % NXCD, off = wgid / NXCD; wgid = (xcd < r ? xcd * (q + 1) : r * (q + 1) + (xcd - r) * q) + off; }
        const int nig = WGM * nN, gid = wgid / nig, fm = gid * WGM, gsz = (nM - fm) < WGM ? (nM - fm) : WGM;
        u.pm = fm + ((wgid % nig) % gsz); u.pn = (wgid % nig) / gsz; return true;
    }
    __device__ __forceinline__ void a_ready(const Unit&) const {}
    __device__ __forceinline__ void done(const Unit&) const {}
};

__device__ __forceinline__ unsigned cvt_pk_bf16(float lo, float hi) { unsigned r; asm volatile("v_cvt_pk_bf16_f32 %0, %1, %2" : "=v"(r) : "v"(lo), "v"(hi)); return r; }
typedef float f32x2 __attribute__((ext_vector_type(2)));
__device__ __forceinline__ f32x2 gelu_pk(f32x2 v) {
    const f32x2 av = __builtin_elementwise_abs(v), d = av * 0.2316418882f + 1.0f;
    f32x2 t; t.x = __builtin_amdgcn_rcpf(d.x); t.y = __builtin_amdgcn_rcpf(d.y);
    f32x2 q = t * 0.5307027145f + (-0.7265760135f); q = q * t + 0.7107068705f; q = q * t + (-0.142248368f); q = q * t + 0.127414796f; q = q * t;
    const f32x2 s = (v * v) * (-0.72134752044f);
    f32x2 e; e.x = __builtin_amdgcn_exp2f(s.x); e.y = __builtin_amdgcn_exp2f(s.y);
    const f32x2 m = v * (q * e), r = v - m;
    f32x2 o; o.x = v.x < 0.f ? m.x : r.x; o.y = v.y < 0.f ? m.y : r.y; return o;
}

template <int ACT  > struct EpiBf16 {
    static constexpr bool PERM = true, AFTER_DRAIN = false; static_assert(ACT == 0 || ACT == 1, "EpiBf16: ACT is 0 (none) or 1 (gelu_pk)");
    bf16_t* O; int ldc; const float* bias; int split_cols; size_t split_stride; float scale0;
    __device__ __forceinline__ void operator()(const f32x4 (&acc)[2][2][4][2], const Unit& u, int wr, int wc, int fr, int fq) const {
        const int row0 = u.pm * BM + wr * 64 + fr; int colt = u.pn * BM; bf16_t* base = O;
        float sc = 1.f; if (split_cols) { const int t = colt / split_cols; base += (size_t)t * split_stride; colt -= t * split_cols; if (t == 0) sc = scale0; }
        const int col0 = colt + wc * 32 + 8 * fq, bcol0 = u.pn * BM + wc * 32 + 8 * fq;
        f32x4 bv[2][2];
#pragma unroll
        for (int bj = 0; bj < 2; ++bj)
#pragma unroll
            for (int n = 0; n < 2; ++n) bv[bj][n] = bias ? *(const f32x4*)(bias + bcol0 + bj * HALF + 4 * n) : (f32x4){0.f, 0.f, 0.f, 0.f};
#pragma unroll
        for (int ai = 0; ai < 2; ++ai)
#pragma unroll
            for (int m = 0; m < 4; ++m) { bf16_t* rowp = base + (size_t)(row0 + ai * HALF + m * 16) * ldc + col0;
#pragma unroll
                for (int bj = 0; bj < 2; ++bj) { f32x4 v0 = acc[ai][bj][m][0] + bv[bj][0], v1 = acc[ai][bj][m][1] + bv[bj][1];
                    if (ACT == 1) { f32x2 a = gelu_pk((f32x2){v0[0], v0[1]}), b = gelu_pk((f32x2){v0[2], v0[3]}), c = gelu_pk((f32x2){v1[0], v1[1]}), d = gelu_pk((f32x2){v1[2], v1[3]});
                        v0 = (f32x4){a.x, a.y, b.x, b.y}; v1 = (f32x4){c.x, c.y, d.x, d.y}; }
                    v0 = v0 * sc; v1 = v1 * sc; u32x4 w; w.x = cvt_pk_bf16(v0[0], v0[1]); w.y = cvt_pk_bf16(v0[2], v0[3]); w.z = cvt_pk_bf16(v1[0], v1[1]); w.w = cvt_pk_bf16(v1[2], v1[3]);
                    *(u32x4*)(rowp + bj * HALF) = w; } }
    }
};

struct EpiProj {
    static constexpr bool PERM = true, AFTER_DRAIN = false;
    bf16_t* O; const float* cs; const float* sn;
    __device__ __forceinline__ void operator()(const f32x4 (&acc)[2][2][4][2], const Unit& u, int wr, int wc, int fr, int fq) const {
        const int sec = u.pn >> 3;
        const int row0 = u.pm * BM + wr * 64 + fr, j0 = wc * 32 + 8 * fq, col0 = u.pn * BM + j0;
#pragma unroll
        for (int ai = 0; ai < 2; ++ai)
#pragma unroll
            for (int m = 0; m < 4; ++m) {
                const int row = row0 + ai * HALF + m * 16;
                f32x4 a0 = acc[ai][0][m][0], a1 = acc[ai][0][m][1], b0 = acc[ai][1][m][0], b1 = acc[ai][1][m][1];
                if (sec < 2) {
                    const float* cp = cs + (size_t)row * 128 + j0; const float* sp = sn + (size_t)row * 128 + j0;
                    const f32x4 c0 = *(const f32x4*)cp, c1 = *(const f32x4*)(cp + 4), s0 = *(const f32x4*)sp, s1 = *(const f32x4*)(sp + 4);
                    const float sc = sec ? 0.0625f : 1.0f;
                    const f32x4 t0 = (a0 * c0 - b0 * s0) * sc, t1 = (a1 * c1 - b1 * s1) * sc;
                    b0 = (a0 * s0 + b0 * c0) * sc; b1 = (a1 * s1 + b1 * c1) * sc; a0 = t0; a1 = t1;
                } else if (sec == 3) {
#pragma unroll
                    for (int j = 0; j < 4; ++j) { a0[j] = silu_f(a0[j]); a1[j] = silu_f(a1[j]); b0[j] = silu_f(b0[j]); b1[j] = silu_f(b1[j]); }
                } else if (sec >= 4) {
#pragma unroll
                    for (int j = 0; j < 4; ++j) { a0[j] = gelu_tanh_f(a0[j]); a1[j] = gelu_tanh_f(a1[j]); b0[j] = gelu_tanh_f(b0[j]); b1[j] = gelu_tanh_f(b1[j]); }
                }
                bf16_t* rowp = O + (size_t)row * 12288 + col0;
                u32x4 w; w.x = cvt_pk_bf16(a0[0], a0[1]); w.y = cvt_pk_bf16(a0[2], a0[3]); w.z = cvt_pk_bf16(a1[0], a1[1]); w.w = cvt_pk_bf16(a1[2], a1[3]);
                *(u32x4*)rowp = w;
                w.x = cvt_pk_bf16(b0[0], b0[1]); w.y = cvt_pk_bf16(b0[2], b0[3]); w.z = cvt_pk_bf16(b1[0], b1[1]); w.w = cvt_pk_bf16(b1[2], b1[3]);
                *(u32x4*)(rowp + HALF) = w;
            }
    }
};
struct EpiResid {
    static constexpr bool PERM = false, AFTER_DRAIN = false;
    const float* base; float* out; int ldc;
    __device__ __forceinline__ void operator()(const f32x4 (&acc)[2][2][4][2], const Unit& u, int wr, int wc, int fr, int fq) const {
        const int row0 = u.pm * BM + wr * 64 + fr, col0 = u.pn * BM + wc * 32 + 4 * fq;
#pragma unroll
        for (int ai = 0; ai < 2; ++ai)
#pragma unroll
            for (int m = 0; m < 4; ++m) { const size_t off = (size_t)(row0 + ai * HALF + m * 16) * ldc + col0;
#pragma unroll
                for (int bj = 0; bj < 2; ++bj)
#pragma unroll
                    for (int n = 0; n < 2; ++n) { const f32x4 bs = *(const f32x4*)(base + off + bj * HALF + n * 16); *(f32x4*)(out + off + bj * HALF + n * 16) = bs + acc[ai][bj][m][n]; } }
    }
};
template <class Epi, class Sched, bool ALIGN_EPI = false, bool SP2 = false>
__device__ __forceinline__ void gemm_phase(PG8_LAS unsigned char* lds, const Gemm g, const Sched& S, const Epi& E) {
    int tid = threadIdx.x; asm volatile("" : "+v"(tid));
    const int wid = __builtin_amdgcn_readfirstlane(tid >> 6), lane = tid & 63, wr = wid >> 2, wc = wid & 3, fr = lane & 15, fq = lane >> 4;
    const int K = g.K, nt = K / BK;
    unsigned voffA[2], voffB[2];
#pragma unroll
    for (int i = 0; i < 2; ++i) { int R, C; stage_rc(tid * 16 + i * 8192, R, C); const int Rb = Epi::PERM ? ((R & ~31) + perm32(R & 31)) : R;
        voffA[i] = (unsigned)(R * K + C) * 2u; voffB[i] = (unsigned)(Rb * K + C) * 2u; }
    const size_t kstep = (size_t)(BK * 2);
    const size_t hstep = (size_t)HALF * K * 2;
    const size_t tstep = 2 * hstep;
    const unsigned ldsw = (unsigned)wid * 1024u;
    const int aoff = lds_byte(wr * 64 + fr, fq * 8), boff = lds_byte(wc * 32 + fr, fq * 8);
#define PG8_SA(b, h) (((b) * 2 + (h)) * HTB)
#define PG8_SB(b, h) ((4 + (b) * 2 + (h)) * HTB)
#define PG8_STAGE(bufoff, gbase, voff) do { _Pragma("unroll") for (int _i = 0; _i < 2; ++_i) \
        __builtin_amdgcn_global_load_lds((const unsigned*)((const char*)(gbase) + (voff)[_i]), (PG8_LAS unsigned*)(lds + (bufoff) + ldsw + _i * 8192), 16, 0, 0); } while (0)
#define PG8_LDA(dst, b, h) do { _Pragma("unroll") for (int m = 0; m < 4; ++m) _Pragma("unroll") for (int k = 0; k < 2; ++k) dst[m][k] = *(const PG8_LAS bf16x8*)(lds + PG8_SA(b, h) + aoff + m * 2048 + k * 1024); } while (0)
#define PG8_LDB(dst, b, h) do { _Pragma("unroll") for (int n = 0; n < 2; ++n) _Pragma("unroll") for (int k = 0; k < 2; ++k) dst[n][k] = *(const PG8_LAS bf16x8*)(lds + PG8_SB(b, h) + boff + n * 2048 + k * 1024); } while (0)
#define PG8_MMA(ai, bj, At, Bt) do { __builtin_amdgcn_s_setprio(1); _Pragma("unroll") for (int m = 0; m < 4; ++m) _Pragma("unroll") for (int n = 0; n < 2; ++n) _Pragma("unroll") for (int k = 0; k < 2; ++k) \
        acc[ai][bj][m][n] = __builtin_amdgcn_mfma_f32_16x16x32_bf16(Bt[n][k], At[m][k], acc[ai][bj][m][n], 0, 0, 0); __builtin_amdgcn_s_setprio(0); } while (0)
#define PG8_WAIT_V(n) asm volatile("s_waitcnt vmcnt(" #n ")" ::: "memory")
#define PG8_WAIT_L(n) asm volatile("s_waitcnt lgkmcnt(" #n ")" ::: "memory")
#define PG8_BAR __builtin_amdgcn_s_barrier()
#define PG8_SCHED __builtin_amdgcn_sched_barrier(0)
    Unit cur, nxt; int ui = 0;
    if (!S.next(0, cur)) return;
    f32x4 acc[2][2][4][2];
#pragma unroll
    for (int a = 0; a < 2; ++a)
#pragma unroll
        for (int b = 0; b < 2; ++b)
#pragma unroll
            for (int m = 0; m < 4; ++m)
#pragma unroll
                for (int n = 0; n < 2; ++n) acc[a][b][m][n] = (f32x4){0.f, 0.f, 0.f, 0.f};
    bf16x8 At[4][2], B0[2][2], B1[2][2];
    const char* cA = (const char*)g.A + (size_t)cur.pm * tstep; const char* cB = (const char*)g.Bt + (size_t)cur.pn * tstep;
    S.a_ready(cur);
    if constexpr (SP2) {
        PG8_STAGE(PG8_SB(0, 0), cB, voffB); PG8_STAGE(PG8_SB(0, 1), cB + hstep, voffB); PG8_STAGE(PG8_SA(0, 0), cA, voffA); PG8_STAGE(PG8_SA(0, 1), cA + hstep, voffA);
        if (wr == 1) PG8_BAR;
        PG8_WAIT_V(2); PG8_BAR;
        PG8_STAGE(PG8_SB(1, 0), cB + kstep, voffB); PG8_STAGE(PG8_SA(1, 0), cA + kstep, voffA); PG8_STAGE(PG8_SB(1, 1), cB + hstep + kstep, voffB);
        PG8_WAIT_V(6); PG8_BAR;
    } else {
        PG8_STAGE(PG8_SB(0, 0), cB, voffB); PG8_STAGE(PG8_SA(0, 0), cA, voffA); PG8_STAGE(PG8_SB(0, 1), cB + hstep, voffB); PG8_STAGE(PG8_SA(0, 1), cA + hstep, voffA);
        if (wr == 1) PG8_BAR;
        PG8_WAIT_V(4); PG8_BAR;
        PG8_STAGE(PG8_SB(1, 0), cB + kstep, voffB); PG8_STAGE(PG8_SA(1, 0), cA + kstep, voffA); PG8_STAGE(PG8_SB(1, 1), cB + hstep + kstep, voffB);
        PG8_WAIT_V(6); PG8_BAR;
    }
    for (;;) {
        const bool has_next = S.next(ui + 1, nxt);
        const char* nA = has_next ? (const char*)g.A + (size_t)nxt.pm * tstep : cA; const char* nB = has_next ? (const char*)g.Bt + (size_t)nxt.pn * tstep : cB;
        for (int t = 0; t < nt; t += 2) {
            const bool last = (t == nt - 2);
            const char* a1 = cA + (size_t)(t + 1) * kstep;
            const char* a2 = last ? nA : cA + (size_t)(t + 2) * kstep; const char* b2 = last ? nB : cB + (size_t)(t + 2) * kstep;
            const char* a3 = a2 + kstep; const char* b3 = b2 + kstep;
            if (last && has_next) S.a_ready(nxt);
            if constexpr (SP2) {
            PG8_LDB(B0, 0, 0); PG8_LDB(B1, 0, 1); PG8_SCHED; PG8_LDA(At, 0, 0); PG8_STAGE(PG8_SA(1, 1), a1 + hstep, voffA);
            PG8_WAIT_V(8); PG8_WAIT_L(0); PG8_BAR; PG8_MMA(0, 0, At, B0); PG8_MMA(0, 1, At, B1); PG8_BAR; PG8_SCHED;
            PG8_LDA(At, 0, 1); PG8_STAGE(PG8_SB(0, 0), b2, voffB); PG8_STAGE(PG8_SB(0, 1), b2 + hstep, voffB); PG8_STAGE(PG8_SA(0, 0), a2, voffA);
            PG8_WAIT_V(8); PG8_WAIT_L(0); PG8_BAR; PG8_MMA(1, 0, At, B0); PG8_MMA(1, 1, At, B1); PG8_BAR; PG8_SCHED;
            PG8_LDB(B0, 1, 0); PG8_LDB(B1, 1, 1); PG8_SCHED; PG8_LDA(At, 1, 0); PG8_STAGE(PG8_SA(0, 1), a2 + hstep, voffA);
            PG8_WAIT_V(8); PG8_WAIT_L(0); PG8_BAR; PG8_MMA(0, 0, At, B0); PG8_MMA(0, 1, At, B1); PG8_BAR; PG8_SCHED;
            PG8_LDA(At, 1, 1); PG8_STAGE(PG8_SB(1, 0), b3, voffB); PG8_STAGE(PG8_SB(1, 1), b3 + hstep, voffB); PG8_STAGE(PG8_SA(1, 0), a3, voffA);
            PG8_WAIT_V(8); PG8_WAIT_L(0); PG8_BAR; PG8_MMA(1, 0, At, B0); PG8_MMA(1, 1, At, B1); PG8_BAR; PG8_SCHED;
            } else {
            PG8_LDB(B0, 0, 0); PG8_SCHED; PG8_LDA(At, 0, 0); PG8_STAGE(PG8_SA(1, 1), a1 + hstep, voffA);
            PG8_WAIT_L(8); PG8_BAR; PG8_WAIT_L(0); PG8_MMA(0, 0, At, B0); PG8_BAR; PG8_SCHED;
            PG8_LDB(B1, 0, 1); PG8_STAGE(PG8_SB(0, 0), b2, voffB);
            PG8_BAR; PG8_WAIT_L(0); PG8_MMA(0, 1, At, B1); PG8_BAR;
            PG8_LDA(At, 0, 1); PG8_STAGE(PG8_SA(0, 0), a2, voffA);
            PG8_BAR; PG8_WAIT_L(0); PG8_MMA(1, 0, At, B0); PG8_BAR; PG8_SCHED;
            PG8_STAGE(PG8_SB(0, 1), b2 + hstep, voffB);
            PG8_WAIT_V(6); PG8_BAR; PG8_MMA(1, 1, At, B1); PG8_BAR;
            PG8_LDB(B0, 1, 0); PG8_SCHED; PG8_LDA(At, 1, 0); PG8_STAGE(PG8_SA(0, 1), a2 + hstep, voffA);
            PG8_WAIT_L(8); PG8_BAR; PG8_WAIT_L(0); PG8_MMA(0, 0, At, B0); PG8_BAR; PG8_SCHED;
            PG8_LDB(B1, 1, 1); PG8_STAGE(PG8_SB(1, 0), b3, voffB);
            PG8_BAR; PG8_WAIT_L(0); PG8_MMA(0, 1, At, B1); PG8_BAR;
            PG8_LDA(At, 1, 1); PG8_STAGE(PG8_SA(1, 0), a3, voffA);
            PG8_BAR; PG8_WAIT_L(0); PG8_MMA(1, 0, At, B0); PG8_BAR; PG8_SCHED;
            PG8_STAGE(PG8_SB(1, 1), b3 + hstep, voffB);
            PG8_WAIT_V(6); PG8_BAR; PG8_MMA(1, 1, At, B1); PG8_BAR;
            }
        }
        if constexpr (ALIGN_EPI) { if (wr == 0) PG8_BAR; }
        if constexpr (!Epi::AFTER_DRAIN) { E(acc, cur, wr, wc, fr, fq); S.done(cur); }
        if (!has_next) break;
#pragma unroll
        for (int a = 0; a < 2; ++a)
#pragma unroll
            for (int b = 0; b < 2; ++b)
#pragma unroll
                for (int m = 0; m < 4; ++m)
#pragma unroll
                    for (int n = 0; n < 2; ++n) acc[a][b][m][n] = (f32x4){0.f, 0.f, 0.f, 0.f};
        cur = nxt; cA = nA; cB = nB; ++ui;
        if constexpr (ALIGN_EPI) { if (wr == 1) PG8_BAR; }
    }
    PG8_WAIT_V(0);
    if constexpr (!ALIGN_EPI) { if (wr == 0) PG8_BAR; }
    PG8_BAR;
    if constexpr (Epi::AFTER_DRAIN) { E.fused(acc, cur, wr, wc, fr, fq, lds, wid, lane); S.done(cur); }
#undef PG8_SA
#undef PG8_SB
#undef PG8_STAGE
#undef PG8_LDA
#undef PG8_LDB
#undef PG8_MMA
#undef PG8_WAIT_V
#undef PG8_WAIT_L
#undef PG8_BAR
#undef PG8_SCHED
}
}
#define XB_TMO      128
#define XB_XCNT(j)  (256  + 64 * (j))
#define XB_XSUB(j)  (1280 + 64 * (j))
#define XB_XGEN(j)  (2304 + 64 * (j))
#define XB_TOP      3328
#define XB_TOPGEN   3392
#define XCD_BAR_WORDS 3456
#define XB_SPIN_CAP (1u << 18)

__device__ __forceinline__ unsigned xb_ld(unsigned* p)              { return __hip_atomic_load(p, __ATOMIC_RELAXED, __HIP_MEMORY_SCOPE_AGENT); }
__device__ __forceinline__ unsigned xb_add(unsigned* p, unsigned v) { return __hip_atomic_fetch_add(p, v, __ATOMIC_RELAXED, __HIP_MEMORY_SCOPE_AGENT); }
__device__ __forceinline__ unsigned xb_xcc_id() { return (unsigned)__builtin_amdgcn_s_getreg((3 << 11) | 20) & 0xFu; }
#define XB_SPIN(cond, bar) do { unsigned _sp = 0; while (cond) { __builtin_amdgcn_s_sleep(1); \
    if ((++_sp & 255u) == 0u) { if (xb_ld(&(bar)[XB_TMO])) break; if (_sp > XB_SPIN_CAP) { atomicAdd(&(bar)[XB_TMO], 1u); break; } } } } while (0)

struct XcdBarrier {
    unsigned* bar; unsigned x;
    volatile LAS unsigned* st;
};

__device__ __forceinline__ XcdBarrier xcd_barrier_post(unsigned* bar, volatile LAS unsigned* st) {
    XcdBarrier b; b.bar = bar; b.x = xb_xcc_id(); b.st = st;
    if (threadIdx.x == 0) (void)xb_add(&bar[XB_XCNT(b.x)], 1u);
    return b;
}
__device__ __forceinline__ void xcd_barrier_complete(unsigned* bar, unsigned x, unsigned& nloc, unsigned& nx) {
    const unsigned G = gridDim.x * gridDim.y * gridDim.z;
    unsigned sum, cnt, mine, sp = 0u;
    for (;;) {
        sum = 0u; cnt = 0u; mine = 0u;
#pragma unroll
        for (unsigned j = 0; j < 16; ++j) { const unsigned c = xb_ld(&bar[XB_XCNT(j)]); sum += c; cnt += (c > 0u) ? 1u : 0u; mine = (j == x) ? c : mine; }
        if (sum == G) break;
        __builtin_amdgcn_s_sleep(1);
        if ((++sp & 255u) == 0u) { if (xb_ld(&bar[XB_TMO])) break; if (sp > XB_SPIN_CAP) { atomicAdd(&bar[XB_TMO], 1u); break; } }
    }
    nloc = mine > 0u ? mine : 1u; nx = cnt > 0u ? cnt : 1u;
}

__device__ __forceinline__ void xcd_barrier(const XcdBarrier& b) {
    asm volatile("s_waitcnt vmcnt(0)" ::: "memory");
    __syncthreads();
    if (threadIdx.x == 0) {
        unsigned* bar = b.bar;
        __builtin_amdgcn_s_waitcnt(0);
        unsigned nloc = b.st[0], nx = b.st[1];
        if (nloc == 0u) { xcd_barrier_complete(bar, b.x, nloc, nx); b.st[0] = nloc; b.st[1] = nx; }
        const unsigned old = xb_add(&bar[XB_XSUB(b.x)], 1u);
        const unsigned gen = old / nloc;
        if (old + 1u == (gen + 1u) * nloc) {
            __builtin_amdgcn_fence(__ATOMIC_RELEASE, "agent");
            asm volatile("s_waitcnt vmcnt(0)" ::: "memory");
            const unsigned og = xb_add(&bar[XB_TOP], 1u);
            const unsigned tg = og / nx;
            if (og + 1u == (tg + 1u) * nx) xb_add(&bar[XB_TOPGEN], 1u);
            else XB_SPIN(xb_ld(&bar[XB_TOPGEN]) == tg, bar);
            __builtin_amdgcn_fence(__ATOMIC_ACQUIRE, "agent");
            xb_add(&bar[XB_XGEN(b.x)], 1u);
            asm volatile("s_waitcnt vmcnt(0)" ::: "memory");
        } else {
            XB_SPIN(xb_ld(&bar[XB_XGEN(b.x)]) == gen, bar);
            __builtin_amdgcn_fence(__ATOMIC_ACQUIRE, "agent");
            asm volatile("s_waitcnt vmcnt(0)" ::: "memory");
        }
    }
    __syncthreads();
}


__device__ __forceinline__ void p0_transpose_item(const float* W, int K, int N, bf16* WT, LAS float* scr, int item, int lane) {
    const int nblk = N / 32, kb = item / nblk, nb = item % nblk, k0 = 64 * kb, n0 = 32 * nb;
#pragma unroll 8
    for (int i = 0; i < 32; ++i) { const int kk = 2 * i + (lane >> 5); scr[kk * 33 + (lane & 31)] = W[(size_t)(k0 + kk) * N + n0 + (lane & 31)]; }
    LDS_WAIT(); asm volatile("" ::: "memory");
    const int c = lane & 7;
#pragma unroll
    for (int j = 0; j < 4; ++j) { const int n = (lane >> 3) + 8 * j; const LAS float* s = scr + (8 * c) * 33 + n;
        v4u o; o.x = pk2(s[0 * 33], s[1 * 33]); o.y = pk2(s[2 * 33], s[3 * 33]); o.z = pk2(s[4 * 33], s[5 * 33]); o.w = pk2(s[6 * 33], s[7 * 33]);
        *(v4u*)(WT + (size_t)(n0 + n) * K + k0 + 8 * c) = o; }
    LDS_WAIT(); asm volatile("" ::: "memory");
}
__device__ __forceinline__ void rms_row_to_bf16(const float* xrow, const float* g, bf16* orow, int lane) {
    const f32x4* xr = (const f32x4*)xrow + lane; f32x4 v[16]; float ss = 0.f;
#pragma unroll
    for (int j = 0; j < 16; ++j) { v[j] = xr[64 * j]; ss += (v[j].x * v[j].x + v[j].y * v[j].y) + (v[j].z * v[j].z + v[j].w * v[j].w); }
    const float rs = rsqrtf(wave_sum(ss) * (1.f / D) + EPS);
    const f32x4* gr = (const f32x4*)g + lane; v2u* o8 = (v2u*)orow + lane;
#pragma unroll
    for (int j = 0; j < 16; ++j) { const f32x4 gg = gr[64 * j]; v2u o; o.x = pk2(v[j].x * rs * gg.x, v[j].y * rs * gg.y); o.y = pk2(v[j].z * rs * gg.z, v[j].w * rs * gg.w); o8[64 * j] = o; }
}
__device__ __forceinline__ int block_excl_scan(int v, LAS int* sc, int tid, int& tot) {
    const int lane = tid & 63, w = tid >> 6; int x = v;
#pragma unroll
    for (int o = 1; o < 64; o <<= 1) { const int y = __shfl_up(x, o); if (lane >= o) x += y; }
    __syncthreads();
    if (lane == 63) sc[w] = x;
    __syncthreads();
    int base = 0, t = 0;
#pragma unroll
    for (int i = 0; i < 8; ++i) { const int s = sc[i]; if (i < w) base += s; t += s; }
    tot = t; return base + x - v;
}
__device__ __forceinline__ int build_list(const int* eid, int e, LAS int* list, LAS int* sc, int tid, int& off) {
    const int4* p = (const int4*)(eid + 32 * tid); unsigned mask = 0u; int cm = 0, cl = 0;
#pragma unroll
    for (int i = 0; i < 8; ++i) { const int4 v = p[i];
        if (v.x == e) { mask |= 1u << (4 * i); ++cm; } if (v.y == e) { mask |= 2u << (4 * i); ++cm; } if (v.z == e) { mask |= 4u << (4 * i); ++cm; } if (v.w == e) { mask |= 8u << (4 * i); ++cm; }
        cl += (v.x < e) + (v.y < e) + (v.z < e) + (v.w < e); }
    int tot; int pos = block_excl_scan(cm, sc, tid, tot);
    int tl; (void)block_excl_scan(cl, sc + 8, tid, tl); off = tl;
    while (mask) { const int b = __builtin_ctz(mask); mask &= mask - 1u; list[pos++] = 32 * tid + b; }
    __syncthreads();
    return tot;
}


__device__ __forceinline__ int build_list16(const int* eid, int e, LAS unsigned short* list, LAS int* sc, int tid, int& off) {
    const int4* p = (const int4*)(eid + 32 * tid); unsigned mask = 0u; int cm = 0, cl = 0;
#pragma unroll
    for (int i = 0; i < 8; ++i) { const int4 v = p[i];
        if (v.x == e) { mask |= 1u << (4 * i); ++cm; } if (v.y == e) { mask |= 2u << (4 * i); ++cm; } if (v.z == e) { mask |= 4u << (4 * i); ++cm; } if (v.w == e) { mask |= 8u << (4 * i); ++cm; }
        cl += (v.x < e) + (v.y < e) + (v.z < e) + (v.w < e); }
    int tot; int pos = block_excl_scan(cm, sc, tid, tot);
    int tl; (void)block_excl_scan(cl, sc + 8, tid, tl); off = tl;
    while (mask) { const int b = __builtin_ctz(mask); mask &= mask - 1u; list[pos++] = (unsigned short)(32 * tid + b); }
    __syncthreads();
    return tot;
}
__device__ __forceinline__ unsigned cvtpk(float lo, float hi) { unsigned r; asm("v_cvt_pk_bf16_f32 %0, %1, %2" : "=v"(r) : "v"(lo), "v"(hi)); return r; }
typedef float f32x2g __attribute__((ext_vector_type(2)));
typedef short s16x4 __attribute__((ext_vector_type(4)));
__device__ __forceinline__ void moe_kloop(LAS unsigned char* lds, int tid, int wave, int lane, const bf16* Asrc, const unsigned (&aoff)[6], const float* bsrc, int ldb, int K, int nsl, f32x4 (&acc)[3][8]) {
    const int fr = lane & 15, fq = lane >> 4, swz = fr & 7, kc_a = tid & 7, ra = tid >> 3, n2 = tid & 63, kc_b = wave;
    const unsigned a_wr = (unsigned)(ra * 128 + ((kc_a ^ (ra & 7)) << 4));
    const unsigned b_wr0 = 49152u + (unsigned)((2 * n2) * 128 + ((kc_b ^ ((2 * n2) & 7)) << 4)), b_wr1 = 49152u + (unsigned)((2 * n2 + 1) * 128 + ((kc_b ^ ((2 * n2 + 1) & 7)) << 4));
    const unsigned a_rd = (unsigned)((wave * 16 + fr) * 128), b_rd = 49152u + (unsigned)(fr * 128);
#pragma unroll
    for (int sl = 0; sl < 3; ++sl)
#pragma unroll
        for (int nt = 0; nt < 8; ++nt) acc[sl][nt] = (f32x4){0.f, 0.f, 0.f, 0.f};
    v4u areg[6]; f32x2g breg[8];
#define MOE_LOAD(k0) do { _Pragma("unroll") for (int i_ = 0; i_ < 6; ++i_) areg[i_] = *(const v4u*)(Asrc + aoff[i_] + (k0)); \
        _Pragma("unroll") for (int i_ = 0; i_ < 8; ++i_) breg[i_] = __builtin_nontemporal_load((const f32x2g*)(bsrc + (size_t)((k0) + i_) * ldb)); } while (0)
#define MOE_STORE(bo) do { _Pragma("unroll") for (int i_ = 0; i_ < 6; ++i_) *(LAS v4u*)(lds + (bo) + a_wr + i_ * 8192) = areg[i_]; \
        v4u w_; w_.x = cvtpk(breg[0].x, breg[1].x); w_.y = cvtpk(breg[2].x, breg[3].x); w_.z = cvtpk(breg[4].x, breg[5].x); w_.w = cvtpk(breg[6].x, breg[7].x); *(LAS v4u*)(lds + (bo) + b_wr0) = w_; \
        w_.x = cvtpk(breg[0].y, breg[1].y); w_.y = cvtpk(breg[2].y, breg[3].y); w_.z = cvtpk(breg[4].y, breg[5].y); w_.w = cvtpk(breg[6].y, breg[7].y); *(LAS v4u*)(lds + (bo) + b_wr1) = w_; } while (0)
#define MOE_COMPUTE(bo) do { _Pragma("unroll 1") for (int ks_ = 0; ks_ < 2; ++ks_) { const unsigned xk_ = (unsigned)(((4 * ks_ + fq) ^ swz) << 4); \
        _Pragma("unroll") for (int hf_ = 0; hf_ < 2; ++hf_) { bf16x8 bfr_[4]; \
        _Pragma("unroll") for (int nt_ = 0; nt_ < 4; ++nt_) bfr_[nt_] = *(const LAS bf16x8*)(lds + (bo) + b_rd + (hf_ * 4 + nt_) * 2048 + xk_); \
        _Pragma("unroll") for (int sl_ = 0; sl_ < 3; ++sl_) if (sl_ < nsl) { const bf16x8 af_ = *(const LAS bf16x8*)(lds + (bo) + a_rd + sl_ * 16384 + xk_); \
            _Pragma("unroll") for (int nt_ = 0; nt_ < 4; ++nt_) acc[sl_][hf_ * 4 + nt_] = __builtin_amdgcn_mfma_f32_16x16x32_bf16(bfr_[nt_], af_, acc[sl_][hf_ * 4 + nt_], 0, 0, 0); } } } } while (0)
    __syncthreads();
    MOE_LOAD(0); MOE_STORE(0u); __syncthreads();
    const int S = K >> 6;
    for (int s = 0; s < S; ++s) {
        const unsigned cur = (unsigned)(s & 1) * 65536u, nxt = 65536u - cur;
        if (s + 1 < S) MOE_LOAD((s + 1) * 64);
        MOE_COMPUTE(cur);
        if (s + 1 < S) MOE_STORE(nxt);
        __syncthreads();
    }
#undef MOE_LOAD
#undef MOE_STORE
#undef MOE_COMPUTE
}

struct Args { const void* in[25]; float* out; unsigned char* ws; };
#define PTRS() const __attribute__((address_space(4))) Args* K_ = (const __attribute__((address_space(4))) Args*)__builtin_amdgcn_kernarg_segment_ptr(); asm volatile("" : "+s"(K_)); \
    int tid = threadIdx.x; asm volatile("" : "+v"(tid)); const int lane = tid & 63, wave = __builtin_amdgcn_readfirstlane(tid >> 6); \
    const int G = gridDim.x, bid = blockIdx.x, gw = bid * NWAVES + wave, NGW = G * NWAVES, gtid = bid * NT + tid, NGT = G * NT; (void)lane; (void)gw; (void)NGW; (void)gtid; (void)NGT; \
    unsigned char* ws = K_->ws; \
    const float* x = (const float*)K_->in[0]; const float* mem = (const float*)K_->in[1]; const int* pos = (const int*)K_->in[2]; \
    const float* g_mix = (const float*)K_->in[3]; const float* w_in = (const float*)K_->in[4]; const float* ret_g = (const float*)K_->in[5]; \
    const float* ln_g = (const float*)K_->in[6]; const float* ln_b = (const float*)K_->in[7]; const float* gm_ws = (const float*)K_->in[8]; const float* gm_bs = (const float*)K_->in[9]; \
    const float* w_out = (const float*)K_->in[10]; const float* g_xa = (const float*)K_->in[11]; const float* g_mem = (const float*)K_->in[12]; \
    const float* wq = (const float*)K_->in[13]; const float* wkv = (const float*)K_->in[14]; const float* wo = (const float*)K_->in[15]; \
    const float* g_moe = (const float*)K_->in[16]; const float* rgw = (const float*)K_->in[17]; const float* rgb = (const float*)K_->in[18]; \
    const float* rew = (const float*)K_->in[19]; const float* reb = (const float*)K_->in[20]; \
    const float* wg = (const float*)K_->in[21]; const float* wu = (const float*)K_->in[22]; const float* wd = (const float*)K_->in[23]; const float* g_fin = (const float*)K_->in[24]; \
    float* out = K_->out; \
    float* WrT = (float*)(ws + WS_WRT); \
    bf16* WtIn = (bf16*)(ws + WS_WIN); bf16* WtOut = (bf16*)(ws + WS_WOUT); bf16* WtQ = (bf16*)(ws + WS_WQ); bf16* WtKV = (bf16*)(ws + WS_WKV); bf16* WtO = (bf16*)(ws + WS_WO); \
    bf16* XN = (bf16*)(ws + WS_XN); bf16* MN = (bf16*)(ws + WS_MN); float* COS = (float*)(ws + WS_COS); float* SIN = (float*)(ws + WS_SIN); \
    bf16* PROJ = (bf16*)(ws + WS_PROJ); bf16* RET = (bf16*)(ws + WS_RET); bf16* MIX = (bf16*)(ws + WS_MIX); float* H = (float*)(ws + WS_H); \
    bf16* QX = (bf16*)(ws + WS_QX); bf16* KX = (bf16*)(ws + WS_KVX); bf16* VT = KX + (size_t)NMEM * XW; bf16* OX = (bf16*)(ws + WS_OX); \
    int* EID = (int*)(ws + WS_EID); float* GATE = (float*)(ws + WS_EID + 65536); int* SLOTS = (int*)(ws + WS_EID + 131072); int* OFFCNT = (int*)(ws + WS_EID + 196608); float* GSTAT = (float*)(ws + WS_EID + 262144); \
    bf16* HACT = (bf16*)(ws + WS_HACT); bf16* Y = (bf16*)(ws + WS_Y);
__global__ void __launch_bounds__(NWAVES * 64, 2) mk_fwd(Args a) {
    extern __shared__ __attribute__((aligned(16))) unsigned char lds_raw[];
    LAS unsigned char* lds = (LAS unsigned char*)lds_raw;
    const int tid0 = threadIdx.x;
    for (int u = tid0; u < (LDS_BYTES - LDSCTL_OFF) / 4; u += NT) ((LAS unsigned*)(lds + LDSCTL_OFF))[u] = 0u;
    __syncthreads();
    volatile LAS unsigned* MISC = (volatile LAS unsigned*)(lds + MISC_OFF);
    XcdBarrier bar; { PTRS(); bar = xcd_barrier_post((unsigned*)(ws + WS_CTL) + CW_BAR, MISC + 8); }

#ifndef SK_P0
    { PTRS();
    {
        LAS float* scr = (LAS float*)(lds + RING_OFF + wave * 16384);
        constexpr int I_IN = (D / 64) * (INC / 32), I_OUT = (D / 64) * (D / 32), I_Q = (D / 64) * (XW / 32), I_KV = (D / 64) * (2 * XW / 32), I_O = (XW / 64) * (D / 32);
        constexpr int NITEMS = I_IN + I_OUT + I_Q + I_KV + I_O;
        for (int it = gw; it < NITEMS; it += NGW) {
            int r = it;
            if (r < I_IN) { p0_transpose_item(w_in, D, INC, WtIn, scr, r, lane); continue; } r -= I_IN;
            if (r < I_OUT) { p0_transpose_item(w_out, D, D, WtOut, scr, r, lane); continue; } r -= I_OUT;
            if (r < I_Q) { p0_transpose_item(wq, D, XW, WtQ, scr, r, lane); continue; } r -= I_Q;
            if (r < I_KV) { p0_transpose_item(wkv, D, 2 * XW, WtKV, scr, r, lane); continue; } r -= I_KV;
            p0_transpose_item(wo, XW, D, WtO, scr, r, lane);
        }
        for (int i = gtid; i < 72 * D; i += NGT) { const int j = i >> 12, k = i & (D - 1); WrT[i] = j < 8 ? rgw[(size_t)k * 8 + j] : rew[(size_t)k * 64 + (j - 8)]; }
        for (int m = gw; m < NTOK; m += NGW) rms_row_to_bf16(x + (size_t)m * D, g_mix, XN + (size_t)m * D, lane);
        for (int m = gw; m < NMEM; m += NGW) rms_row_to_bf16(mem + (size_t)m * D, g_mem, MN + (size_t)m * D, lane);
        for (int i = gtid; i < NTOK * 128; i += NGT) { const int j = i & 127, row = i >> 7; const float inv = powf(10000.0f, -(float)(2 * j) / 256.0f); const float ang = (float)pos[row] * inv; COS[i] = cosf(ang); SIN[i] = sinf(ang); }
    }
    xcd_barrier(bar);

    }
#endif
#ifndef SK_P1
    { PTRS();
    {   pg8::Gemm g{XN, WtIn, NTOK, INC, D}; pg8::StaticOrder S; S.init(NTOK, INC, G, bid);
        pg8::EpiProj E{PROJ, COS, SIN};
        pg8::gemm_phase<pg8::EpiProj, pg8::StaticOrder, PG8_ALIGN, PG8_SP2>(lds + RING_OFF, g, S, E); }
    xcd_barrier(bar);

    }
#endif
#ifndef SK_P2
    { PTRS();
    {
        constexpr int KT_OFF = 0, VT_OFF = 65536, VS_OFF = VT_OFF + 8704, ST_OFF = VS_OFF + 8704;
        const int fr = lane & 15, fq = lane >> 4, qt = wave < 4 ? wave : 11 - wave;
        const int kswz = ((fr & 3) << 2) | ((fr >> 2) & 3);
        for (int ui = 0; ; ++ui) {
            int vb; if (G == 256) { if (ui >= 1) break; vb = (((bid & 7) * 4 + (bid >> 6)) << 3) | ((bid >> 3) & 7); } else { vb = bid + ui * G; if (vb >= NB * RH * 8) break; }
            const int es = vb & 7, h = (vb >> 3) & 7, b = vb >> 6;
            const float l2g = log2f(1.0f - exp2f(-5.0f - (float)h));
            float An[8], Br[4], rsc[4];
#pragma unroll
            for (int nt = 0; nt < 8; ++nt) An[nt] = exp2f(16.0f * (float)(qt - nt) * l2g);
#pragma unroll
            for (int r = 0; r < 4; ++r) { Br[r] = exp2f((float)(fr - 4 * fq - r) * l2g); rsc[r] = exp2f((float)(16 * qt + 4 * fq + r + 1) * l2g); }
            const float cdec = exp2f(128.0f * l2g);
            const float vsc0 = exp2f((float)(127 - (tid >> 3)) * l2g), vsc1 = exp2f((float)(127 - 64 - (tid >> 3)) * l2g);
            f32x4 st[2][2];
#pragma unroll
            for (int et = 0; et < 2; ++et)
#pragma unroll
                for (int dt = 0; dt < 2; ++dt) st[et][dt] = (f32x4){0.f, 0.f, 0.f, 0.f};
            __syncthreads();
            { const v4u z = {0u, 0u, 0u, 0u}; *(LAS v4u*)(lds + ST_OFF + tid * 32) = z; *(LAS v4u*)(lds + ST_OFF + tid * 32 + 16) = z; }
            for (int c = 0; c < SEQ / CHK; ++c) {
                const size_t tok0 = (size_t)b * SEQ + (size_t)c * CHK;
                {
                    const int ch32 = tid & 31, rb = tid >> 5; const bf16* src = PROJ + (tok0 + rb) * INC + RW + h * RDH + ch32 * 8;
                    const unsigned woff = (unsigned)((ch32 >> 4) * 32768 + 256 * rb + 16 * ((ch32 & 15) ^ (((rb & 3) << 2) | ((rb >> 2) & 3))));
                    v4u kv[8];
#pragma unroll
                    for (int i = 0; i < 8; ++i) kv[i] = *(const v4u*)(src + (size_t)(16 * i) * INC);
#pragma unroll
                    for (int i = 0; i < 8; ++i) *(LAS v4u*)(lds + KT_OFF + woff + i * 4096) = kv[i];
                }
                {
                    const int eg = tid & 7, tk = tid >> 3;
#pragma unroll
                    for (int i = 0; i < 2; ++i) { const v2u vv = *(const v2u*)(PROJ + (tok0 + tk + 64 * i) * INC + 2 * RW + h * RDH + es * 32 + eg * 4); const float sc = i ? vsc1 : vsc0;
                        LAS bf16* vt = (LAS bf16*)(lds + VT_OFF) + (4 * eg) * 136 + tk + 64 * i; LAS bf16* vs = (LAS bf16*)(lds + VS_OFF) + (4 * eg) * 136 + tk + 64 * i;
                        vt[0] = (bf16)(vv.x & 0xffffu); vt[136] = (bf16)(vv.x >> 16); vt[272] = (bf16)(vv.y & 0xffffu); vt[408] = (bf16)(vv.y >> 16);
                        vs[0] = (bf16)f2bf(bflo(vv.x) * sc); vs[136] = (bf16)f2bf(bfhi(vv.x) * sc); vs[272] = (bf16)f2bf(bflo(vv.y) * sc); vs[408] = (bf16)f2bf(bfhi(vv.y) * sc); }
                }
                bf16x8 qf[8];
                { const bf16* qsrc = PROJ + (tok0 + 16 * qt + fr) * INC + h * RDH + 8 * fq;
#pragma unroll
                  for (int s8 = 0; s8 < 8; ++s8) qf[s8] = *(const bf16x8*)(qsrc + 32 * s8); }
                __syncthreads();
                v4u pk[4];
#pragma unroll
                for (int s2 = 0; s2 < 4; ++s2) { v4u pw = {0u, 0u, 0u, 0u};
#pragma unroll
                    for (int hh = 0; hh < 2; ++hh) { const int nt = 2 * s2 + hh;
                        if (nt <= qt) { f32x4 a = {0.f, 0.f, 0.f, 0.f};
#pragma unroll
                            for (int s8 = 0; s8 < 8; ++s8) { const bf16x8 kf = *(const LAS bf16x8*)(lds + KT_OFF + (s8 >> 2) * 32768 + 256 * (16 * nt + fr) + 16 * ((4 * (s8 & 3) + fq) ^ kswz));
                                a = __builtin_amdgcn_mfma_f32_16x16x32_bf16(kf, qf[s8], a, 0, 0, 0); }
                            float p0 = a[0] * An[nt] * Br[0], p1 = a[1] * An[nt] * Br[1], p2 = a[2] * An[nt] * Br[2], p3 = a[3] * An[nt] * Br[3];
                            if (nt == qt) { const int dq = fr - 4 * fq; p0 = dq >= 0 ? p0 : 0.f; p1 = dq >= 1 ? p1 : 0.f; p2 = dq >= 2 ? p2 : 0.f; p3 = dq >= 3 ? p3 : 0.f; }
                            if (hh == 0) { pw.x = cvtpk(p0, p1); pw.y = cvtpk(p2, p3); } else { pw.z = cvtpk(p0, p1); pw.w = cvtpk(p2, p3); } } }
                    pk[s2] = pw; }
                f32x4 oi[2], oc[2];
#pragma unroll
                for (int et = 0; et < 2; ++et) { oi[et] = (f32x4){0.f, 0.f, 0.f, 0.f}; oc[et] = (f32x4){0.f, 0.f, 0.f, 0.f}; }
#pragma unroll
                for (int s2 = 0; s2 < 4; ++s2) if (2 * s2 <= qt) {
#pragma unroll
                    for (int et = 0; et < 2; ++et) { const LAS unsigned char* vp = lds + VT_OFF + (16 * et + fr) * 272 + (32 * s2 + 4 * fq) * 2;
                        const v2u lo = *(const LAS v2u*)vp, hi = *(const LAS v2u*)(vp + 32); const v4u vw = {lo.x, lo.y, hi.x, hi.y};
                        oi[et] = __builtin_amdgcn_mfma_f32_16x16x32_bf16(__builtin_bit_cast(bf16x8, pk[s2]), __builtin_bit_cast(bf16x8, vw), oi[et], 0, 0, 0); } }
#pragma unroll
                for (int s8 = 0; s8 < 8; ++s8)
#pragma unroll
                    for (int et = 0; et < 2; ++et) { const bf16x8 sf = *(const LAS bf16x8*)(lds + ST_OFF + (16 * et + fr) * 512 + (((4 * s8 + fq) ^ fr) << 4));
                        oc[et] = __builtin_amdgcn_mfma_f32_16x16x32_bf16(qf[s8], sf, oc[et], 0, 0, 0); }
#pragma unroll
                for (int et = 0; et < 2; ++et)
#pragma unroll
                    for (int r = 0; r < 4; ++r) RET[(tok0 + 16 * qt + 4 * fq + r) * RW + h * RDH + es * 32 + 16 * et + fr] = (bf16)f2bf(oi[et][r] + rsc[r] * oc[et][r]);
#pragma unroll
                for (int et = 0; et < 2; ++et)
#pragma unroll
                    for (int dt = 0; dt < 2; ++dt) st[et][dt] = st[et][dt] * cdec;
#pragma unroll
                for (int ks = 0; ks < 4; ++ks) { bf16x8 af[2];
#pragma unroll
                    for (int et = 0; et < 2; ++et) af[et] = *(const LAS bf16x8*)(lds + VS_OFF + (16 * et + fr) * 272 + 64 * ks + 16 * fq);
#pragma unroll
                    for (int dt = 0; dt < 2; ++dt) { const int cc = 2 * wave + dt, q_ = fr >> 2, p_ = fr & 3;
                        const int r0 = 32 * ks + 8 * fq + q_, r1 = r0 + 4;
                        const unsigned a0 = (unsigned)((cc >> 3) * 32768 + 256 * r0 + 16 * ((2 * (cc & 7) + (p_ >> 1)) ^ (((r0 & 3) << 2) | ((r0 >> 2) & 3))) + 8 * (p_ & 1));
                        const unsigned a1 = (unsigned)((cc >> 3) * 32768 + 256 * r1 + 16 * ((2 * (cc & 7) + (p_ >> 1)) ^ (((r1 & 3) << 2) | ((r1 >> 2) & 3))) + 8 * (p_ & 1));
                        const s16x4 t0 = __builtin_amdgcn_ds_read_tr16_b64_v4i16((LAS s16x4*)(lds + KT_OFF + a0)), t1 = __builtin_amdgcn_ds_read_tr16_b64_v4i16((LAS s16x4*)(lds + KT_OFF + a1));
                        const bf16x8 kf = __builtin_shufflevector(t0, t1, 0, 1, 2, 3, 4, 5, 6, 7);
#pragma unroll
                        for (int et = 0; et < 2; ++et) st[et][dt] = __builtin_amdgcn_mfma_f32_16x16x32_bf16(af[et], kf, st[et][dt], 0, 0, 0); } }
                __syncthreads();
#pragma unroll
                for (int et = 0; et < 2; ++et)
#pragma unroll
                    for (int dt = 0; dt < 2; ++dt)
#pragma unroll
                        for (int r = 0; r < 4; ++r) { const int e = 16 * et + 4 * fq + r, d = 32 * wave + 16 * dt + fr;
                            *(LAS bf16*)(lds + ST_OFF + e * 512 + ((((d >> 3) ^ (e & 15)) << 4) + (d & 7) * 2)) = (bf16)f2bf(st[et][dt][r]); }
            }
        }
        for (int m = gw; m < NTOK; m += NGW) { const bf16* p_ = PROJ + (size_t)m * INC + 5 * RW + lane * 8; float xv[32]; float s_ = 0.f;
#pragma unroll
            for (int i = 0; i < 4; ++i) { const v4u w = *(const v4u*)(p_ + 512 * i); xv[8 * i + 0] = bflo(w.x); xv[8 * i + 1] = bfhi(w.x); xv[8 * i + 2] = bflo(w.y); xv[8 * i + 3] = bfhi(w.y); xv[8 * i + 4] = bflo(w.z); xv[8 * i + 5] = bfhi(w.z); xv[8 * i + 6] = bflo(w.w); xv[8 * i + 7] = bfhi(w.w); }
#pragma unroll
            for (int i = 0; i < 32; ++i) s_ += xv[i];
            const float mu = wave_sum(s_) * (1.f / GMW); float q_ = 0.f;
#pragma unroll
            for (int i = 0; i < 32; ++i) { const float d_ = xv[i] - mu; q_ += d_ * d_; }
            const float rs = rsqrtf(wave_sum(q_) * (1.f / GMW) + EPS);
            if (lane == 0) { GSTAT[2 * m] = mu; GSTAT[2 * m + 1] = rs; } }
    }
    xcd_barrier(bar);
    }
#endif

#ifndef SK_P3
    { PTRS();
    for (int it = gw; it < NTOK * RH; it += NGW) {
        const int h = it & 7; const size_t row = it >> 3;
        const v2u rv = *(const v2u*)(RET + row * RW + h * RDH + lane * 4);
        float v0 = bflo(rv.x), v1 = bfhi(rv.x), v2 = bflo(rv.y), v3 = bfhi(rv.y);
        const float mu = wave_sum((v0 + v1) + (v2 + v3)) * (1.f / 256.f);
        v0 -= mu; v1 -= mu; v2 -= mu; v3 -= mu;
        const float rs = rsqrtf(wave_sum((v0 * v0 + v1 * v1) + (v2 * v2 + v3 * v3)) * (1.f / 256.f) + EPS);
        const int c = h * RDH + lane * 4; const f32x4 rg = *(const f32x4*)(ret_g + c);
        const v2u gv = *(const v2u*)(PROJ + row * INC + 3 * RW + c);
        v2u o; o.x = pk2(bflo(gv.x) * (v0 * rs * rg.x), bfhi(gv.x) * (v1 * rs * rg.y)); o.y = pk2(bflo(gv.y) * (v2 * rs * rg.z), bfhi(gv.y) * (v3 * rs * rg.w));
        *(v2u*)(MIX + row * D + c) = o;
    }
    {
        const int fr = lane & 15, fq = lane >> 4, tt = wave < 4 ? wave : 11 - wave, q_ = fr >> 2, p_ = fr & 3;
        for (int ui = 0; ; ++ui) {
            int un; if (G == 256) { if (ui >= 2) break; un = (((bid & 7) * 8 + ui * 4 + (bid >> 6)) << 3) | ((bid >> 3) & 7); } else { un = bid + ui * G; if (un >= NB * (SEQ / CHK) * GG) break; }
            const int g = un & 7, n = (un >> 3) & 15, b = un >> 7; const size_t row0 = (size_t)b * SEQ + n * CHK;
            __syncthreads();
            {   const int ch = tid & 31, rb = tid >> 5; const int c0 = g * GCG + ch * 8;
                const f32x4 lga = *(const f32x4*)(ln_g + c0), lgb = *(const f32x4*)(ln_g + c0 + 4), lba = *(const f32x4*)(ln_b + c0), lbb = *(const f32x4*)(ln_b + c0 + 4);
                const unsigned woff = (unsigned)((ch >> 4) * 32768 + 256 * rb + 16 * ((ch & 15) ^ (((rb & 3) << 2) | ((rb >> 2) & 3))));
#pragma unroll
                for (int i = 0; i < 8; ++i) { const size_t row = row0 + rb + 16 * i; const v4u w = *(const v4u*)(PROJ + row * INC + 5 * RW + c0); const float mu = GSTAT[2 * row], rs = GSTAT[2 * row + 1];
                    v4u o; o.x = cvtpk((bflo(w.x) - mu) * rs * lga.x + lba.x, (bfhi(w.x) - mu) * rs * lga.y + lba.y); o.y = cvtpk((bflo(w.y) - mu) * rs * lga.z + lba.z, (bfhi(w.y) - mu) * rs * lga.w + lba.w);
                    o.z = cvtpk((bflo(w.z) - mu) * rs * lgb.x + lbb.x, (bfhi(w.z) - mu) * rs * lgb.y + lbb.y); o.w = cvtpk((bflo(w.w) - mu) * rs * lgb.z + lbb.z, (bfhi(w.w) - mu) * rs * lgb.w + lbb.w);
                    *(LAS v4u*)(lds + woff + i * 4096) = o; } }
            const int t_ = 16 * tt + fr, kmax = (16 * tt + 15) >> 5;
            v4u wf[4];
#pragma unroll
            for (int ks = 0; ks < 4; ++ks) { v4u w = {0u, 0u, 0u, 0u};
                if (ks <= kmax) { const float* wp = gm_ws + ((size_t)g * CHK + t_) * CHK + 32 * ks + 8 * fq; const f32x4 a = *(const f32x4*)wp, c = *(const f32x4*)(wp + 4); const int s0 = 32 * ks + 8 * fq;
                    w.x = cvtpk(s0 + 0 <= t_ ? a.x : 0.f, s0 + 1 <= t_ ? a.y : 0.f); w.y = cvtpk(s0 + 2 <= t_ ? a.z : 0.f, s0 + 3 <= t_ ? a.w : 0.f);
                    w.z = cvtpk(s0 + 4 <= t_ ? c.x : 0.f, s0 + 5 <= t_ ? c.y : 0.f); w.w = cvtpk(s0 + 6 <= t_ ? c.z : 0.f, s0 + 7 <= t_ ? c.w : 0.f); }
                wf[ks] = w; }
            const float bias = gm_bs[g * CHK + t_];
            __syncthreads();
            f32x4 acc[16];
#pragma unroll
            for (int ct = 0; ct < 16; ++ct) acc[ct] = (f32x4){0.f, 0.f, 0.f, 0.f};
#pragma unroll
            for (int ks = 0; ks < 4; ++ks) if (ks <= kmax) {
                const int r0 = 32 * ks + 8 * fq + q_, r1 = r0 + 4;
                const unsigned x0 = (unsigned)(((r0 & 3) << 2) | ((r0 >> 2) & 3)), x1 = (unsigned)(((r1 & 3) << 2) | ((r1 >> 2) & 3));
#pragma unroll
                for (int ct = 0; ct < 16; ++ct) { const unsigned chk = (unsigned)(2 * (ct & 7) + (p_ >> 1));
                    const s16x4 t0 = __builtin_amdgcn_ds_read_tr16_b64_v4i16((LAS s16x4*)(lds + (ct >> 3) * 32768 + 256 * r0 + 16 * (chk ^ x0) + 8 * (p_ & 1)));
                    const s16x4 t1 = __builtin_amdgcn_ds_read_tr16_b64_v4i16((LAS s16x4*)(lds + (ct >> 3) * 32768 + 256 * r1 + 16 * (chk ^ x1) + 8 * (p_ & 1)));
                    const bf16x8 vf = __builtin_shufflevector(t0, t1, 0, 1, 2, 3, 4, 5, 6, 7);
                    acc[ct] = __builtin_amdgcn_mfma_f32_16x16x32_bf16(vf, __builtin_bit_cast(bf16x8, wf[ks]), acc[ct], 0, 0, 0);
                    if ((ct & 7) == 7) asm volatile("" ::: "memory"); } }
            {   const size_t row = row0 + t_; const bf16* up = PROJ + row * INC + 4 * RW + g * GCG + 4 * fq; bf16* op = MIX + row * D + RW + g * GCG + 4 * fq;
#pragma unroll
                for (int ct = 0; ct < 16; ++ct) { const v2u uu = *(const v2u*)(up + 16 * ct); v2u o;
                    o.x = cvtpk(bflo(uu.x) * (acc[ct][0] + bias), bfhi(uu.x) * (acc[ct][1] + bias)); o.y = cvtpk(bflo(uu.y) * (acc[ct][2] + bias), bfhi(uu.y) * (acc[ct][3] + bias));
                    *(v2u*)(op + 16 * ct) = o; } }
        }
    }
    xcd_barrier(bar);

    }
#endif
#ifndef SK_P4
    { PTRS();
    {   pg8::Gemm g{MIX, WtOut, NTOK, D, D}; pg8::StaticOrder S; S.init(NTOK, D, G, bid);
        pg8::EpiResid E{x, H, D};
        pg8::gemm_phase<pg8::EpiResid, pg8::StaticOrder, PG8_ALIGN, PG8_SP2>(lds + RING_OFF, g, S, E); }
    xcd_barrier(bar);
    }
#endif
#ifndef SK_P4b
    { PTRS();
    for (int m = gw; m < NTOK; m += NGW) rms_row_to_bf16(H + (size_t)m * D, g_xa, XN + (size_t)m * D, lane);
    xcd_barrier(bar);
    }
#endif
#ifndef SK_P5
    { PTRS();
    {   pg8::Gemm g{XN, WtQ, NTOK, XW, D}; pg8::StaticOrder S; S.init(NTOK, XW, G, bid);
        pg8::EpiBf16<0> E{QX, XW, nullptr, 0, 0, 1.f};
        pg8::gemm_phase<pg8::EpiBf16<0>, pg8::StaticOrder, PG8_ALIGN, PG8_SP2>(lds + RING_OFF, g, S, E); }
    {   pg8::Gemm g{MN, WtKV, NMEM, XW, D}; pg8::StaticOrder S; S.init(NMEM, XW, G, (bid + G - 128) % G);
        pg8::EpiBf16<0> E{KX, XW, nullptr, 0, 0, 1.f};
        pg8::gemm_phase<pg8::EpiBf16<0>, pg8::StaticOrder, PG8_ALIGN, PG8_SP2>(lds + RING_OFF, g, S, E); }
    {   pg8::Gemm g{WtKV + (size_t)XW * D, MN, XW, NMEM, D}; pg8::StaticOrder S; S.init(XW, NMEM, G, (bid + G - 144) % G);
        pg8::EpiBf16<0> E{VT, NMEM, nullptr, 0, 0, 1.f};
        pg8::gemm_phase<pg8::EpiBf16<0>, pg8::StaticOrder, PG8_ALIGN, PG8_SP2>(lds + RING_OFF, g, S, E); }
    xcd_barrier(bar);
    }
#endif
#ifndef SK_P6
    { PTRS();
    {
        const int fr = lane & 15, fq = lane >> 4; const int kkey = (((fr >> 2) & 3) << 2) | (fr & 3);
        for (int ui = 0; ; ++ui) {
            int un; if (G == 256) { if (ui >= 1) break; un = ((((bid & 7) * 2 + (bid >> 7)) << 4) | ((bid >> 3) & 15)); } else { un = bid + ui * G; if (un >= NB * XH * 16) break; }
            const int qb = un & 15, h = (un >> 4) & 3, b = un >> 6; const size_t row0 = (size_t)b * SEQ + qb * 128;
            const int ch = tid & 31, rb = tid >> 5;
            __syncthreads();
            {   v4u kv[16]; const bf16* src = KX + ((size_t)b * MEML + rb) * XW + h * XDH + ch * 8;
#pragma unroll
                for (int i = 0; i < 16; ++i) kv[i] = *(const v4u*)(src + (size_t)(16 * i) * XW);
#pragma unroll
                for (int i = 0; i < 16; ++i) { const int m = rb + 16 * i; *(LAS v4u*)(lds + m * 512 + ((ch ^ ((((m >> 3) & 3) << 2) | (m & 3))) << 4)) = kv[i]; } }
            bf16x8 qf[8];
            { const bf16* qsrc = QX + (row0 + 16 * wave + fr) * XW + h * XDH + 8 * fq;
#pragma unroll
              for (int s8 = 0; s8 < 8; ++s8) qf[s8] = *(const bf16x8*)(qsrc + 32 * s8); }
            __syncthreads();
            f32x4 sa[16];
#pragma unroll
            for (int nt = 0; nt < 16; ++nt) { f32x4 a = {0.f, 0.f, 0.f, 0.f}; const int mrow = 32 * (nt >> 1) + 8 * (fr >> 2) + 4 * (nt & 1) + (fr & 3);
#pragma unroll
                for (int s8 = 0; s8 < 8; ++s8) { const bf16x8 kf = *(const LAS bf16x8*)(lds + mrow * 512 + (((4 * s8 + fq) ^ kkey) << 4)); a = __builtin_amdgcn_mfma_f32_16x16x32_bf16(kf, qf[s8], a, 0, 0, 0); }
                sa[nt] = a; if (nt & 1) asm volatile("" ::: "memory"); }
            float mx = sa[0][0];
#pragma unroll
            for (int nt = 0; nt < 16; ++nt) mx = fmaxf(fmaxf(fmaxf(mx, sa[nt][0]), fmaxf(sa[nt][1], sa[nt][2])), sa[nt][3]);
            mx = fmaxf(mx, __shfl_xor(mx, 16)); mx = fmaxf(mx, __shfl_xor(mx, 32));
            float sum = 0.f; const float cs = 0.0625f * 1.4426950408889634f;
#pragma unroll
            for (int nt = 0; nt < 16; ++nt)
#pragma unroll
                for (int r = 0; r < 4; ++r) { const float e = __builtin_amdgcn_exp2f((sa[nt][r] - mx) * cs); sa[nt][r] = e; sum += e; }
            sum += __shfl_xor(sum, 16); sum += __shfl_xor(sum, 32);
            const float inv = 1.0f / sum;
            v4u pf[8];
#pragma unroll
            for (int s8 = 0; s8 < 8; ++s8) { v4u w; w.x = cvtpk(sa[2 * s8][0] * inv, sa[2 * s8][1] * inv); w.y = cvtpk(sa[2 * s8][2] * inv, sa[2 * s8][3] * inv);
                w.z = cvtpk(sa[2 * s8 + 1][0] * inv, sa[2 * s8 + 1][1] * inv); w.w = cvtpk(sa[2 * s8 + 1][2] * inv, sa[2 * s8 + 1][3] * inv); pf[s8] = w; }
            asm volatile("" ::: "memory");
            v4u vreg[16];
            { const bf16* src = VT + ((size_t)h * XDH + rb) * NMEM + b * MEML + ch * 8;
#pragma unroll
              for (int i = 0; i < 16; ++i) vreg[i] = *(const v4u*)(src + (size_t)(16 * i) * NMEM); }
            __syncthreads();
#pragma unroll
            for (int i = 0; i < 16; ++i) { const int d = rb + 16 * i; *(LAS v4u*)(lds + d * 512 + ((ch ^ (d & 15)) << 4)) = vreg[i]; }
            __syncthreads();
            f32x4 o[16];
#pragma unroll
            for (int dt = 0; dt < 16; ++dt) o[dt] = (f32x4){0.f, 0.f, 0.f, 0.f};
#pragma unroll
            for (int s8 = 0; s8 < 8; ++s8)
#pragma unroll
                for (int dt = 0; dt < 16; ++dt) { const bf16x8 vf = *(const LAS bf16x8*)(lds + (16 * dt + fr) * 512 + (((4 * s8 + fq) ^ fr) << 4));
                    o[dt] = __builtin_amdgcn_mfma_f32_16x16x32_bf16(vf, __builtin_bit_cast(bf16x8, pf[s8]), o[dt], 0, 0, 0); if ((dt & 7) == 7) asm volatile("" ::: "memory"); }
            bf16* op = OX + (row0 + 16 * wave + fr) * XW + h * XDH + 4 * fq;
#pragma unroll
            for (int dt = 0; dt < 16; ++dt) { v2u w; w.x = cvtpk(o[dt][0], o[dt][1]); w.y = cvtpk(o[dt][2], o[dt][3]); *(v2u*)(op + 16 * dt) = w; }
        }
    }
    xcd_barrier(bar);
    }
#endif
#ifndef SK_P7
    { PTRS();
    {   pg8::Gemm g{OX, WtO, NTOK, D, XW}; pg8::StaticOrder S; S.init(NTOK, D, G, bid);
        pg8::EpiResid E{H, H, D};
        pg8::gemm_phase<pg8::EpiResid, pg8::StaticOrder, PG8_ALIGN, PG8_SP2>(lds + RING_OFF, g, S, E); }
    xcd_barrier(bar);
    }
#endif
#ifndef SK_P7b
    { PTRS();
    for (int m = gw; m < NTOK; m += NGW) {
        const f32x4* xr = (const f32x4*)(H + (size_t)m * D) + lane; f32x4 v[16]; float ss = 0.f;
#pragma unroll
        for (int j = 0; j < 16; ++j) { v[j] = xr[64 * j]; ss += (v[j].x * v[j].x + v[j].y * v[j].y) + (v[j].z * v[j].z + v[j].w * v[j].w); }
        const float rs = rsqrtf(wave_sum(ss) * (1.f / D) + EPS);
        const f32x4* gr = (const f32x4*)g_moe + lane; v2u* o8 = (v2u*)(XN + (size_t)m * D) + lane;
#pragma unroll
        for (int j = 0; j < 16; ++j) { const f32x4 gg = gr[64 * j]; v[j] = v[j] * rs * gg; v2u o; o.x = pk2(v[j].x, v[j].y); o.y = pk2(v[j].z, v[j].w); o8[64 * j] = o; }
        int gi = 0; float gm = -3.0e38f, den = 0.f;
#pragma unroll 1
        for (int j = 0; j < 8; ++j) { const f32x4* wr_ = (const f32x4*)(WrT + (size_t)j * D) + lane; float acc = 0.f;
#pragma unroll
            for (int q = 0; q < 16; ++q) { const f32x4 w = wr_[64 * q]; acc += (v[q].x * w.x + v[q].y * w.y) + (v[q].z * w.z + v[q].w * w.w); }
            const float l = wave_sum(acc) + rgb[j];
            if (l > gm) { den = den * __expf(gm - l) + 1.0f; gm = l; gi = j; } else den += __expf(l - gm); }
        const float ggate = 1.0f / den;
        int i0 = 0, i1 = 0; float v0 = -3.0e38f, v1 = -3.0e38f;
#pragma unroll 1
        for (int p = 0; p < 8; ++p) { const f32x4* wr_ = (const f32x4*)(WrT + (size_t)(8 + gi * 8 + p) * D) + lane; float acc = 0.f;
#pragma unroll
            for (int q = 0; q < 16; ++q) { const f32x4 w = wr_[64 * q]; acc += (v[q].x * w.x + v[q].y * w.y) + (v[q].z * w.z + v[q].w * w.w); }
            const float l = wave_sum(acc) + reb[gi * 8 + p];
            if (l > v0) { v1 = v0; i1 = i0; v0 = l; i0 = p; } else if (l > v1) { v1 = l; i1 = p; } }
        const float e1 = __expf(v1 - v0), g0 = 1.0f / (1.0f + e1), g1 = e1 / (1.0f + e1);
        if (lane == 0) { EID[2 * m] = gi * 8 + i0; EID[2 * m + 1] = gi * 8 + i1; GATE[2 * m] = g0 * ggate; GATE[2 * m + 1] = g1 * ggate; }
    }
    xcd_barrier(bar);
    }
#endif
#ifndef SK_P9
    { PTRS();
    {   LAS unsigned short* list = (LAS unsigned short*)(lds + LIST_OFF); LAS int* sc = (LAS int*)(lds + SC_OFF);
        for (int ui = 0; ; ++ui) {
            int un; if (G == 256) { if (ui >= 2) break; const int xcd = bid & 7, i = bid >> 3; un = ((xcd * 8 + ui * 4 + (i >> 3)) << 3) | (i & 7); } else { un = bid + ui * G; if (un >= NE * 8) break; }
            const int e = un >> 3, hs = un & 7; int off; __syncthreads();
            const int cnt = build_list16(EID, e, list, sc, tid, off);
            if (hs == 0) { for (int r = tid; r < cnt; r += NT) SLOTS[off + r] = (int)list[r]; if (tid == 0) { OFFCNT[2 * e] = off; OFFCNT[2 * e + 1] = cnt; } }
            const float* bsrc = ((tid & 63) < 32 ? wg : wu) + (size_t)e * D * FF + (size_t)(8 * wave) * FF + hs * 64 + ((2 * (tid & 63)) & 63);
            for (int row0 = 0; row0 < cnt; row0 += 384) {
                const int nrow = min(cnt - row0, 384), nmt = (nrow + 15) >> 4, nsl = max(0, (nmt - wave + 7) >> 3);
                unsigned aoff[6];
#pragma unroll
                for (int i = 0; i < 6; ++i) { const int r = min(row0 + (tid >> 3) + 64 * i, cnt - 1); aoff[i] = (unsigned)(list[r] >> 1) * (unsigned)D + (unsigned)((tid & 7) * 8); }
                f32x4 acc[3][8];
                moe_kloop(lds, tid, wave, lane, XN, aoff, bsrc, FF, D, nsl, acc);
                const int fr = lane & 15, fq = lane >> 4;
#pragma unroll
                for (int sl = 0; sl < 3; ++sl) if (sl < nsl) { const int r = row0 + (wave + 8 * sl) * 16 + fr;
                    if (r < cnt) { bf16* hp = HACT + (size_t)(off + r) * FF + hs * 64 + 4 * fq;
#pragma unroll
                        for (int nt = 0; nt < 4; ++nt) { const f32x4 gv = acc[sl][nt], uv = acc[sl][nt + 4]; v2u o; o.x = pk2(silu_f(gv[0]) * uv[0], silu_f(gv[1]) * uv[1]); o.y = pk2(silu_f(gv[2]) * uv[2], silu_f(gv[3]) * uv[3]);
                            *(v2u*)(hp + nt * 16) = o; } } }
            }
        }
    }
    xcd_barrier(bar);
    {   for (int ui = 0; ; ++ui) {
            int un; if (G == 256) { if (ui >= 2) break; const int xcd = bid & 7, i = bid >> 3; un = ((xcd * 8 + ui * 4 + (i >> 3)) << 3) | (i & 7); } else { un = bid + ui * G; if (un >= NE * 8) break; }
            const int e = un >> 3, c8 = un & 7; const int off = OFFCNT[2 * e], cnt = OFFCNT[2 * e + 1];
            for (int sub = 0; sub < 4; ++sub) {
                const int col0 = c8 * 512 + sub * 128;
                const float* bsrc = wd + (size_t)e * FF * D + (size_t)(8 * wave) * D + col0 + 2 * (tid & 63);
                for (int row0 = 0; row0 < cnt; row0 += 384) {
                    const int nrow = min(cnt - row0, 384), nmt = (nrow + 15) >> 4, nsl = max(0, (nmt - wave + 7) >> 3);
                    unsigned aoff[6];
#pragma unroll
                    for (int i = 0; i < 6; ++i) { const int r = min(row0 + (tid >> 3) + 64 * i, cnt - 1); aoff[i] = (unsigned)(off + r) * (unsigned)FF + (unsigned)((tid & 7) * 8); }
                    f32x4 acc[3][8];
                    moe_kloop(lds, tid, wave, lane, HACT, aoff, bsrc, D, FF, nsl, acc);
                    const int fr = lane & 15, fq = lane >> 4;
#pragma unroll
                    for (int sl = 0; sl < 3; ++sl) if (sl < nsl) { const int r = row0 + (wave + 8 * sl) * 16 + fr;
                        if (r < cnt) { const int slot = SLOTS[off + r]; const float gt = GATE[slot]; bf16* yp = Y + (size_t)slot * D + col0 + 4 * fq;
#pragma unroll
                            for (int nt = 0; nt < 8; ++nt) { const f32x4 v = acc[sl][nt]; v2u o; o.x = pk2(gt * v[0], gt * v[1]); o.y = pk2(gt * v[2], gt * v[3]); *(v2u*)(yp + nt * 16) = o; } } }
                }
            }
        }
    }
    xcd_barrier(bar);
    }
#endif
#ifndef SK_P11
    { PTRS();
    for (int m = gw; m < NTOK; m += NGW) {
        const f32x4* xr = (const f32x4*)(H + (size_t)m * D) + lane; const v2u* y0 = (const v2u*)(Y + (size_t)(2 * m) * D) + lane; const v2u* y1 = (const v2u*)(Y + (size_t)(2 * m + 1) * D) + lane;
        f32x4 v[16]; float ss = 0.f;
#pragma unroll
        for (int j = 0; j < 16; ++j) { const v2u a0 = y0[64 * j], a1 = y1[64 * j]; f32x4 t = xr[64 * j];
            t.x = (t.x + bflo(a0.x)) + bflo(a1.x); t.y = (t.y + bfhi(a0.x)) + bfhi(a1.x); t.z = (t.z + bflo(a0.y)) + bflo(a1.y); t.w = (t.w + bfhi(a0.y)) + bfhi(a1.y);
            v[j] = t; ss += (t.x * t.x + t.y * t.y) + (t.z * t.z + t.w * t.w); }
        const float rs = rsqrtf(wave_sum(ss) * (1.f / D) + EPS);
        const f32x4* gr = (const f32x4*)g_fin + lane; f32x4* orow = (f32x4*)(out + (size_t)m * D) + lane;
#pragma unroll
        for (int j = 0; j < 16; ++j) orow[64 * j] = v[j] * rs * gr[64 * j];
    }
    }
#endif
}

extern "C" void kernel_launch(void* const* d_in, const int* in_sizes, int n_in, void* d_out, int out_size, void* d_ws, size_t ws_size, hipStream_t stream) {
    static int grid = 0;
    if (grid == 0) {
        if (n_in != 25 || out_size != NTOK * D || ws_size < WS_END) { fprintf(stderr, "kernel_launch: unexpected shapes (n_in %d out %d ws %zu)\n", n_in, out_size, ws_size); grid = -1; return; }
        int dev = 0, cus = 0, per_cu = 0;
        if (hipGetDevice(&dev) != hipSuccess || hipDeviceGetAttribute(&cus, hipDeviceAttributeMultiprocessorCount, dev) != hipSuccess) { grid = -1; return; }
        if (hipFuncSetAttribute((const void*)mk_fwd, hipFuncAttributeMaxDynamicSharedMemorySize, LDS_BYTES) != hipSuccess) { fprintf(stderr, "kernel_launch: hipFuncSetAttribute failed\n"); grid = -1; return; }
        if (hipOccupancyMaxActiveBlocksPerMultiprocessor(&per_cu, (const void*)mk_fwd, NWAVES * 64, LDS_BYTES) != hipSuccess || per_cu < 1) { fprintf(stderr, "kernel_launch: occupancy query reports %d blocks per CU\n", per_cu); }
        (void)hipGetLastError();
        grid = cus;
    }
    if (grid < 0) return;
    if (hipMemsetAsync((char*)d_ws + WS_CTL, 0, CTL_ZERO_BYTES, stream) != hipSuccess) return;
    Args a{};
    for (int i = 0; i < 25; ++i) a.in[i] = d_in[i];
    a.out = (float*)d_out; a.ws = (unsigned char*)d_ws;
    hipLaunchKernelGGL(mk_fwd, dim3(grid), dim3(NWAVES * 64), LDS_BYTES, stream, a);
}
```

```cpp
#include <hip/hip_runtime.h>
#include <cstdio>
#include <cstdint>

#ifndef XCD_CONTIG
#define XCD_CONTIG 0
#endif
#if XCD_CONTIG
#define XCD_OF(b) ((b) >> 5)
#define IDX_OF(b) ((b) & 31)
#else
#define XCD_OF(b) ((b) & 7)
#define IDX_OF(b) ((b) >> 3)
#endif
#ifndef P1_ROUND_BARRIER
#define P1_ROUND_BARRIER 0
#endif
#ifndef PG8_SP2
#define PG8_SP2 true
#endif
#ifndef PG8_ALIGN
#define PG8_ALIGN true
#endif
constexpr int NWAVES = 8, NT = 512;
constexpr int D = 4096, NB = 4, SEQ = 2048, NTOK = NB * SEQ, MEML = 256, NMEM = NB * MEML;
constexpr int RW = 2048, GMW = 2048, INC = 12288, RH = 8, RDH = 256, GG = 8, GCG = 256, CHK = 128;
constexpr int XH = 4, XDH = 256, XW = 1024;
constexpr int NE = 64, FF = 512, NSLOT = NTOK * 2;
constexpr float EPS = 1e-6f;
constexpr size_t MiB = 1u << 20;
constexpr size_t WS_CTL = 0, CTL_ZERO_BYTES = 1 * MiB;
constexpr size_t WS_WRT = 1 * MiB;
constexpr size_t WS_WIN = 3 * MiB;
constexpr size_t WS_WOUT = 99 * MiB;
constexpr size_t WS_WQ = 131 * MiB;
constexpr size_t WS_WKV = 139 * MiB;
constexpr size_t WS_WO = 155 * MiB;
constexpr size_t WS_XN = 163 * MiB;
constexpr size_t WS_MN = 227 * MiB;
constexpr size_t WS_COS = 235 * MiB, WS_SIN = 239 * MiB;
constexpr size_t WS_PROJ = 243 * MiB;
constexpr size_t WS_RET = 435 * MiB;
constexpr size_t WS_MIX = 467 * MiB;
constexpr size_t WS_H = 531 * MiB;
constexpr size_t WS_QX = 659 * MiB;
constexpr size_t WS_KVX = 675 * MiB;
constexpr size_t WS_OX = 679 * MiB;
constexpr size_t WS_EID = 695 * MiB;
constexpr size_t WS_HACT = 696 * MiB;
constexpr size_t WS_Y = 712 * MiB;
constexpr size_t WS_SSP = 840 * MiB;
constexpr size_t WS_END = 842 * MiB;
constexpr int CW_TMO = 0, CW_CODE = 1, CW_BAR = 4096;
constexpr int RING_OFF = 0, RING_BYTES = 131072;
constexpr int LDSCTL_OFF = RING_BYTES, MISC_OFF = LDSCTL_OFF + 320;
constexpr int AUX_OFF = LDSCTL_OFF + 1024;
constexpr int LIST_OFF = AUX_OFF, SC_OFF = LIST_OFF + 16384;
constexpr int LDS_BYTES = 163840;

#define GAS __attribute__((address_space(1)))
#define LAS __attribute__((address_space(3)))
typedef unsigned short bf16;
typedef unsigned v4u __attribute__((ext_vector_type(4)));
typedef unsigned v2u __attribute__((ext_vector_type(2)));
typedef float f32x4 __attribute__((ext_vector_type(4)));
typedef short bf16x8 __attribute__((ext_vector_type(8)));
typedef GAS unsigned gu32;
#define RLX_AGENT __ATOMIC_RELAXED, __HIP_MEMORY_SCOPE_AGENT
#define LDS_WAIT() asm volatile("s_waitcnt lgkmcnt(0)" ::: "memory")
#define VM_WAIT() asm volatile("s_waitcnt vmcnt(0)" ::: "memory")
__device__ __forceinline__ unsigned f2bf(float f) { unsigned u = __builtin_bit_cast(unsigned, f); return (u + 0x7fffu + ((u >> 16) & 1u)) >> 16; }
__device__ __forceinline__ unsigned pk2(float lo, float hi) { return f2bf(lo) | (f2bf(hi) << 16); }
__device__ __forceinline__ float bf2f(unsigned b) { return __builtin_bit_cast(float, b << 16); }
__device__ __forceinline__ float bflo(unsigned w) { return __builtin_bit_cast(float, w << 16); }
__device__ __forceinline__ float bfhi(unsigned w) { return __builtin_bit_cast(float, w & 0xffff0000u); }
__device__ __forceinline__ float wave_sum(float v) {
#define WS_DPP(ctrl) v += __builtin_bit_cast(float, __builtin_amdgcn_update_dpp(0, __builtin_bit_cast(int, v), ctrl, 0xF, 0xF, true))
    WS_DPP(0xB1); WS_DPP(0x4E); WS_DPP(0x141); WS_DPP(0x140);
#undef WS_DPP
    const int iv = __builtin_bit_cast(int, v);
    const float r0 = __builtin_bit_cast(float, __builtin_amdgcn_readlane(iv, 0)), r1 = __builtin_bit_cast(float, __builtin_amdgcn_readlane(iv, 16)), r2 = __builtin_bit_cast(float, __builtin_amdgcn_readlane(iv, 32)), r3 = __builtin_bit_cast(float, __builtin_amdgcn_readlane(iv, 48));
    return (r0 + r1) + (r2 + r3);
}
__device__ __forceinline__ float fast_sigmoid(float x) { return __builtin_amdgcn_rcpf(1.0f + __builtin_amdgcn_exp2f(-1.4426950408889634f * x)); }
__device__ __forceinline__ float gelu_tanh_f(float x) { return x * fast_sigmoid(1.5957691216057308f * (x + 0.044715f * x * x * x)); }
__device__ __forceinline__ float silu_f(float x) { return x * fast_sigmoid(x); }
namespace pg8 {
#define PG8_LAS __attribute__((address_space(3)))
typedef unsigned short bf16_t;
typedef short bf16x8 __attribute__((ext_vector_type(8)));
typedef float f32x4 __attribute__((ext_vector_type(4)));
typedef unsigned u32x4 __attribute__((ext_vector_type(4)));
constexpr int BM = 256, BK = 64, HALF = 128, HTB = HALF * BK * 2  , STAGE_BYTES = 8 * HTB, NXCD = 8, WGM = 8;

__host__ __device__ __forceinline__ int lds_byte(int r, int c) { const int st = (r >> 4) * 2 + (c >> 5), rr = r & 15, cc = c & 31, ob = rr * 64 + cc * 2; return st * 1024 + (ob ^ (((ob >> 9) & 1) << 5)); }
__host__ __device__ __forceinline__ void stage_rc(int b, int& R, int& C) { const int st = b / 1024, sb = b % 1024, swz = sb ^ (((sb >> 9) & 1) << 5); R = (st >> 1) * 16 + swz / 64; C = (st & 1) * 32 + (swz % 64) / 2; }
__host__ __device__ __forceinline__ int perm32(int rho) { const int n = rho >> 4, i = rho & 15; return 8 * (i >> 2) + 4 * n + (i & 3); }

struct Unit { int pm, pn; };
struct Gemm { const bf16_t* A; const bf16_t* Bt; int M, N, K; };

struct StaticOrder {
    int nM, nN, nwg, G, c;
    __host__ __device__ void init(int M, int N, int G_, int c_) { nM = M / BM; nN = N / BM; nwg = nM * nN; G = G_; c = c_; }
    __host__ __device__ bool next(int i, Unit& u) const {
        const long L = (long)i * G + c; if (L >= nwg) return false;
        int wgid = (int)L; { const int q = nwg / NXCD, r = nwg % NXCD, xcd = wgid % NXCD, off = wgid / NXCD; wgid = (xcd < r ? xcd * (q + 1) : r * (q + 1) + (xcd - r) * q) + off; }
        const int nig = WGM * nN, gid = wgid / nig, fm = gid * WGM, gsz = (nM - fm) < WGM ? (nM - fm) : WGM;
        u.pm = fm + ((wgid % nig) % gsz); u.pn = (wgid % nig) / gsz; return true;
    }
    __device__ __forceinline__ void a_ready(const Unit&) const {}
    __device__ __forceinline__ void done(const Unit&) const {}
};

__device__ __forceinline__ unsigned cvt_pk_bf16(float lo, float hi) { unsigned r; asm volatile("v_cvt_pk_bf16_f32 %0, %1, %2" : "=v"(r) : "v"(lo), "v"(hi)); return r; }
typedef float f32x2 __attribute__((ext_vector_type(2)));
__device__ __forceinline__ f32x2 gelu_pk(f32x2 v) {
    const f32x2 av = __builtin_elementwise_abs(v), d = av * 0.2316418882f + 1.0f;
    f32x2 t; t.x = __builtin_amdgcn_rcpf(d.x); t.y = __builtin_amdgcn_rcpf(d.y);
    f32x2 q = t * 0.5307027145f + (-0.7265760135f); q = q * t + 0.7107068705f; q = q * t + (-0.142248368f); q = q * t + 0.127414796f; q = q * t;
    const f32x2 s = (v * v) * (-0.72134752044f);
    f32x2 e; e.x = __builtin_amdgcn_exp2f(s.x); e.y = __builtin_amdgcn_exp2f(s.y);
    const f32x2 m = v * (q * e), r = v - m;
    f32x2 o; o.x = v.x < 0.f ? m.x : r.x; o.y = v.y < 0.f ? m.y : r.y; return o;
}

template <int ACT  > struct EpiBf16 {
    static constexpr bool PERM = true, AFTER_DRAIN = false; static_assert(ACT == 0 || ACT == 1, "EpiBf16: ACT is 0 (none) or 1 (gelu_pk)");
    bf16_t* O; int ldc; const float* bias; int split_cols; size_t split_stride; float scale0;
    __device__ __forceinline__ void operator()(const f32x4 (&acc)[2][2][4][2], const Unit& u, int wr, int wc, int fr, int fq) const {
        const int row0 = u.pm * BM + wr * 64 + fr; int colt = u.pn * BM; bf16_t* base = O;
        float sc = 1.f; if (split_cols) { const int t = colt / split_cols; base += (size_t)t * split_stride; colt -= t * split_cols; if (t == 0) sc = scale0; }
        const int col0 = colt + wc * 32 + 8 * fq, bcol0 = u.pn * BM + wc * 32 + 8 * fq;
        f32x4 bv[2][2];
#pragma unroll
        for (int bj = 0; bj < 2; ++bj)
#pragma unroll
            for (int n = 0; n < 2; ++n) bv[bj][n] = bias ? *(const f32x4*)(bias + bcol0 + bj * HALF + 4 * n) : (f32x4){0.f, 0.f, 0.f, 0.f};
#pragma unroll
        for (int ai = 0; ai < 2; ++ai)
#pragma unroll
            for (int m = 0; m < 4; ++m) { bf16_t* rowp = base + (size_t)(row0 + ai * HALF + m * 16) * ldc + col0;
#pragma unroll
                for (int bj = 0; bj < 2; ++bj) { f32x4 v0 = acc[ai][bj][m][0] + bv[bj][0], v1 = acc[ai][bj][m][1] + bv[bj][1];
                    if (ACT == 1) { f32x2 a = gelu_pk((f32x2){v0[0], v0[1]}), b = gelu_pk((f32x2){v0[2], v0[3]}), c = gelu_pk((f32x2){v1[0], v1[1]}), d = gelu_pk((f32x2){v1[2], v1[3]});
                        v0 = (f32x4){a.x, a.y, b.x, b.y}; v1 = (f32x4){c.x, c.y, d.x, d.y}; }
                    v0 = v0 * sc; v1 = v1 * sc; u32x4 w; w.x = cvt_pk_bf16(v0[0], v0[1]); w.y = cvt_pk_bf16(v0[2], v0[3]); w.z = cvt_pk_bf16(v1[0], v1[1]); w.w = cvt_pk_bf16(v1[2], v1[3]);
                    *(u32x4*)(rowp + bj * HALF) = w; } }
    }
};

struct EpiProj {
    static constexpr bool PERM = true, AFTER_DRAIN = false;
    bf16_t* O; const float* cs; const float* sn;
    __device__ __forceinline__ void operator()(const f32x4 (&acc)[2][2][4][2], const Unit& u, int wr, int wc, int fr, int fq) const {
        const int sec = u.pn >> 3;
        const int row0 = u.pm * BM + wr * 64 + fr, j0 = wc * 32 + 8 * fq, col0 = u.pn * BM + j0;
#pragma unroll
        for (int ai = 0; ai < 2; ++ai)
#pragma unroll
            for (int m = 0; m < 4; ++m) {
                const int row = row0 + ai * HALF + m * 16;
                f32x4 a0 = acc[ai][0][m][0], a1 = acc[ai][0][m][1], b0 = acc[ai][1][m][0], b1 = acc[ai][1][m][1];
                if (sec < 2) {
                    const float* cp = cs + (size_t)row * 128 + j0; const float* sp = sn + (size_t)row * 128 + j0;
                    const f32x4 c0 = *(const f32x4*)cp, c1 = *(const f32x4*)(cp + 4), s0 = *(const f32x4*)sp, s1 = *(const f32x4*)(sp + 4);
                    const float sc = sec ? 0.0625f : 1.0f;
                    const f32x4 t0 = (a0 * c0 - b0 * s0) * sc, t1 = (a1 * c1 - b1 * s1) * sc;
                    b0 = (a0 * s0 + b0 * c0) * sc; b1 = (a1 * s1 + b1 * c1) * sc; a0 = t0; a1 = t1;
                } else if (sec == 3) {
#pragma unroll
                    for (int j = 0; j < 4; ++j) { a0[j] = silu_f(a0[j]); a1[j] = silu_f(a1[j]); b0[j] = silu_f(b0[j]); b1[j] = silu_f(b1[j]); }
                } else if (sec >= 4) {
#pragma unroll
                    for (int j = 0; j < 4; ++j) { a0[j] = gelu_tanh_f(a0[j]); a1[j] = gelu_tanh_f(a1[j]); b0[j] = gelu_tanh_f(b0[j]); b1[j] = gelu_tanh_f(b1[j]); }
                }
                bf16_t* rowp = O + (size_t)row * 12288 + col0;
                u32x4 w; w.x = cvt_pk_bf16(a0[0], a0[1]); w.y = cvt_pk_bf16(a0[2], a0[3]); w.z = cvt_pk_bf16(a1[0], a1[1]); w.w = cvt_pk_bf16(a1[2], a1[3]);
                *(u32x4*)rowp = w;
                w.x = cvt_pk_bf16(b0[0], b0[1]); w.y = cvt_pk_bf16(b0[2], b0[3]); w.z = cvt_pk_bf16(b1[0], b1[1]); w.w = cvt_pk_bf16(b1[2], b1[3]);
                *(u32x4*)(rowp + HALF) = w;
            }
    }
};
struct EpiResid {
    static constexpr bool PERM = true, AFTER_DRAIN = false;
    const bf16_t* base; bf16_t* out; int ldc;
    __device__ __forceinline__ void operator()(const f32x4 (&acc)[2][2][4][2], const Unit& u, int wr, int wc, int fr, int fq) const {
        const int row0 = u.pm * BM + wr * 64 + fr, col0 = u.pn * BM + wc * 32 + 8 * fq;
#pragma unroll
        for (int ai = 0; ai < 2; ++ai)
#pragma unroll
            for (int m = 0; m < 4; ++m) { const size_t off = (size_t)(row0 + ai * HALF + m * 16) * ldc + col0;
#pragma unroll
                for (int bj = 0; bj < 2; ++bj) { const u32x4 b = *(const u32x4*)(base + off + bj * HALF); const f32x4 a0 = acc[ai][bj][m][0], a1 = acc[ai][bj][m][1];
                    u32x4 w; w.x = cvt_pk_bf16(bflo(b.x) + a0[0], bfhi(b.x) + a0[1]); w.y = cvt_pk_bf16(bflo(b.y) + a0[2], bfhi(b.y) + a0[3]);
                    w.z = cvt_pk_bf16(bflo(b.z) + a1[0], bfhi(b.z) + a1[1]); w.w = cvt_pk_bf16(bflo(b.w) + a1[2], bfhi(b.w) + a1[3]);
                    *(u32x4*)(out + off + bj * HALF) = w; } }
    }
};

struct EpiResidNorm {
    static constexpr bool PERM = true, AFTER_DRAIN = false;
    const float* base; bf16_t* xb; float* ssp; int ldc;
    __device__ __forceinline__ void operator()(const f32x4 (&acc)[2][2][4][2], const Unit& u, int wr, int wc, int fr, int fq) const {
        const int row0 = u.pm * BM + wr * 64 + fr, col0 = u.pn * BM + wc * 32 + 8 * fq;
#pragma unroll
        for (int ai = 0; ai < 2; ++ai)
#pragma unroll
            for (int m = 0; m < 4; ++m) { const int row = row0 + ai * HALF + m * 16; const size_t off = (size_t)row * ldc + col0; float ss = 0.f;
#pragma unroll
                for (int bj = 0; bj < 2; ++bj) { const f32x4 v0 = *(const f32x4*)(base + off + bj * HALF) + acc[ai][bj][m][0], v1 = *(const f32x4*)(base + off + bj * HALF + 4) + acc[ai][bj][m][1];
                    ss += ((v0[0] * v0[0] + v0[1] * v0[1]) + (v0[2] * v0[2] + v0[3] * v0[3])) + ((v1[0] * v1[0] + v1[1] * v1[1]) + (v1[2] * v1[2] + v1[3] * v1[3]));
                    u32x4 w; w.x = cvt_pk_bf16(v0[0], v0[1]); w.y = cvt_pk_bf16(v0[2], v0[3]); w.z = cvt_pk_bf16(v1[0], v1[1]); w.w = cvt_pk_bf16(v1[2], v1[3]);
                    *(u32x4*)(xb + off + bj * HALF) = w; }
                ss += __shfl_xor(ss, 16); ss += __shfl_xor(ss, 32);
                if (fq == 0) ssp[(size_t)row * 64 + u.pn * 4 + wc] = ss; }
    }
};
struct EpiBf16RowScale {
    static constexpr bool PERM = true, AFTER_DRAIN = false;
    bf16_t* O; int ldc; const PG8_LAS float* rs;
    __device__ __forceinline__ void operator()(const f32x4 (&acc)[2][2][4][2], const Unit& u, int wr, int wc, int fr, int fq) const {
        const int rl0 = wr * 64 + fr, col0 = u.pn * BM + wc * 32 + 8 * fq;
#pragma unroll
        for (int ai = 0; ai < 2; ++ai)
#pragma unroll
            for (int m = 0; m < 4; ++m) { const int rl = rl0 + ai * HALF + m * 16; const float sc = rs[rl]; bf16_t* rowp = O + (size_t)(u.pm * BM + rl) * ldc + col0;
#pragma unroll
                for (int bj = 0; bj < 2; ++bj) { const f32x4 v0 = acc[ai][bj][m][0] * sc, v1 = acc[ai][bj][m][1] * sc;
                    u32x4 w; w.x = cvt_pk_bf16(v0[0], v0[1]); w.y = cvt_pk_bf16(v0[2], v0[3]); w.z = cvt_pk_bf16(v1[0], v1[1]); w.w = cvt_pk_bf16(v1[2], v1[3]);
                    *(u32x4*)(rowp + bj * HALF) = w; } }
    }
};
template <class Epi, class Sched, bool ALIGN_EPI = false, bool SP2 = false>
__device__ __forceinline__ void gemm_phase(PG8_LAS unsigned char* lds, const Gemm g, const Sched& S, const Epi& E) {
    int tid = threadIdx.x; asm volatile("" : "+v"(tid));
    const int wid = __builtin_amdgcn_readfirstlane(tid >> 6), lane = tid & 63, wr = wid >> 2, wc = wid & 3, fr = lane & 15, fq = lane >> 4;
    const int K = g.K, nt = K / BK;
    unsigned voffA[2], voffB[2];
#pragma unroll
    for (int i = 0; i < 2; ++i) { int R, C; stage_rc(tid * 16 + i * 8192, R, C); const int Rb = Epi::PERM ? ((R & ~31) + perm32(R & 31)) : R;
        voffA[i] = (unsigned)(R * K + C) * 2u; voffB[i] = (unsigned)(Rb * K + C) * 2u; }
    const size_t kstep = (size_t)(BK * 2);
    const size_t hstep = (size_t)HALF * K * 2;
    const size_t tstep = 2 * hstep;
    const unsigned ldsw = (unsigned)wid * 1024u;
    const int aoff = lds_byte(wr * 64 + fr, fq * 8), boff = lds_byte(wc * 32 + fr, fq * 8);
#define PG8_SA(b, h) (((b) * 2 + (h)) * HTB)
#define PG8_SB(b, h) ((4 + (b) * 2 + (h)) * HTB)
#define PG8_STAGE(bufoff, gbase, voff) do { _Pragma("unroll") for (int _i = 0; _i < 2; ++_i) \
        __builtin_amdgcn_global_load_lds((const unsigned*)((const char*)(gbase) + (voff)[_i]), (PG8_LAS unsigned*)(lds + (bufoff) + ldsw + _i * 8192), 16, 0, 0); } while (0)
#define PG8_LDA(dst, b, h) do { _Pragma("unroll") for (int m = 0; m < 4; ++m) _Pragma("unroll") for (int k = 0; k < 2; ++k) dst[m][k] = *(const PG8_LAS bf16x8*)(lds + PG8_SA(b, h) + aoff + m * 2048 + k * 1024); } while (0)
#define PG8_LDB(dst, b, h) do { _Pragma("unroll") for (int n = 0; n < 2; ++n) _Pragma("unroll") for (int k = 0; k < 2; ++k) dst[n][k] = *(const PG8_LAS bf16x8*)(lds + PG8_SB(b, h) + boff + n * 2048 + k * 1024); } while (0)
#define PG8_MMA(ai, bj, At, Bt) do { __builtin_amdgcn_s_setprio(1); _Pragma("unroll") for (int m = 0; m < 4; ++m) _Pragma("unroll") for (int n = 0; n < 2; ++n) _Pragma("unroll") for (int k = 0; k < 2; ++k) \
        acc[ai][bj][m][n] = __builtin_amdgcn_mfma_f32_16x16x32_bf16(Bt[n][k], At[m][k], acc[ai][bj][m][n], 0, 0, 0); __builtin_amdgcn_s_setprio(0); } while (0)
#define PG8_WAIT_V(n) asm volatile("s_waitcnt vmcnt(" #n ")" ::: "memory")
#define PG8_WAIT_L(n) asm volatile("s_waitcnt lgkmcnt(" #n ")" ::: "memory")
#define PG8_BAR __builtin_amdgcn_s_barrier()
#define PG8_SCHED __builtin_amdgcn_sched_barrier(0)
    Unit cur, nxt; int ui = 0;
    if (!S.next(0, cur)) return;
    f32x4 acc[2][2][4][2];
#pragma unroll
    for (int a = 0; a < 2; ++a)
#pragma unroll
        for (int b = 0; b < 2; ++b)
#pragma unroll
            for (int m = 0; m < 4; ++m)
#pragma unroll
                for (int n = 0; n < 2; ++n) acc[a][b][m][n] = (f32x4){0.f, 0.f, 0.f, 0.f};
    bf16x8 At[4][2], B0[2][2], B1[2][2];
    const char* cA = (const char*)g.A + (size_t)cur.pm * tstep; const char* cB = (const char*)g.Bt + (size_t)cur.pn * tstep;
    S.a_ready(cur);
    if constexpr (SP2) {
        PG8_STAGE(PG8_SB(0, 0), cB, voffB); PG8_STAGE(PG8_SB(0, 1), cB + hstep, voffB); PG8_STAGE(PG8_SA(0, 0), cA, voffA); PG8_STAGE(PG8_SA(0, 1), cA + hstep, voffA);
        if (wr == 1) PG8_BAR;
        PG8_WAIT_V(2); PG8_BAR;
        PG8_STAGE(PG8_SB(1, 0), cB + kstep, voffB); PG8_STAGE(PG8_SA(1, 0), cA + kstep, voffA); PG8_STAGE(PG8_SB(1, 1), cB + hstep + kstep, voffB);
        PG8_WAIT_V(6); PG8_BAR;
    } else {
        PG8_STAGE(PG8_SB(0, 0), cB, voffB); PG8_STAGE(PG8_SA(0, 0), cA, voffA); PG8_STAGE(PG8_SB(0, 1), cB + hstep, voffB); PG8_STAGE(PG8_SA(0, 1), cA + hstep, voffA);
        if (wr == 1) PG8_BAR;
        PG8_WAIT_V(4); PG8_BAR;
        PG8_STAGE(PG8_SB(1, 0), cB + kstep, voffB); PG8_STAGE(PG8_SA(1, 0), cA + kstep, voffA); PG8_STAGE(PG8_SB(1, 1), cB + hstep + kstep, voffB);
        PG8_WAIT_V(6); PG8_BAR;
    }
    for (;;) {
        const bool has_next = S.next(ui + 1, nxt);
        const char* nA = has_next ? (const char*)g.A + (size_t)nxt.pm * tstep : cA; const char* nB = has_next ? (const char*)g.Bt + (size_t)nxt.pn * tstep : cB;
        for (int t = 0; t < nt; t += 2) {
            const bool last = (t == nt - 2);
            const char* a1 = cA + (size_t)(t + 1) * kstep;
            const char* a2 = last ? nA : cA + (size_t)(t + 2) * kstep; const char* b2 = last ? nB : cB + (size_t)(t + 2) * kstep;
            const char* a3 = a2 + kstep; const char* b3 = b2 + kstep;
            if (last && has_next) S.a_ready(nxt);
            if constexpr (SP2) {
            PG8_LDB(B0, 0, 0); PG8_LDB(B1, 0, 1); PG8_SCHED; PG8_LDA(At, 0, 0); PG8_STAGE(PG8_SA(1, 1), a1 + hstep, voffA);
            PG8_WAIT_V(8); PG8_WAIT_L(0); PG8_BAR; PG8_MMA(0, 0, At, B0); PG8_MMA(0, 1, At, B1); PG8_BAR; PG8_SCHED;
            PG8_LDA(At, 0, 1); PG8_STAGE(PG8_SB(0, 0), b2, voffB); PG8_STAGE(PG8_SB(0, 1), b2 + hstep, voffB); PG8_STAGE(PG8_SA(0, 0), a2, voffA);
            PG8_WAIT_V(8); PG8_WAIT_L(0); PG8_BAR; PG8_MMA(1, 0, At, B0); PG8_MMA(1, 1, At, B1); PG8_BAR; PG8_SCHED;
            PG8_LDB(B0, 1, 0); PG8_LDB(B1, 1, 1); PG8_SCHED; PG8_LDA(At, 1, 0); PG8_STAGE(PG8_SA(0, 1), a2 + hstep, voffA);
            PG8_WAIT_V(8); PG8_WAIT_L(0); PG8_BAR; PG8_MMA(0, 0, At, B0); PG8_MMA(0, 1, At, B1); PG8_BAR; PG8_SCHED;
            PG8_LDA(At, 1, 1); PG8_STAGE(PG8_SB(1, 0), b3, voffB); PG8_STAGE(PG8_SB(1, 1), b3 + hstep, voffB); PG8_STAGE(PG8_SA(1, 0), a3, voffA);
            PG8_WAIT_V(8); PG8_WAIT_L(0); PG8_BAR; PG8_MMA(1, 0, At, B0); PG8_MMA(1, 1, At, B1); PG8_BAR; PG8_SCHED;
            } else {
            PG8_LDB(B0, 0, 0); PG8_SCHED; PG8_LDA(At, 0, 0); PG8_STAGE(PG8_SA(1, 1), a1 + hstep, voffA);
            PG8_WAIT_L(8); PG8_BAR; PG8_WAIT_L(0); PG8_MMA(0, 0, At, B0); PG8_BAR; PG8_SCHED;
            PG8_LDB(B1, 0, 1); PG8_STAGE(PG8_SB(0, 0), b2, voffB);
            PG8_BAR; PG8_WAIT_L(0); PG8_MMA(0, 1, At, B1); PG8_BAR;
            PG8_LDA(At, 0, 1); PG8_STAGE(PG8_SA(0, 0), a2, voffA);
            PG8_BAR; PG8_WAIT_L(0); PG8_MMA(1, 0, At, B0); PG8_BAR; PG8_SCHED;
            PG8_STAGE(PG8_SB(0, 1), b2 + hstep, voffB);
            PG8_WAIT_V(6); PG8_BAR; PG8_MMA(1, 1, At, B1); PG8_BAR;
            PG8_LDB(B0, 1, 0); PG8_SCHED; PG8_LDA(At, 1, 0); PG8_STAGE(PG8_SA(0, 1), a2 + hstep, voffA);
            PG8_WAIT_L(8); PG8_BAR; PG8_WAIT_L(0); PG8_MMA(0, 0, At, B0); PG8_BAR; PG8_SCHED;
            PG8_LDB(B1, 1, 1); PG8_STAGE(PG8_SB(1, 0), b3, voffB);
            PG8_BAR; PG8_WAIT_L(0); PG8_MMA(0, 1, At, B1); PG8_BAR;
            PG8_LDA(At, 1, 1); PG8_STAGE(PG8_SA(1, 0), a3, voffA);
            PG8_BAR; PG8_WAIT_L(0); PG8_MMA(1, 0, At, B0); PG8_BAR; PG8_SCHED;
            PG8_STAGE(PG8_SB(1, 1), b3 + hstep, voffB);
            PG8_WAIT_V(6); PG8_BAR; PG8_MMA(1, 1, At, B1); PG8_BAR;
            }
        }
        if constexpr (ALIGN_EPI) { if (wr == 0) PG8_BAR; }
        if constexpr (!Epi::AFTER_DRAIN) { E(acc, cur, wr, wc, fr, fq); S.done(cur); }
        if (!has_next) break;
#pragma unroll
        for (int a = 0; a < 2; ++a)
#pragma unroll
            for (int b = 0; b < 2; ++b)
#pragma unroll
                for (int m = 0; m < 4; ++m)
#pragma unroll
                    for (int n = 0; n < 2; ++n) acc[a][b][m][n] = (f32x4){0.f, 0.f, 0.f, 0.f};
        cur = nxt; cA = nA; cB = nB; ++ui;
        if constexpr (ALIGN_EPI) { if (wr == 1) PG8_BAR; }
    }
    PG8_WAIT_V(0);
    if constexpr (!ALIGN_EPI) { if (wr == 0) PG8_BAR; }
    PG8_BAR;
    if constexpr (Epi::AFTER_DRAIN) { E.fused(acc, cur, wr, wc, fr, fq, lds, wid, lane); S.done(cur); }
#undef PG8_SA
#undef PG8_SB
#undef PG8_STAGE
#undef PG8_LDA
#undef PG8_LDB
#undef PG8_MMA
#undef PG8_WAIT_V
#undef PG8_WAIT_L
#undef PG8_BAR
#undef PG8_SCHED
}
}
#define XB_TMO      128
#define XB_XCNT(j)  (256  + 64 * (j))
#define XB_XSUB(j)  (1280 + 64 * (j))
#define XB_XGEN(j)  (2304 + 64 * (j))
#define XB_TOP      3328
#define XB_TOPGEN   3392
#define XCD_BAR_WORDS 3456
#define XB_SPIN_CAP (1u << 18)

__device__ __forceinline__ unsigned xb_ld(unsigned* p)              { return __hip_atomic_load(p, __ATOMIC_RELAXED, __HIP_MEMORY_SCOPE_AGENT); }
__device__ __forceinline__ unsigned xb_add(unsigned* p, unsigned v) { return __hip_atomic_fetch_add(p, v, __ATOMIC_RELAXED, __HIP_MEMORY_SCOPE_AGENT); }
__device__ __forceinline__ unsigned xb_xcc_id() { return (unsigned)__builtin_amdgcn_s_getreg((3 << 11) | 20) & 0xFu; }
#define XB_SPIN(cond, bar) do { unsigned _sp = 0; while (cond) { __builtin_amdgcn_s_sleep(1); \
    if ((++_sp & 255u) == 0u) { if (xb_ld(&(bar)[XB_TMO])) break; if (_sp > XB_SPIN_CAP) { atomicAdd(&(bar)[XB_TMO], 1u); break; } } } } while (0)

struct XcdBarrier {
    unsigned* bar; unsigned x;
    volatile LAS unsigned* st;
};

__device__ __forceinline__ XcdBarrier xcd_barrier_post(unsigned* bar, volatile LAS unsigned* st) {
    XcdBarrier b; b.bar = bar; b.x = xb_xcc_id(); b.st = st;
    if (threadIdx.x == 0) (void)xb_add(&bar[XB_XCNT(b.x)], 1u);
    return b;
}
__device__ __forceinline__ void xcd_barrier_complete(unsigned* bar, unsigned x, unsigned& nloc, unsigned& nx) {
    const unsigned G = gridDim.x * gridDim.y * gridDim.z;
    unsigned sum, cnt, mine, sp = 0u;
    for (;;) {
        sum = 0u; cnt = 0u; mine = 0u;
#pragma unroll
        for (unsigned j = 0; j < 16; ++j) { const unsigned c = xb_ld(&bar[XB_XCNT(j)]); sum += c; cnt += (c > 0u) ? 1u : 0u; mine = (j == x) ? c : mine; }
        if (sum == G) break;
        __builtin_amdgcn_s_sleep(1);
        if ((++sp & 255u) == 0u) { if (xb_ld(&bar[XB_TMO])) break; if (sp > XB_SPIN_CAP) { atomicAdd(&bar[XB_TMO], 1u); break; } }
    }
    nloc = mine > 0u ? mine : 1u; nx = cnt > 0u ? cnt : 1u;
}

__device__ __forceinline__ void xcd_barrier(const XcdBarrier& b) {
    asm volatile("s_waitcnt vmcnt(0)" ::: "memory");
    __syncthreads();
    if (threadIdx.x == 0) {
        unsigned* bar = b.bar;
        __builtin_amdgcn_s_waitcnt(0);
        unsigned nloc = b.st[0], nx = b.st[1];
        if (nloc == 0u) { xcd_barrier_complete(bar, b.x, nloc, nx); b.st[0] = nloc; b.st[1] = nx; }
        const unsigned old = xb_add(&bar[XB_XSUB(b.x)], 1u);
        const unsigned gen = old / nloc;
        if (old + 1u == (gen + 1u) * nloc) {
            __builtin_amdgcn_fence(__ATOMIC_RELEASE, "agent");
            asm volatile("s_waitcnt vmcnt(0)" ::: "memory");
            const unsigned og = xb_add(&bar[XB_TOP], 1u);
            const unsigned tg = og / nx;
            if (og + 1u == (tg + 1u) * nx) xb_add(&bar[XB_TOPGEN], 1u);
            else XB_SPIN(xb_ld(&bar[XB_TOPGEN]) == tg, bar);
            __builtin_amdgcn_fence(__ATOMIC_ACQUIRE, "agent");
            xb_add(&bar[XB_XGEN(b.x)], 1u);
            asm volatile("s_waitcnt vmcnt(0)" ::: "memory");
        } else {
            XB_SPIN(xb_ld(&bar[XB_XGEN(b.x)]) == gen, bar);
            __builtin_amdgcn_fence(__ATOMIC_ACQUIRE, "agent");
            asm volatile("s_waitcnt vmcnt(0)" ::: "memory");
        }
    }
    __syncthreads();
}


__device__ __forceinline__ void p0_transpose_item(const float* W, int K, int N, bf16* WT, LAS float* scr, int item, int lane, const float* kscale = nullptr) {
    const int tn_ = N / 128, t_ = item >> 3, w_ = item & 7, kb = (t_ / tn_) * 2 + (w_ >> 2), nb = (t_ % tn_) * 4 + (w_ & 3), k0 = 64 * kb, n0 = 32 * nb;
#pragma unroll 8
    for (int i = 0; i < 32; ++i) { const int kk = 2 * i + (lane >> 5); scr[kk * 33 + (lane & 31)] = __builtin_nontemporal_load(&W[(size_t)(k0 + kk) * N + n0 + (lane & 31)]); }
    LDS_WAIT(); asm volatile("" ::: "memory");
    const int c = lane & 7;
#pragma unroll
    for (int j = 0; j < 4; ++j) { const int n = (lane >> 3) + 8 * j; const LAS float* s = scr + (8 * c) * 33 + n;
        f32x4 ka = {1.f, 1.f, 1.f, 1.f}, kb = {1.f, 1.f, 1.f, 1.f}; if (kscale) { ka = *(const f32x4*)(kscale + k0 + 8 * c); kb = *(const f32x4*)(kscale + k0 + 8 * c + 4); }
        v4u o; o.x = pk2(s[0 * 33] * ka.x, s[1 * 33] * ka.y); o.y = pk2(s[2 * 33] * ka.z, s[3 * 33] * ka.w); o.z = pk2(s[4 * 33] * kb.x, s[5 * 33] * kb.y); o.w = pk2(s[6 * 33] * kb.z, s[7 * 33] * kb.w);
        *(v4u*)(WT + (size_t)(n0 + n) * K + k0 + 8 * c) = o; }
    LDS_WAIT(); asm volatile("" ::: "memory");
}
__device__ __forceinline__ void rms_row_to_bf16(const float* xrow, const f32x4 (&gg)[16], bf16* orow, int lane) {
    const f32x4* xr = (const f32x4*)xrow + lane; f32x4 v[16]; float ss = 0.f;
#pragma unroll
    for (int j = 0; j < 16; ++j) { v[j] = __builtin_nontemporal_load(xr + 64 * j); ss += (v[j].x * v[j].x + v[j].y * v[j].y) + (v[j].z * v[j].z + v[j].w * v[j].w); }
    const float rs = rsqrtf(wave_sum(ss) * (1.f / D) + EPS);
    v2u* o8 = (v2u*)orow + lane;
#pragma unroll
    for (int j = 0; j < 16; ++j) { v2u o; o.x = pk2(v[j].x * rs * gg[j].x, v[j].y * rs * gg[j].y); o.y = pk2(v[j].z * rs * gg[j].z, v[j].w * rs * gg[j].w); o8[64 * j] = o; }
}
__device__ __forceinline__ int block_excl_scan(int v, LAS int* sc, int tid, int& tot) {
    const int lane = tid & 63, w = tid >> 6; int x = v;
#pragma unroll
    for (int o = 1; o < 64; o <<= 1) { const int y = __shfl_up(x, o); if (lane >= o) x += y; }
    __syncthreads();
    if (lane == 63) sc[w] = x;
    __syncthreads();
    int base = 0, t = 0;
#pragma unroll
    for (int i = 0; i < 8; ++i) { const int s = sc[i]; if (i < w) base += s; t += s; }
    tot = t; return base + x - v;
}
__device__ __forceinline__ int build_list(const int* eid, int e, LAS int* list, LAS int* sc, int tid, int& off) {
    const int4* p = (const int4*)(eid + 32 * tid); unsigned mask = 0u; int cm = 0, cl = 0;
#pragma unroll
    for (int i = 0; i < 8; ++i) { const int4 v = p[i];
        if (v.x == e) { mask |= 1u << (4 * i); ++cm; } if (v.y == e) { mask |= 2u << (4 * i); ++cm; } if (v.z == e) { mask |= 4u << (4 * i); ++cm; } if (v.w == e) { mask |= 8u << (4 * i); ++cm; }
        cl += (v.x < e) + (v.y < e) + (v.z < e) + (v.w < e); }
    int tot; int pos = block_excl_scan(cm, sc, tid, tot);
    int tl; (void)block_excl_scan(cl, sc + 8, tid, tl); off = tl;
    while (mask) { const int b = __builtin_ctz(mask); mask &= mask - 1u; list[pos++] = 32 * tid + b; }
    __syncthreads();
    return tot;
}


__device__ __forceinline__ int build_list16(const int* eid, int e, LAS unsigned short* list, LAS int* sc, int tid, int& off) {
    const int4* p = (const int4*)(eid + 32 * tid); unsigned mask = 0u; int cm = 0, cl = 0;
#pragma unroll
    for (int i = 0; i < 8; ++i) { const int4 v = p[i];
        if (v.x == e) { mask |= 1u << (4 * i); ++cm; } if (v.y == e) { mask |= 2u << (4 * i); ++cm; } if (v.z == e) { mask |= 4u << (4 * i); ++cm; } if (v.w == e) { mask |= 8u << (4 * i); ++cm; }
        cl += (v.x < e) + (v.y < e) + (v.z < e) + (v.w < e); }
    int tot; int pos = block_excl_scan(cm, sc, tid, tot);
    int tl; (void)block_excl_scan(cl, sc + 8, tid, tl); off = tl;
    while (mask) { const int b = __builtin_ctz(mask); mask &= mask - 1u; list[pos++] = (unsigned short)(32 * tid + b); }
    __syncthreads();
    return tot;
}
__device__ __forceinline__ int pack4_fp8_sat(float a, float b, float c, float d) {
    a = __builtin_amdgcn_fmed3f(a, -448.0f, 448.0f); b = __builtin_amdgcn_fmed3f(b, -448.0f, 448.0f); c = __builtin_amdgcn_fmed3f(c, -448.0f, 448.0f); d = __builtin_amdgcn_fmed3f(d, -448.0f, 448.0f);
    int w = __builtin_amdgcn_cvt_pk_fp8_f32(a, b, 0, false); return __builtin_amdgcn_cvt_pk_fp8_f32(c, d, w, true); }
__device__ __forceinline__ unsigned cvtpk(float lo, float hi) { unsigned r; asm("v_cvt_pk_bf16_f32 %0, %1, %2" : "=v"(r) : "v"(lo), "v"(hi)); return r; }
typedef float f32x2g __attribute__((ext_vector_type(2)));
typedef short s16x4 __attribute__((ext_vector_type(4)));
#define MOE_KEY(q) ((0x78 >> (2 * (q))) & 3)
typedef int v4i __attribute__((ext_vector_type(4)));
typedef int v8i __attribute__((ext_vector_type(8)));
template <int NSEG, int NSL, class Epi>
__device__ __forceinline__ void moe_kloop(LAS unsigned char* lds, int tid, int wave, int lane, const unsigned char* Asrc, const unsigned (&aoff)[3], int ndma, const float* bptr, int ldb, int K, size_t bsegb, float wscale, const Epi& E) {
    const int fr = lane & 15, fq = lane >> 4, c4 = lane & 31, kq = 2 * wave + (lane >> 5);
    const unsigned ldsbase = (unsigned)(size_t)lds;
    const unsigned b_wr = ldsbase + 49152u + (unsigned)((4 * c4) * 64 + (((kq >> 2) ^ MOE_KEY(c4 & 3)) << 4) + (kq & 3) * 4);
    const unsigned a_dma = (unsigned)(wave * 3072), r_dma = 65536u + (unsigned)(wave * 4096), r_rd = 65536u + (unsigned)((4 * kq) * 512 + c4 * 16);
    const unsigned a_rd = (unsigned)((wave * 16 + fr) * 64), b_rd = 49152u + (unsigned)(fr * 64);
    const unsigned xk = (unsigned)((fq ^ MOE_KEY((fr >> 2) & 3)) << 4);
    const size_t ldbb = (size_t)ldb * 4; const int S = K >> 6, T = S * NSEG;
    f32x4 acc[3][8];
#pragma unroll
    for (int sl = 0; sl < 3; ++sl)
#pragma unroll
        for (int nt = 0; nt < 8; ++nt) acc[sl][nt] = (f32x4){0.f, 0.f, 0.f, 0.f};
#define MOE_GW(g_) (((g_) >= T) ? (g_) - T : (g_))
#define MOE_FETCH_A(g_, bo) do { const GAS char* ap_ = (const GAS char*)Asrc + (MOE_GW(g_) % S) * 64; _Pragma("unroll") for (int i_ = 0; i_ < 3; ++i_) if (i_ < ndma) \
        __builtin_amdgcn_global_load_lds((const GAS unsigned*)(ap_ + aoff[i_]), (LAS unsigned*)(lds + (bo) + a_dma + i_ * 1024), 16, 0, 0); } while (0)
#define MOE_FETCH_B(g_, slot) do { const GAS char* bp_ = (const GAS char*)bptr + (size_t)(MOE_GW(g_) / S) * bsegb + (size_t)((MOE_GW(g_) % S) * 64) * ldbb; _Pragma("unroll") for (int j_ = 0; j_ < 4; ++j_) \
        __builtin_amdgcn_global_load_lds((const GAS unsigned*)(bp_ + (size_t)(2 * j_) * ldbb), (LAS unsigned*)(lds + r_dma + (slot) * 32768u + j_ * 1024), 16, 0, 18  ); } while (0)
#define MOE_CONVERT(slot, bo8) do { f32x4 x_[4]; _Pragma("unroll") for (int i_ = 0; i_ < 4; ++i_) x_[i_] = *(const LAS f32x4*)(lds + r_rd + (slot) * 32768u + i_ * 512); \
        _Pragma("unroll") for (int j_ = 0; j_ < 4; ++j_) { int w_ = __builtin_amdgcn_cvt_pk_fp8_f32(x_[0][j_] * wscale, x_[1][j_] * wscale, 0, false); w_ = __builtin_amdgcn_cvt_pk_fp8_f32(x_[2][j_] * wscale, x_[3][j_] * wscale, w_, true); \
            if ((bo8) == 0u) { if (j_ == 0) asm volatile("ds_write_b32 %0, %1" :: "v"(b_wr), "v"(w_) : "memory"); else if (j_ == 1) asm volatile("ds_write_b32 %0, %1 offset:64" :: "v"(b_wr), "v"(w_) : "memory"); \
                else if (j_ == 2) asm volatile("ds_write_b32 %0, %1 offset:128" :: "v"(b_wr), "v"(w_) : "memory"); else asm volatile("ds_write_b32 %0, %1 offset:192" :: "v"(b_wr), "v"(w_) : "memory"); } \
            else { if (j_ == 0) asm volatile("ds_write_b32 %0, %1 offset:8192" :: "v"(b_wr), "v"(w_) : "memory"); else if (j_ == 1) asm volatile("ds_write_b32 %0, %1 offset:8256" :: "v"(b_wr), "v"(w_) : "memory"); \
                else if (j_ == 2) asm volatile("ds_write_b32 %0, %1 offset:8320" :: "v"(b_wr), "v"(w_) : "memory"); else asm volatile("ds_write_b32 %0, %1 offset:8384" :: "v"(b_wr), "v"(w_) : "memory"); } } } while (0)
#define MOE_DSR(dst, addr, off) asm volatile("ds_read_b128 %0, %1 offset:" #off : "=v"(dst) : "v"(addr))
#define MOE_FENCE() asm volatile("" ::: "memory")
#define MOE_SYNC() do { asm volatile("s_waitcnt lgkmcnt(0)" ::: "memory"); __builtin_amdgcn_s_barrier(); asm volatile("" ::: "memory"); } while (0)
    __builtin_amdgcn_s_waitcnt(0); __builtin_amdgcn_s_barrier(); asm volatile("" ::: "memory");
    MOE_FETCH_A(0, 0u); MOE_FETCH_B(0, 0u); MOE_FETCH_B(1, 1u);
    asm volatile("s_waitcnt vmcnt(0)" ::: "memory");
    MOE_CONVERT(0u, 0u);
    MOE_SYNC();
    v8i fa_[3], fb_[8];
#pragma unroll
    for (int i = 0; i < 3; ++i) fa_[i] = (v8i){0, 0, 0, 0, 0, 0, 0, 0};
#pragma unroll
    for (int i = 0; i < 8; ++i) fb_[i] = (v8i){0, 0, 0, 0, 0, 0, 0, 0};
#define MOE_READS(CUR) v4i ta_[3], tb_[8]; { const unsigned a0_ = a_rd + xk, b0_ = b_rd + xk; if ((CUR) == 0u) { \
          MOE_DSR(ta_[0], a0_, 0); MOE_DSR(ta_[1], a0_, 8192); if (NSL == 3) MOE_DSR(ta_[2], a0_, 16384); \
          MOE_DSR(tb_[0], b0_, 0); MOE_DSR(tb_[1], b0_, 1024); MOE_DSR(tb_[2], b0_, 2048); MOE_DSR(tb_[3], b0_, 3072); MOE_DSR(tb_[4], b0_, 4096); MOE_DSR(tb_[5], b0_, 5120); MOE_DSR(tb_[6], b0_, 6144); MOE_DSR(tb_[7], b0_, 7168); } else { \
          MOE_DSR(ta_[0], a0_, 24576); MOE_DSR(ta_[1], a0_, 32768); if (NSL == 3) MOE_DSR(ta_[2], a0_, 40960); \
          MOE_DSR(tb_[0], b0_, 8192); MOE_DSR(tb_[1], b0_, 9216); MOE_DSR(tb_[2], b0_, 10240); MOE_DSR(tb_[3], b0_, 11264); MOE_DSR(tb_[4], b0_, 12288); MOE_DSR(tb_[5], b0_, 13312); MOE_DSR(tb_[6], b0_, 14336); MOE_DSR(tb_[7], b0_, 15360); } }
#define MOE_WAIT_LO() do { if (NSL == 3) asm volatile("s_waitcnt lgkmcnt(4)" : "+v"(ta_[0]), "+v"(ta_[1]), "+v"(ta_[2]), "+v"(tb_[0]), "+v"(tb_[1]), "+v"(tb_[2]), "+v"(tb_[3]) :: "memory"); \
          else asm volatile("s_waitcnt lgkmcnt(4)" : "+v"(ta_[0]), "+v"(ta_[1]), "+v"(tb_[0]), "+v"(tb_[1]), "+v"(tb_[2]), "+v"(tb_[3]) :: "memory"); } while (0)
#define MOE_WAIT_HI() asm volatile("s_waitcnt lgkmcnt(0)" : "+v"(tb_[4]), "+v"(tb_[5]), "+v"(tb_[6]), "+v"(tb_[7]) :: "memory")
#define MOE_PUT(dst, src, H) do { (dst)[4 * (H) + 0] = (src)[0]; (dst)[4 * (H) + 1] = (src)[1]; (dst)[4 * (H) + 2] = (src)[2]; (dst)[4 * (H) + 3] = (src)[3]; } while (0)
#pragma unroll 1
    for (int s = 0; s < T; s += 2) {
        {
            MOE_FETCH_A(s + 1, 24576u);
            MOE_READS(0u);
            MOE_FENCE(); MOE_FETCH_B(s + 2, 0u); MOE_FENCE();
            MOE_WAIT_LO(); MOE_WAIT_HI();
#pragma unroll
            for (int sl_ = 0; sl_ < NSL; ++sl_) MOE_PUT(fa_[sl_], ta_[sl_], 0);
#pragma unroll
            for (int nt_ = 0; nt_ < 8; ++nt_) MOE_PUT(fb_[nt_], tb_[nt_], 0);
            asm volatile("s_waitcnt vmcnt(4)" ::: "memory");
            MOE_CONVERT(1u, 8192u);
            MOE_SYNC();
        }
        {
            MOE_FETCH_A(s + 2, 0u);
            MOE_READS(1u);
            MOE_WAIT_LO();
#pragma unroll
            for (int sl_ = 0; sl_ < NSL; ++sl_) MOE_PUT(fa_[sl_], ta_[sl_], 1);
#pragma unroll
            for (int nt_ = 0; nt_ < 4; ++nt_) MOE_PUT(fb_[nt_], tb_[nt_], 1);
#pragma unroll
            for (int nt_ = 0; nt_ < 4; ++nt_)
#pragma unroll
                for (int sl_ = 0; sl_ < NSL; ++sl_) acc[sl_][nt_] = __builtin_amdgcn_mfma_scale_f32_16x16x128_f8f6f4(fb_[nt_], fa_[sl_], acc[sl_][nt_], 0, 0, 0, 0, 0, 0);
            MOE_FENCE(); MOE_FETCH_B(s + 3, 1u); MOE_FENCE();
            MOE_WAIT_HI();
#pragma unroll
            for (int nt_ = 4; nt_ < 8; ++nt_) MOE_PUT(fb_[nt_], tb_[nt_], 1);
#pragma unroll
            for (int nt_ = 4; nt_ < 8; ++nt_)
#pragma unroll
                for (int sl_ = 0; sl_ < NSL; ++sl_) acc[sl_][nt_] = __builtin_amdgcn_mfma_scale_f32_16x16x128_f8f6f4(fb_[nt_], fa_[sl_], acc[sl_][nt_], 0, 0, 0, 0, 0, 0);
            MOE_FENCE();
            asm volatile("s_waitcnt vmcnt(4)" ::: "memory");
            MOE_CONVERT(0u, 0u);
            MOE_SYNC();
        }
        if (NSEG > 1 && (s + 2) % S == 0) { E(s / S, acc);
#pragma unroll
            for (int sl = 0; sl < 3; ++sl)
#pragma unroll
                for (int nt = 0; nt < 8; ++nt) acc[sl][nt] = (f32x4){0.f, 0.f, 0.f, 0.f}; }
    }
    asm volatile("s_waitcnt vmcnt(0)" ::: "memory"); MOE_SYNC();
    if (NSEG == 1) E(0, acc);
#undef MOE_GW
#undef MOE_FETCH_A
#undef MOE_FETCH_B
#undef MOE_CONVERT
#undef MOE_FENCE
#undef MOE_DSR
#undef MOE_READS
#undef MOE_WAIT_LO
#undef MOE_WAIT_HI
#undef MOE_PUT
#undef MOE_SYNC
}

struct Args { const void* in[25]; float* out; unsigned char* ws; };
#define PTRS() const __attribute__((address_space(4))) Args* K_ = (const __attribute__((address_space(4))) Args*)__builtin_amdgcn_kernarg_segment_ptr(); asm volatile("" : "+s"(K_)); \
    int tid; asm volatile("v_mbcnt_lo_u32_b32 %0, -1, 0\n\tv_mbcnt_hi_u32_b32 %0, -1, %0" : "=v"(tid)); tid |= wave0 << 6; const int lane = tid & 63, wave = __builtin_amdgcn_readfirstlane(tid >> 6); \
    const int G = gridDim.x, bid = blockIdx.x, gw = bid * NWAVES + wave, NGW = G * NWAVES, gtid = bid * NT + tid, NGT = G * NT; (void)lane; (void)gw; (void)NGW; (void)gtid; (void)NGT; \
    unsigned char* ws = K_->ws; \
    const float* x = (const float*)K_->in[0]; const float* mem = (const float*)K_->in[1]; const int* pos = (const int*)K_->in[2]; \
    const float* g_mix = (const float*)K_->in[3]; const float* w_in = (const float*)K_->in[4]; const float* ret_g = (const float*)K_->in[5]; \
    const float* ln_g = (const float*)K_->in[6]; const float* ln_b = (const float*)K_->in[7]; const float* gm_ws = (const float*)K_->in[8]; const float* gm_bs = (const float*)K_->in[9]; \
    const float* w_out = (const float*)K_->in[10]; const float* g_xa = (const float*)K_->in[11]; const float* g_mem = (const float*)K_->in[12]; \
    const float* wq = (const float*)K_->in[13]; const float* wkv = (const float*)K_->in[14]; const float* wo = (const float*)K_->in[15]; \
    const float* g_moe = (const float*)K_->in[16]; const float* rgw = (const float*)K_->in[17]; const float* rgb = (const float*)K_->in[18]; \
    const float* rew = (const float*)K_->in[19]; const float* reb = (const float*)K_->in[20]; \
    const float* wg = (const float*)K_->in[21]; const float* wu = (const float*)K_->in[22]; const float* wd = (const float*)K_->in[23]; const float* g_fin = (const float*)K_->in[24]; \
    float* out = K_->out; \
    float* WrT = (float*)(ws + WS_WRT); \
    bf16* WtIn = (bf16*)(ws + WS_WIN); bf16* WtOut = (bf16*)(ws + WS_WOUT); bf16* WtQ = (bf16*)(ws + WS_WQ); bf16* WtKV = (bf16*)(ws + WS_WKV); bf16* WtO = (bf16*)(ws + WS_WO); \
    bf16* XN = (bf16*)(ws + WS_XN); bf16* MN = (bf16*)(ws + WS_MN); float* COS = (float*)(ws + WS_COS); float* SIN = (float*)(ws + WS_SIN); \
    bf16* PROJ = (bf16*)(ws + WS_PROJ); bf16* RET = (bf16*)(ws + WS_RET); bf16* MIX = (bf16*)(ws + WS_MIX); bf16* HB = (bf16*)(ws + WS_H); \
    bf16* QX = (bf16*)(ws + WS_QX); bf16* KX = (bf16*)(ws + WS_KVX); bf16* VT = KX + (size_t)NMEM * XW; bf16* OX = (bf16*)(ws + WS_OX); \
    int* EID = (int*)(ws + WS_EID); float* GATE = (float*)(ws + WS_EID + 65536); int* SLOTS = (int*)(ws + WS_EID + 131072); int* OFFCNT = (int*)(ws + WS_EID + 196608); float* GSTAT = (float*)(ws + WS_EID + 262144); float* SSP = (float*)(ws + WS_SSP); \
    unsigned char* HACT8 = (unsigned char*)(ws + WS_HACT); unsigned char* XN8 = (unsigned char*)(ws + WS_XN); unsigned char* Y8 = (unsigned char*)(ws + WS_Y);
__global__ void __launch_bounds__(NWAVES * 64, 2) mk_fwd(Args a) {
    extern __shared__ __attribute__((aligned(16))) unsigned char lds_raw[];
    LAS unsigned char* lds = (LAS unsigned char*)lds_raw;
    const int tid0 = threadIdx.x;
    const int wave0 = __builtin_amdgcn_readfirstlane(tid0 >> 6);
    for (int u = tid0; u < (LDS_BYTES - LDSCTL_OFF) / 4; u += NT) ((LAS unsigned*)(lds + LDSCTL_OFF))[u] = 0u;
    __syncthreads();
    volatile LAS unsigned* MISC = (volatile LAS unsigned*)(lds + MISC_OFF);
    XcdBarrier bar; { PTRS(); bar = xcd_barrier_post((unsigned*)(ws + WS_CTL) + CW_BAR, MISC + 8); }

#ifndef SK_P0
    { PTRS();
    {
        LAS float* scr = (LAS float*)(lds + RING_OFF + wave * 16384);
        constexpr int I_IN = (D / 64) * (INC / 32), I_OUT = (D / 64) * (D / 32), I_Q = (D / 64) * (XW / 32), I_KV = (D / 64) * (2 * XW / 32), I_O = (XW / 64) * (D / 32);
        constexpr int NITEMS = I_IN + I_OUT + I_Q + I_KV + I_O;
        for (int it = gw; it < NITEMS; it += NGW) {
            int r = it;
            if (r < I_IN) { p0_transpose_item(w_in, D, INC, WtIn, scr, r, lane); continue; } r -= I_IN;
            if (r < I_OUT) { p0_transpose_item(w_out, D, D, WtOut, scr, r, lane); continue; } r -= I_OUT;
            if (r < I_Q) { p0_transpose_item(wq, D, XW, WtQ, scr, r, lane, g_xa); continue; } r -= I_Q;
            if (r < I_KV) { p0_transpose_item(wkv, D, 2 * XW, WtKV, scr, r, lane); continue; } r -= I_KV;
            p0_transpose_item(wo, XW, D, WtO, scr, r, lane);
        }
        for (int i = gtid; i < 72 * D; i += NGT) { const int j = i >> 12, k = i & (D - 1); WrT[i] = j < 8 ? rgw[(size_t)k * 8 + j] : rew[(size_t)k * 64 + (j - 8)]; }
        { f32x4 gg[16];
#pragma unroll
          for (int j = 0; j < 16; ++j) gg[j] = ((const f32x4*)g_mix)[lane + 64 * j];
          for (int m = gw; m < NTOK; m += NGW) rms_row_to_bf16(x + (size_t)m * D, gg, XN + (size_t)m * D, lane);
#pragma unroll
          for (int j = 0; j < 16; ++j) gg[j] = ((const f32x4*)g_mem)[lane + 64 * j];
          for (int m = gw; m < NMEM; m += NGW) rms_row_to_bf16(mem + (size_t)m * D, gg, MN + (size_t)m * D, lane); }
        for (int i = gtid; i < NTOK * 128; i += NGT) { const int j = i & 127, row = i >> 7; const float inv = exp2f(-(float)(2 * j) * (13.287712379549449f / 256.0f)); const float ang = (float)pos[row] * inv;
            float rev = ang * 0.15915494309189535f; rev -= floorf(rev); COS[i] = __builtin_amdgcn_cosf(rev); SIN[i] = __builtin_amdgcn_sinf(rev); }
    }
    xcd_barrier(bar);

    }
#endif
#ifndef SK_P1
    { PTRS();
    {   pg8::Gemm g{XN, WtIn, NTOK, INC, D}; pg8::StaticOrder S; S.init(NTOK, INC, G, bid);
        pg8::EpiProj E{PROJ, COS, SIN};
#if P1_ROUND_BARRIER
        struct RoundUnit { pg8::StaticOrder S; int r; __device__ bool next(int i, pg8::Unit& o) const { return i == 0 && S.next(r, o); } __device__ __forceinline__ void a_ready(const pg8::Unit&) const {} __device__ __forceinline__ void done(const pg8::Unit&) const {} };
        const int rounds = (S.nwg + G - 1) / G;
#pragma unroll 1
        for (int r = 0; r < rounds; ++r) { RoundUnit R{S, r}; pg8::gemm_phase<pg8::EpiProj, RoundUnit, PG8_ALIGN, PG8_SP2>(lds + RING_OFF, g, R, E); if (r + 1 < rounds) xcd_barrier(bar); }
#else
        pg8::gemm_phase<pg8::EpiProj, pg8::StaticOrder, PG8_ALIGN, PG8_SP2>(lds + RING_OFF, g, S, E);
#endif
    }
    xcd_barrier(bar);

    }
#endif
#ifndef SK_P2
    { PTRS();
    {
        constexpr int KT_OFF = 0, VT_OFF = 65536, VS_OFF = VT_OFF + 8704, ST_OFF = VS_OFF + 8704;
        const int fr = lane & 15, fq = lane >> 4, qt = wave < 4 ? wave : 11 - wave;
        const int kswz = ((fr & 3) << 2) | ((fr >> 2) & 3);
        for (int ui = 0; ; ++ui) {
            int vb; if (G == 256) { if (ui >= 1) break; vb = (((bid & 7) * 4 + (bid >> 6)) << 3) | ((bid >> 3) & 7); } else { vb = bid + ui * G; if (vb >= NB * RH * 8) break; }
            const int es = vb & 7, h = (vb >> 3) & 7, b = vb >> 6;
            const float l2g = log2f(1.0f - exp2f(-5.0f - (float)h));
            float An[8], Br[4], rsc[4];
#pragma unroll
            for (int nt = 0; nt < 8; ++nt) An[nt] = exp2f(16.0f * (float)(qt - nt) * l2g);
#pragma unroll
            for (int r = 0; r < 4; ++r) { Br[r] = exp2f((float)(fr - 4 * fq - r) * l2g); rsc[r] = exp2f((float)(16 * qt + 4 * fq + r + 1) * l2g); }
            const float cdec = exp2f(128.0f * l2g);
            const float vsc0 = exp2f((float)(127 - (tid >> 3)) * l2g), vsc1 = exp2f((float)(127 - 64 - (tid >> 3)) * l2g);
            f32x4 st[2][2];
#pragma unroll
            for (int et = 0; et < 2; ++et)
#pragma unroll
                for (int dt = 0; dt < 2; ++dt) st[et][dt] = (f32x4){0.f, 0.f, 0.f, 0.f};
            __syncthreads();
            { const v4u z = {0u, 0u, 0u, 0u}; *(LAS v4u*)(lds + ST_OFF + tid * 32) = z; *(LAS v4u*)(lds + ST_OFF + tid * 32 + 16) = z; }
            for (int c = 0; c < SEQ / CHK; ++c) {
                const size_t tok0 = (size_t)b * SEQ + (size_t)c * CHK;
                {
                    const int ch32 = tid & 31, rb = tid >> 5; const bf16* src = PROJ + (tok0 + rb) * INC + RW + h * RDH + ch32 * 8;
                    const unsigned woff = (unsigned)((ch32 >> 4) * 32768 + 256 * rb + 16 * ((ch32 & 15) ^ (((rb & 3) << 2) | ((rb >> 2) & 3))));
                    v4u kv[8];
#pragma unroll
                    for (int i = 0; i < 8; ++i) kv[i] = *(const v4u*)(src + (size_t)(16 * i) * INC);
#pragma unroll
                    for (int i = 0; i < 8; ++i) *(LAS v4u*)(lds + KT_OFF + woff + i * 4096) = kv[i];
                }
                {
                    const int eg = tid & 7, tk = tid >> 3;
#pragma unroll
                    for (int i = 0; i < 2; ++i) { const v2u vv = *(const v2u*)(PROJ + (tok0 + tk + 64 * i) * INC + 2 * RW + h * RDH + es * 32 + eg * 4); const float sc = i ? vsc1 : vsc0;
                        LAS bf16* vt = (LAS bf16*)(lds + VT_OFF) + (4 * eg) * 136 + tk + 64 * i; LAS bf16* vs = (LAS bf16*)(lds + VS_OFF) + (4 * eg) * 136 + tk + 64 * i;
                        vt[0] = (bf16)(vv.x & 0xffffu); vt[136] = (bf16)(vv.x >> 16); vt[272] = (bf16)(vv.y & 0xffffu); vt[408] = (bf16)(vv.y >> 16);
                        vs[0] = (bf16)f2bf(bflo(vv.x) * sc); vs[136] = (bf16)f2bf(bfhi(vv.x) * sc); vs[272] = (bf16)f2bf(bflo(vv.y) * sc); vs[408] = (bf16)f2bf(bfhi(vv.y) * sc); }
                }
                bf16x8 qf[8];
                { const bf16* qsrc = PROJ + (tok0 + 16 * qt + fr) * INC + h * RDH + 8 * fq;
#pragma unroll
                  for (int s8 = 0; s8 < 8; ++s8) qf[s8] = *(const bf16x8*)(qsrc + 32 * s8); }
                __syncthreads();
                v4u pk[4];
#pragma unroll
                for (int s2 = 0; s2 < 4; ++s2) { v4u pw = {0u, 0u, 0u, 0u};
                    if (2 * s2 <= qt) {
                        f32x4 a0 = {0.f, 0.f, 0.f, 0.f}, a1 = {0.f, 0.f, 0.f, 0.f};
#pragma unroll
                        for (int s8 = 0; s8 < 8; ++s8) { const unsigned ko = (unsigned)((s8 >> 2) * 32768 + 256 * (32 * s2 + fr) + 16 * ((4 * (s8 & 3) + fq) ^ kswz));
                            const bf16x8 kf0 = *(const LAS bf16x8*)(lds + KT_OFF + ko), kf1 = *(const LAS bf16x8*)(lds + KT_OFF + ko + 4096);
                            a0 = __builtin_amdgcn_mfma_f32_16x16x32_bf16(kf0, qf[s8], a0, 0, 0, 0); a1 = __builtin_amdgcn_mfma_f32_16x16x32_bf16(kf1, qf[s8], a1, 0, 0, 0); }
                        { const int nt = 2 * s2; float p0 = a0[0] * An[nt] * Br[0], p1 = a0[1] * An[nt] * Br[1], p2 = a0[2] * An[nt] * Br[2], p3 = a0[3] * An[nt] * Br[3];
                          if (nt == qt) { const int dq = fr - 4 * fq; p0 = dq >= 0 ? p0 : 0.f; p1 = dq >= 1 ? p1 : 0.f; p2 = dq >= 2 ? p2 : 0.f; p3 = dq >= 3 ? p3 : 0.f; }
                          pw.x = cvtpk(p0, p1); pw.y = cvtpk(p2, p3); }
                        if (2 * s2 + 1 <= qt) { const int nt = 2 * s2 + 1; float p0 = a1[0] * An[nt] * Br[0], p1 = a1[1] * An[nt] * Br[1], p2 = a1[2] * An[nt] * Br[2], p3 = a1[3] * An[nt] * Br[3];
                          if (nt == qt) { const int dq = fr - 4 * fq; p0 = dq >= 0 ? p0 : 0.f; p1 = dq >= 1 ? p1 : 0.f; p2 = dq >= 2 ? p2 : 0.f; p3 = dq >= 3 ? p3 : 0.f; }
                          pw.z = cvtpk(p0, p1); pw.w = cvtpk(p2, p3); } }
                    pk[s2] = pw; }
                f32x4 oi[2], oc[2];
#pragma unroll
                for (int et = 0; et < 2; ++et) { oi[et] = (f32x4){0.f, 0.f, 0.f, 0.f}; oc[et] = (f32x4){0.f, 0.f, 0.f, 0.f}; }
#pragma unroll
                for (int s2 = 0; s2 < 4; ++s2) if (2 * s2 <= qt) {
#pragma unroll
                    for (int et = 0; et < 2; ++et) { const LAS unsigned char* vp = lds + VT_OFF + (16 * et + fr) * 272 + (32 * s2 + 4 * fq) * 2;
                        const v2u lo = *(const LAS v2u*)vp, hi = *(const LAS v2u*)(vp + 32); const v4u vw = {lo.x, lo.y, hi.x, hi.y};
                        oi[et] = __builtin_amdgcn_mfma_f32_16x16x32_bf16(__builtin_bit_cast(bf16x8, pk[s2]), __builtin_bit_cast(bf16x8, vw), oi[et], 0, 0, 0); } }
#pragma unroll
                for (int s8 = 0; s8 < 8; ++s8)
#pragma unroll
                    for (int et = 0; et < 2; ++et) { const bf16x8 sf = *(const LAS bf16x8*)(lds + ST_OFF + (16 * et + fr) * 512 + (((4 * s8 + fq) ^ fr) << 4));
                        oc[et] = __builtin_amdgcn_mfma_f32_16x16x32_bf16(qf[s8], sf, oc[et], 0, 0, 0); }
#pragma unroll
                for (int et = 0; et < 2; ++et)
#pragma unroll
                    for (int r = 0; r < 4; ++r) RET[(tok0 + 16 * qt + 4 * fq + r) * RW + h * RDH + es * 32 + 16 * et + fr] = (bf16)f2bf(oi[et][r] + rsc[r] * oc[et][r]);
#pragma unroll
                for (int et = 0; et < 2; ++et)
#pragma unroll
                    for (int dt = 0; dt < 2; ++dt) st[et][dt] = st[et][dt] * cdec;
#pragma unroll
                for (int ks = 0; ks < 4; ++ks) { bf16x8 af[2];
#pragma unroll
                    for (int et = 0; et < 2; ++et) af[et] = *(const LAS bf16x8*)(lds + VS_OFF + (16 * et + fr) * 272 + 64 * ks + 16 * fq);
#pragma unroll
                    for (int dt = 0; dt < 2; ++dt) { const int cc = 2 * wave + dt, q_ = fr >> 2, p_ = fr & 3;
                        const int r0 = 32 * ks + 8 * fq + q_, r1 = r0 + 4;
                        const unsigned a0 = (unsigned)((cc >> 3) * 32768 + 256 * r0 + 16 * ((2 * (cc & 7) + (p_ >> 1)) ^ (((r0 & 3) << 2) | ((r0 >> 2) & 3))) + 8 * (p_ & 1));
                        const unsigned a1 = (unsigned)((cc >> 3) * 32768 + 256 * r1 + 16 * ((2 * (cc & 7) + (p_ >> 1)) ^ (((r1 & 3) << 2) | ((r1 >> 2) & 3))) + 8 * (p_ & 1));
                        const s16x4 t0 = __builtin_amdgcn_ds_read_tr16_b64_v4i16((LAS s16x4*)(lds + KT_OFF + a0)), t1 = __builtin_amdgcn_ds_read_tr16_b64_v4i16((LAS s16x4*)(lds + KT_OFF + a1));
                        const bf16x8 kf = __builtin_shufflevector(t0, t1, 0, 1, 2, 3, 4, 5, 6, 7);
#pragma unroll
                        for (int et = 0; et < 2; ++et) st[et][dt] = __builtin_amdgcn_mfma_f32_16x16x32_bf16(af[et], kf, st[et][dt], 0, 0, 0); } }
                __syncthreads();
#pragma unroll
                for (int et = 0; et < 2; ++et)
#pragma unroll
                    for (int dt = 0; dt < 2; ++dt)
#pragma unroll
                        for (int r = 0; r < 4; ++r) { const int e = 16 * et + 4 * fq + r, d = 32 * wave + 16 * dt + fr;
                            *(LAS bf16*)(lds + ST_OFF + e * 512 + ((((d >> 3) ^ (e & 15)) << 4) + (d & 7) * 2)) = (bf16)f2bf(st[et][dt][r]); }
            }
        }
        for (int m = gw; m < NTOK; m += NGW) { const bf16* p_ = PROJ + (size_t)m * INC + 5 * RW + lane * 8; float xv[32]; float s_ = 0.f;
#pragma unroll
            for (int i = 0; i < 4; ++i) { const v4u w = *(const v4u*)(p_ + 512 * i); xv[8 * i + 0] = bflo(w.x); xv[8 * i + 1] = bfhi(w.x); xv[8 * i + 2] = bflo(w.y); xv[8 * i + 3] = bfhi(w.y); xv[8 * i + 4] = bflo(w.z); xv[8 * i + 5] = bfhi(w.z); xv[8 * i + 6] = bflo(w.w); xv[8 * i + 7] = bfhi(w.w); }
#pragma unroll
            for (int i = 0; i < 32; ++i) s_ += xv[i];
            const float mu = wave_sum(s_) * (1.f / GMW); float q_ = 0.f;
#pragma unroll
            for (int i = 0; i < 32; ++i) { const float d_ = xv[i] - mu; q_ += d_ * d_; }
            const float rs = rsqrtf(wave_sum(q_) * (1.f / GMW) + EPS);
            if (lane == 0) { GSTAT[2 * m] = mu; GSTAT[2 * m + 1] = rs; } }
    }
    xcd_barrier(bar);
    }
#endif

#ifndef SK_P3
    { PTRS();
    for (int row = gw; row < NTOK; row += NGW) {
        const int c0 = lane * 32; const bf16* rp = RET + (size_t)row * RW + c0; const bf16* gp = PROJ + (size_t)row * INC + 3 * RW + c0;
        v4u rv[4], gv[4];
#pragma unroll
        for (int i = 0; i < 4; ++i) { rv[i] = *(const v4u*)(rp + 8 * i); gv[i] = *(const v4u*)(gp + 8 * i); }
        float v[32]; float s_ = 0.f;
#pragma unroll
        for (int i = 0; i < 4; ++i) { v[8 * i + 0] = bflo(rv[i].x); v[8 * i + 1] = bfhi(rv[i].x); v[8 * i + 2] = bflo(rv[i].y); v[8 * i + 3] = bfhi(rv[i].y); v[8 * i + 4] = bflo(rv[i].z); v[8 * i + 5] = bfhi(rv[i].z); v[8 * i + 6] = bflo(rv[i].w); v[8 * i + 7] = bfhi(rv[i].w); }
#pragma unroll
        for (int i = 0; i < 32; ++i) s_ += v[i];
        s_ += __shfl_xor(s_, 1); s_ += __shfl_xor(s_, 2); s_ += __shfl_xor(s_, 4);
        const float mu = s_ * (1.f / 256.f); float q_ = 0.f;
#pragma unroll
        for (int i = 0; i < 32; ++i) { v[i] -= mu; q_ += v[i] * v[i]; }
        q_ += __shfl_xor(q_, 1); q_ += __shfl_xor(q_, 2); q_ += __shfl_xor(q_, 4);
        const float rs = rsqrtf(q_ * (1.f / 256.f) + EPS);
#pragma unroll
        for (int i = 0; i < 4; ++i) { const f32x4 ga = *(const f32x4*)(ret_g + c0 + 8 * i), gb = *(const f32x4*)(ret_g + c0 + 8 * i + 4); v4u o;
            o.x = pk2(bflo(gv[i].x) * (v[8 * i + 0] * rs * ga.x), bfhi(gv[i].x) * (v[8 * i + 1] * rs * ga.y)); o.y = pk2(bflo(gv[i].y) * (v[8 * i + 2] * rs * ga.z), bfhi(gv[i].y) * (v[8 * i + 3] * rs * ga.w));
            o.z = pk2(bflo(gv[i].z) * (v[8 * i + 4] * rs * gb.x), bfhi(gv[i].z) * (v[8 * i + 5] * rs * gb.y)); o.w = pk2(bflo(gv[i].w) * (v[8 * i + 6] * rs * gb.z), bfhi(gv[i].w) * (v[8 * i + 7] * rs * gb.w));
            *(v4u*)(MIX + (size_t)row * D + c0 + 8 * i) = o; }
    }
    {
        const int fr = lane & 15, fq = lane >> 4, tt = wave < 4 ? wave : 11 - wave, q_ = fr >> 2, p_ = fr & 3;
        for (int ui = 0; ; ++ui) {
            int un; if (G == 256) { if (ui >= 2) break; un = (((bid & 7) * 8 + ui * 4 + (bid >> 6)) << 3) | ((bid >> 3) & 7); } else { un = bid + ui * G; if (un >= NB * (SEQ / CHK) * GG) break; }
            const int g = un & 7, n = (un >> 3) & 15, b = un >> 7; const size_t row0 = (size_t)b * SEQ + n * CHK;
            __syncthreads();
            {   const int ch = tid & 31, rb = tid >> 5; const int c0 = g * GCG + ch * 8;
                const f32x4 lga = *(const f32x4*)(ln_g + c0), lgb = *(const f32x4*)(ln_g + c0 + 4), lba = *(const f32x4*)(ln_b + c0), lbb = *(const f32x4*)(ln_b + c0 + 4);
                const unsigned woff = (unsigned)((ch >> 4) * 32768 + 256 * rb + 16 * ((ch & 15) ^ (((rb & 3) << 2) | ((rb >> 2) & 3))));
#pragma unroll
                for (int i = 0; i < 8; ++i) { const size_t row = row0 + rb + 16 * i; const v4u w = *(const v4u*)(PROJ + row * INC + 5 * RW + c0); const float mu = GSTAT[2 * row], rs = GSTAT[2 * row + 1];
                    v4u o; o.x = cvtpk((bflo(w.x) - mu) * rs * lga.x + lba.x, (bfhi(w.x) - mu) * rs * lga.y + lba.y); o.y = cvtpk((bflo(w.y) - mu) * rs * lga.z + lba.z, (bfhi(w.y) - mu) * rs * lga.w + lba.w);
                    o.z = cvtpk((bflo(w.z) - mu) * rs * lgb.x + lbb.x, (bfhi(w.z) - mu) * rs * lgb.y + lbb.y); o.w = cvtpk((bflo(w.w) - mu) * rs * lgb.z + lbb.z, (bfhi(w.w) - mu) * rs * lgb.w + lbb.w);
                    *(LAS v4u*)(lds + woff + i * 4096) = o; } }
            const int t_ = 16 * tt + fr, kmax = (16 * tt + 15) >> 5;
            v4u wf[4];
#pragma unroll
            for (int ks = 0; ks < 4; ++ks) { v4u w = {0u, 0u, 0u, 0u};
                if (ks <= kmax) { const float* wp = gm_ws + ((size_t)g * CHK + t_) * CHK + 32 * ks + 8 * fq; const f32x4 a = *(const f32x4*)wp, c = *(const f32x4*)(wp + 4); const int s0 = 32 * ks + 8 * fq;
                    w.x = cvtpk(s0 + 0 <= t_ ? a.x : 0.f, s0 + 1 <= t_ ? a.y : 0.f); w.y = cvtpk(s0 + 2 <= t_ ? a.z : 0.f, s0 + 3 <= t_ ? a.w : 0.f);
                    w.z = cvtpk(s0 + 4 <= t_ ? c.x : 0.f, s0 + 5 <= t_ ? c.y : 0.f); w.w = cvtpk(s0 + 6 <= t_ ? c.z : 0.f, s0 + 7 <= t_ ? c.w : 0.f); }
                wf[ks] = w; }
            const float bias = gm_bs[g * CHK + t_];
            __syncthreads();
            f32x4 acc[16];
#pragma unroll
            for (int ct = 0; ct < 16; ++ct) acc[ct] = (f32x4){0.f, 0.f, 0.f, 0.f};
#pragma unroll
            for (int ks = 0; ks < 4; ++ks) if (ks <= kmax) {
                const int r0 = 32 * ks + 8 * fq + q_, r1 = r0 + 4;
                const unsigned x0 = (unsigned)(((r0 & 3) << 2) | ((r0 >> 2) & 3)), x1 = (unsigned)(((r1 & 3) << 2) | ((r1 >> 2) & 3));
#pragma unroll
                for (int ct = 0; ct < 16; ++ct) { const unsigned chk = (unsigned)(2 * (ct & 7) + (p_ >> 1));
                    const s16x4 t0 = __builtin_amdgcn_ds_read_tr16_b64_v4i16((LAS s16x4*)(lds + (ct >> 3) * 32768 + 256 * r0 + 16 * (chk ^ x0) + 8 * (p_ & 1)));
                    const s16x4 t1 = __builtin_amdgcn_ds_read_tr16_b64_v4i16((LAS s16x4*)(lds + (ct >> 3) * 32768 + 256 * r1 + 16 * (chk ^ x1) + 8 * (p_ & 1)));
                    const bf16x8 vf = __builtin_shufflevector(t0, t1, 0, 1, 2, 3, 4, 5, 6, 7);
                    acc[ct] = __builtin_amdgcn_mfma_f32_16x16x32_bf16(vf, __builtin_bit_cast(bf16x8, wf[ks]), acc[ct], 0, 0, 0);
                    if ((ct & 7) == 7) asm volatile("" ::: "memory"); } }
            {   const size_t row = row0 + t_; const bf16* up = PROJ + row * INC + 4 * RW + g * GCG + 4 * fq; bf16* op = MIX + row * D + RW + g * GCG + 4 * fq;
#pragma unroll
                for (int ct = 0; ct < 16; ++ct) { const v2u uu = *(const v2u*)(up + 16 * ct); v2u o;
                    o.x = cvtpk(bflo(uu.x) * (acc[ct][0] + bias), bfhi(uu.x) * (acc[ct][1] + bias)); o.y = cvtpk(bflo(uu.y) * (acc[ct][2] + bias), bfhi(uu.y) * (acc[ct][3] + bias));
                    *(v2u*)(op + 16 * ct) = o; } }
        }
    }
    xcd_barrier(bar);

    }
#endif
#ifndef SK_P4
    { PTRS();
    {   pg8::Gemm g{MIX, WtOut, NTOK, D, D}; pg8::StaticOrder S; S.init(NTOK, D, G, bid);
        pg8::EpiResidNorm E{x, XN, SSP, D};
        pg8::gemm_phase<pg8::EpiResidNorm, pg8::StaticOrder, PG8_ALIGN, PG8_SP2>(lds + RING_OFF, g, S, E); }
    xcd_barrier(bar);
    }
#endif
#ifndef SK_P5
    { PTRS();
    {   pg8::Gemm g{XN, WtQ, NTOK, XW, D}; pg8::StaticOrder S; S.init(NTOK, XW, G, bid);
        LAS float* rs = (LAS float*)(lds + AUX_OFF);
        for (int ui = 0; ; ++ui) { pg8::Unit u; if (!S.next(ui, u)) break;
            __syncthreads();
            if (tid < 256) { const float* sp = SSP + (size_t)(u.pm * 256 + tid) * 64; float ss = 0.f;
#pragma unroll
                for (int j = 0; j < 16; ++j) { const f32x4 v = *(const f32x4*)(sp + 4 * j); ss += (v.x + v.y) + (v.z + v.w); }
                rs[tid] = rsqrtf(ss * (1.f / D) + EPS); }
            __syncthreads();
            pg8::Gemm g1 = g;
            struct OneUnit { pg8::Unit u; __device__ bool next(int i, pg8::Unit& o) const { if (i) return false; o = u; return true; } __device__ __forceinline__ void a_ready(const pg8::Unit&) const {} __device__ __forceinline__ void done(const pg8::Unit&) const {} } O1{u};
            pg8::EpiBf16RowScale E{QX, XW, rs};
            pg8::gemm_phase<pg8::EpiBf16RowScale, OneUnit, PG8_ALIGN, PG8_SP2>(lds + RING_OFF, g1, O1, E); } }
    {   pg8::Gemm g{MN, WtKV, NMEM, XW, D}; pg8::StaticOrder S; S.init(NMEM, XW, G, (bid + G - 128 % G) % G);
        pg8::EpiBf16<0> E{KX, XW, nullptr, 0, 0, 1.f};
        pg8::gemm_phase<pg8::EpiBf16<0>, pg8::StaticOrder, PG8_ALIGN, PG8_SP2>(lds + RING_OFF, g, S, E); }
    {   pg8::Gemm g{WtKV + (size_t)XW * D, MN, XW, NMEM, D}; pg8::StaticOrder S; S.init(XW, NMEM, G, (bid + G - 144 % G) % G);
        pg8::EpiBf16<0> E{VT, NMEM, nullptr, 0, 0, 1.f};
        pg8::gemm_phase<pg8::EpiBf16<0>, pg8::StaticOrder, PG8_ALIGN, PG8_SP2>(lds + RING_OFF, g, S, E); }
    xcd_barrier(bar);
    }
#endif
#ifndef SK_P6
    { PTRS();
    {
        const int fr = lane & 15, fq = lane >> 4; const int kkey = (((fr >> 2) & 3) << 2) | (fr & 3);
        for (int ui = 0; ; ++ui) {
            int un; if (G == 256) { if (ui >= 1) break; un = ((((bid & 7) * 2 + (bid >> 7)) << 4) | ((bid >> 3) & 15)); } else { un = bid + ui * G; if (un >= NB * XH * 16) break; }
            const int qb = un & 15, h = (un >> 4) & 3, b = un >> 6; const size_t row0 = (size_t)b * SEQ + qb * 128;
            const int ch = tid & 31, rb = tid >> 5;
            __syncthreads();
            {   v4u kv[16]; const bf16* src = KX + ((size_t)b * MEML + rb) * XW + h * XDH + ch * 8;
#pragma unroll
                for (int i = 0; i < 16; ++i) kv[i] = *(const v4u*)(src + (size_t)(16 * i) * XW);
#pragma unroll
                for (int i = 0; i < 16; ++i) { const int m = rb + 16 * i; *(LAS v4u*)(lds + m * 512 + ((ch ^ ((((m >> 3) & 3) << 2) | (m & 3))) << 4)) = kv[i]; } }
            bf16x8 qf[8];
            { const bf16* qsrc = QX + (row0 + 16 * wave + fr) * XW + h * XDH + 8 * fq;
#pragma unroll
              for (int s8 = 0; s8 < 8; ++s8) qf[s8] = *(const bf16x8*)(qsrc + 32 * s8); }
            __syncthreads();
            f32x4 sa[16];
#pragma unroll
            for (int nt = 0; nt < 16; ++nt) { f32x4 a = {0.f, 0.f, 0.f, 0.f}; const int mrow = 32 * (nt >> 1) + 8 * (fr >> 2) + 4 * (nt & 1) + (fr & 3);
#pragma unroll
                for (int s8 = 0; s8 < 8; ++s8) { const bf16x8 kf = *(const LAS bf16x8*)(lds + mrow * 512 + (((4 * s8 + fq) ^ kkey) << 4)); a = __builtin_amdgcn_mfma_f32_16x16x32_bf16(kf, qf[s8], a, 0, 0, 0); }
                sa[nt] = a; if (nt & 1) asm volatile("" ::: "memory"); }
            float mx = sa[0][0];
#pragma unroll
            for (int nt = 0; nt < 16; ++nt) mx = fmaxf(fmaxf(fmaxf(mx, sa[nt][0]), fmaxf(sa[nt][1], sa[nt][2])), sa[nt][3]);
            mx = fmaxf(mx, __shfl_xor(mx, 16)); mx = fmaxf(mx, __shfl_xor(mx, 32));
            float sum = 0.f; const float cs = 0.0625f * 1.4426950408889634f;
#pragma unroll
            for (int nt = 0; nt < 16; ++nt)
#pragma unroll
                for (int r = 0; r < 4; ++r) { const float e = __builtin_amdgcn_exp2f((sa[nt][r] - mx) * cs); sa[nt][r] = e; sum += e; }
            sum += __shfl_xor(sum, 16); sum += __shfl_xor(sum, 32);
            const float inv = 1.0f / sum;
            v4u pf[8];
#pragma unroll
            for (int s8 = 0; s8 < 8; ++s8) { v4u w; w.x = cvtpk(sa[2 * s8][0] * inv, sa[2 * s8][1] * inv); w.y = cvtpk(sa[2 * s8][2] * inv, sa[2 * s8][3] * inv);
                w.z = cvtpk(sa[2 * s8 + 1][0] * inv, sa[2 * s8 + 1][1] * inv); w.w = cvtpk(sa[2 * s8 + 1][2] * inv, sa[2 * s8 + 1][3] * inv); pf[s8] = w; }
            asm volatile("" ::: "memory");
            v4u vreg[16];
            { const bf16* src = VT + ((size_t)h * XDH + rb) * NMEM + b * MEML + ch * 8;
#pragma unroll
              for (int i = 0; i < 16; ++i) vreg[i] = *(const v4u*)(src + (size_t)(16 * i) * NMEM); }
            __syncthreads();
#pragma unroll
            for (int i = 0; i < 16; ++i) { const int d = rb + 16 * i; *(LAS v4u*)(lds + d * 512 + ((ch ^ (d & 15)) << 4)) = vreg[i]; }
            __syncthreads();
            f32x4 o[16];
#pragma unroll
            for (int dt = 0; dt < 16; ++dt) o[dt] = (f32x4){0.f, 0.f, 0.f, 0.f};
#pragma unroll
            for (int s8 = 0; s8 < 8; ++s8)
#pragma unroll
                for (int dt = 0; dt < 16; ++dt) { const bf16x8 vf = *(const LAS bf16x8*)(lds + (16 * dt + fr) * 512 + (((4 * s8 + fq) ^ fr) << 4));
                    o[dt] = __builtin_amdgcn_mfma_f32_16x16x32_bf16(vf, __builtin_bit_cast(bf16x8, pf[s8]), o[dt], 0, 0, 0); if ((dt & 7) == 7) asm volatile("" ::: "memory"); }
            bf16* op = OX + (row0 + 16 * wave + fr) * XW + h * XDH + 4 * fq;
#pragma unroll
            for (int dt = 0; dt < 16; ++dt) { v2u w; w.x = cvtpk(o[dt][0], o[dt][1]); w.y = cvtpk(o[dt][2], o[dt][3]); *(v2u*)(op + 16 * dt) = w; }
        }
    }
    xcd_barrier(bar);
    }
#endif
#ifndef SK_P7
    { PTRS();
    {   pg8::Gemm g{OX, WtO, NTOK, D, XW}; pg8::StaticOrder S; S.init(NTOK, D, G, bid);
        pg8::EpiResid E{XN, HB, D};
        pg8::gemm_phase<pg8::EpiResid, pg8::StaticOrder, PG8_ALIGN, PG8_SP2>(lds + RING_OFF, g, S, E); }
    xcd_barrier(bar);
    }
#endif
#ifndef SK_P7b
    { PTRS();
    __syncthreads();
    for (int i = tid; i < 8 * D / 4; i += NT) ((LAS f32x4*)lds)[i] = ((const f32x4*)WrT)[i];
    __syncthreads();
    for (int m = gw; m < NTOK; m += NGW) {
        const v2u* xr = (const v2u*)(HB + (size_t)m * D) + lane; f32x4 v[16]; float ss = 0.f;
#pragma unroll
        for (int j = 0; j < 16; ++j) { const v2u t = xr[64 * j]; v[j] = (f32x4){bflo(t.x), bfhi(t.x), bflo(t.y), bfhi(t.y)}; ss += (v[j].x * v[j].x + v[j].y * v[j].y) + (v[j].z * v[j].z + v[j].w * v[j].w); }
        const float rs = rsqrtf(wave_sum(ss) * (1.f / D) + EPS);
        const f32x4* gr = (const f32x4*)g_moe + lane; int* o8 = (int*)(XN8 + (size_t)m * D) + lane;
#pragma unroll
        for (int j = 0; j < 16; ++j) { const f32x4 gg = gr[64 * j]; v[j] = v[j] * rs * gg; }
        asm volatile("" ::: "memory");
#pragma unroll
        for (int j = 0; j < 16; ++j) o8[64 * j] = pack4_fp8_sat(v[j].x, v[j].y, v[j].z, v[j].w);
        int gi = 0; float gm = -3.0e38f, den = 0.f;
#pragma unroll 1
        for (int j = 0; j < 8; ++j) { const LAS f32x4* wr_ = (const LAS f32x4*)(lds + j * 16384) + lane; float acc = 0.f;
#pragma unroll
            for (int q = 0; q < 16; ++q) { const f32x4 w = wr_[64 * q]; acc += (v[q].x * w.x + v[q].y * w.y) + (v[q].z * w.z + v[q].w * w.w); }
            const float l = wave_sum(acc) + rgb[j];
            if (l > gm) { den = den * __expf(gm - l) + 1.0f; gm = l; gi = j; } else den += __expf(l - gm); }
        const float ggate = 1.0f / den;
        int i0 = 0, i1 = 0; float v0 = -3.0e38f, v1 = -3.0e38f;
#pragma unroll 1
        for (int p = 0; p < 8; p += 2) { const f32x4* wa_ = (const f32x4*)(WrT + (size_t)(8 + gi * 8 + p) * D) + lane; const f32x4* wb_ = wa_ + D / 4; float acca = 0.f, accb = 0.f;
#pragma unroll
            for (int q = 0; q < 16; ++q) { const f32x4 wa = wa_[64 * q], wb = wb_[64 * q]; acca += (v[q].x * wa.x + v[q].y * wa.y) + (v[q].z * wa.z + v[q].w * wa.w); accb += (v[q].x * wb.x + v[q].y * wb.y) + (v[q].z * wb.z + v[q].w * wb.w); }
            const float la = wave_sum(acca) + reb[gi * 8 + p], lb = wave_sum(accb) + reb[gi * 8 + p + 1];
            if (la > v0) { v1 = v0; i1 = i0; v0 = la; i0 = p; } else if (la > v1) { v1 = la; i1 = p; }
            if (lb > v0) { v1 = v0; i1 = i0; v0 = lb; i0 = p + 1; } else if (lb > v1) { v1 = lb; i1 = p + 1; } }
        const float e1 = __expf(v1 - v0), g0 = 1.0f / (1.0f + e1), g1 = e1 / (1.0f + e1);
        if (lane == 0) { EID[2 * m] = gi * 8 + i0; EID[2 * m + 1] = gi * 8 + i1; GATE[2 * m] = g0 * ggate; GATE[2 * m + 1] = g1 * ggate; }
    }
    xcd_barrier(bar);
    }
#endif
#ifndef SK_P9
    { PTRS();
    {   LAS unsigned short* list = (LAS unsigned short*)(lds + LIST_OFF); LAS int* sc = (LAS int*)(lds + SC_OFF);
        for (int ui = 0; ; ++ui) {
            int un; if (G == 256) { if (ui >= 2) break; const int xcd = XCD_OF(bid), i = IDX_OF(bid); un = ((xcd * 8 + ui * 4 + (i >> 3)) << 3) | (i & 7); } else { un = bid + ui * G; if (un >= NE * 8) break; }
            const int e = un >> 3, hs = un & 7; int off; __syncthreads();
            int tl = tid; asm volatile("" : "+v"(tl));
            const int cnt = build_list16(EID, e, list, sc, tl, off);
            if (hs == 0) { for (int r = tl; r < cnt; r += NT) SLOTS[off + r] = (int)list[r]; if (tid == 0) { OFFCNT[2 * e] = off; OFFCNT[2 * e + 1] = cnt; } }
            const float* bptr = ((lane & 31) < 16 ? wg : wu) + (size_t)e * D * FF + (size_t)(8 * wave + (lane >> 5)) * FF + hs * 64 + 4 * (lane & 15);
            for (int row0 = 0; row0 < cnt; row0 += 384) {
                unsigned aoff[3];
#pragma unroll
                for (int i = 0; i < 3; ++i) { const int r = min(row0 + 16 * (3 * wave + i) + (lane >> 2), cnt - 1); aoff[i] = (unsigned)(list[r] >> 1) * (unsigned)D + (unsigned)(((lane & 3) ^ MOE_KEY((lane >> 4) & 3)) << 4); }
                const int nrp = (min(cnt - row0, 384) + 15) & ~15; const int ndma = max(0, min(3, (nrp - 48 * wave + 15) >> 4));
                auto epi = [=](int, const f32x4 (&acc)[3][8]) {
                    const int fr = lane & 15, fq = lane >> 4; const float is = 1.0f / 64.0f;
#pragma unroll
                    for (int sl = 0; sl < 3; ++sl) { const int r = row0 + (wave + 8 * sl) * 16 + fr;
                        if (r < cnt && r < row0 + 384) { unsigned char* hp = HACT8 + (size_t)(off + r) * FF + hs * 64 + 4 * fq;
#pragma unroll
                            for (int nt = 0; nt < 4; ++nt) { const f32x4 gv = acc[sl][nt] * is, uv = acc[sl][nt + 4] * is;
                                const int w = pack4_fp8_sat(silu_f(gv[0]) * uv[0], silu_f(gv[1]) * uv[1], silu_f(gv[2]) * uv[2], silu_f(gv[3]) * uv[3]);
                                *(int*)(hp + nt * 16) = w; } } } };
                if (16 * (wave + 16) < nrp) moe_kloop<1, 3>(lds, tid, wave, lane, XN8, aoff, ndma, bptr, FF, D, (size_t)0, 64.0f, epi);
                else moe_kloop<1, 2>(lds, tid, wave, lane, XN8, aoff, ndma, bptr, FF, D, (size_t)0, 64.0f, epi);
            }
        }
    }
    xcd_barrier(bar);
    }
#endif
#ifndef SK_P10
    { PTRS();
    {   for (int ui = 0; ; ++ui) {
            int un; if (G == 256) { if (ui >= 2) break; const int xcd = XCD_OF(bid), i = IDX_OF(bid); un = ((xcd * 8 + ui * 4 + (i >> 3)) << 3) | (i & 7); } else { un = bid + ui * G; if (un >= NE * 8) break; }
            const int e = un >> 3, c8 = un & 7; const int off = OFFCNT[2 * e], cnt = OFFCNT[2 * e + 1];
            const float* bptr = wd + (size_t)e * FF * D + (size_t)(8 * wave + (lane >> 5)) * D + c8 * 512 + 4 * (lane & 31);
            for (int row0 = 0; row0 < cnt; row0 += 384) {
                unsigned aoff[3];
#pragma unroll
                for (int i = 0; i < 3; ++i) { const int r = min(row0 + 16 * (3 * wave + i) + (lane >> 2), cnt - 1); aoff[i] = (unsigned)(off + r) * (unsigned)FF + (unsigned)(((lane & 3) ^ MOE_KEY((lane >> 4) & 3)) << 4); }
                const int nrp = (min(cnt - row0, 384) + 15) & ~15; const int ndma = max(0, min(3, (nrp - 48 * wave + 15) >> 4));
                const int fr = lane & 15, fq = lane >> 4;
                int slot[3]; float gt[3];
#pragma unroll
                for (int sl = 0; sl < 3; ++sl) { const int r = row0 + (wave + 8 * sl) * 16 + fr; slot[sl] = (r < cnt && r < row0 + 384) ? SLOTS[off + r] : -1; gt[sl] = slot[sl] >= 0 ? GATE[slot[sl]] : 0.f; }
                auto epi = [=](int seg, const f32x4 (&acc)[3][8]) {
#pragma unroll
                    for (int sl = 0; sl < 3; ++sl) if (slot[sl] >= 0) { unsigned char* yp = Y8 + (size_t)slot[sl] * D + c8 * 512 + seg * 128 + 4 * fq;
#pragma unroll
                        for (int nt = 0; nt < 8; ++nt) { const f32x4 v = acc[sl][nt]; const int w = pack4_fp8_sat(gt[sl] * v[0], gt[sl] * v[1], gt[sl] * v[2], gt[sl] * v[3]); __builtin_nontemporal_store(w, (int*)(yp + nt * 16)); } } };
                if (16 * (wave + 16) < nrp) moe_kloop<4, 3>(lds, tid, wave, lane, HACT8, aoff, ndma, bptr, D, FF, (size_t)128 * 4, 16.0f, epi);
                else moe_kloop<4, 2>(lds, tid, wave, lane, HACT8, aoff, ndma, bptr, D, FF, (size_t)128 * 4, 16.0f, epi);
            }
        }
    }
    xcd_barrier(bar);
    }
#endif
#ifndef SK_P11
    { PTRS();
    f32x4 ga[8], gb[8];
#pragma unroll
    for (int j = 0; j < 8; ++j) { ga[j] = *(const f32x4*)(g_fin + 8 * lane + 512 * j); gb[j] = *(const f32x4*)(g_fin + 8 * lane + 512 * j + 4); }
    for (int m = gw; m < NTOK; m += NGW) {
        const bf16* hr = HB + (size_t)m * D + 8 * lane; const unsigned char* y0 = Y8 + (size_t)(2 * m) * D + 8 * lane; const unsigned char* y1 = y0 + D;
        f32x4 va[8], vb[8]; float ss = 0.f; const float ys = 1.0f / 16.0f;
#pragma unroll
        for (int j = 0; j < 8; ++j) { const v2u a0 = __builtin_nontemporal_load((const v2u*)(y0 + 512 * j)), a1 = __builtin_nontemporal_load((const v2u*)(y1 + 512 * j)); const v4u hh = __builtin_nontemporal_load((const v4u*)(hr + 512 * j)); f32x4 ta = (f32x4){bflo(hh.x), bfhi(hh.x), bflo(hh.y), bfhi(hh.y)}, tb = (f32x4){bflo(hh.z), bfhi(hh.z), bflo(hh.w), bfhi(hh.w)};
            const f32x2g p0 = __builtin_amdgcn_cvt_pk_f32_fp8((int)a0.x, false), p1 = __builtin_amdgcn_cvt_pk_f32_fp8((int)a0.x, true), p2 = __builtin_amdgcn_cvt_pk_f32_fp8((int)a0.y, false), p3 = __builtin_amdgcn_cvt_pk_f32_fp8((int)a0.y, true);
            const f32x2g q0 = __builtin_amdgcn_cvt_pk_f32_fp8((int)a1.x, false), q1 = __builtin_amdgcn_cvt_pk_f32_fp8((int)a1.x, true), q2 = __builtin_amdgcn_cvt_pk_f32_fp8((int)a1.y, false), q3 = __builtin_amdgcn_cvt_pk_f32_fp8((int)a1.y, true);
            ta.x = (ta.x + p0.x * ys) + q0.x * ys; ta.y = (ta.y + p0.y * ys) + q0.y * ys; ta.z = (ta.z + p1.x * ys) + q1.x * ys; ta.w = (ta.w + p1.y * ys) + q1.y * ys;
            tb.x = (tb.x + p2.x * ys) + q2.x * ys; tb.y = (tb.y + p2.y * ys) + q2.y * ys; tb.z = (tb.z + p3.x * ys) + q3.x * ys; tb.w = (tb.w + p3.y * ys) + q3.y * ys;
            va[j] = ta; vb[j] = tb; ss += ((ta.x * ta.x + ta.y * ta.y) + (ta.z * ta.z + ta.w * ta.w)) + ((tb.x * tb.x + tb.y * tb.y) + (tb.z * tb.z + tb.w * tb.w)); }
        const float rs = rsqrtf(wave_sum(ss) * (1.f / D) + EPS);
        float* orow = out + (size_t)m * D + 8 * lane;
#pragma unroll
        for (int j = 0; j < 8; ++j) { __builtin_nontemporal_store(va[j] * rs * ga[j], (f32x4*)(orow + 512 * j)); __builtin_nontemporal_store(vb[j] * rs * gb[j], (f32x4*)(orow + 512 * j + 4)); }
    }
    }
#endif
}

extern "C" void kernel_launch(void* const* d_in, const int* in_sizes, int n_in, void* d_out, int out_size, void* d_ws, size_t ws_size, hipStream_t stream) {
    static int grid = 0;
    if (grid == 0) {
        if (n_in != 25 || out_size != NTOK * D || ws_size < WS_END) { fprintf(stderr, "kernel_launch: unexpected shapes (n_in %d out %d ws %zu)\n", n_in, out_size, ws_size); grid = -1; return; }
        int dev = 0, cus = 0, per_cu = 0;
        if (hipGetDevice(&dev) != hipSuccess || hipDeviceGetAttribute(&cus, hipDeviceAttributeMultiprocessorCount, dev) != hipSuccess) { grid = -1; return; }
        if (hipFuncSetAttribute((const void*)mk_fwd, hipFuncAttributeMaxDynamicSharedMemorySize, LDS_BYTES) != hipSuccess) { fprintf(stderr, "kernel_launch: hipFuncSetAttribute failed\n"); grid = -1; return; }
        if (hipOccupancyMaxActiveBlocksPerMultiprocessor(&per_cu, (const void*)mk_fwd, NWAVES * 64, LDS_BYTES) != hipSuccess || per_cu < 1) { fprintf(stderr, "kernel_launch: occupancy query reports %d blocks per CU\n", per_cu); }
        (void)hipGetLastError();
        grid = cus;
    }
    if (grid < 0) return;
    if (hipMemsetAsync((char*)d_ws + WS_CTL, 0, CTL_ZERO_BYTES, stream) != hipSuccess) return;
    Args a{};
    for (int i = 0; i < 25; ++i) a.in[i] = d_in[i];
    a.out = (float*)d_out; a.ws = (unsigned char*)d_ws;
    hipLaunchKernelGGL(mk_fwd, dim3(grid), dim3(NWAVES * 64), LDS_BYTES, stream, a);
}
```

```cpp
#include <hip/hip_runtime.h>
#include <cstdio>
#include <cstdint>

#ifndef XCD_CONTIG
#define XCD_CONTIG 0
#endif
#if XCD_CONTIG
#define XCD_OF(b) ((b) >> 5)
#define IDX_OF(b) ((b) & 31)
#else
#define XCD_OF(b) ((b) & 7)
#define IDX_OF(b) ((b) >> 3)
#endif
#ifndef P1_ROUND_BARRIER
#define P1_ROUND_BARRIER 0
#endif
#ifndef PG8_SP2
#define PG8_SP2 true
#endif
#ifndef PG8_ALIGN
#define PG8_ALIGN true
#endif
constexpr int NWAVES = 8, NT = 512;
constexpr int D = 4096, NB = 4, SEQ = 2048, NTOK = NB * SEQ, MEML = 256, NMEM = NB * MEML;
constexpr int RW = 2048, GMW = 2048, INC = 12288, RH = 8, RDH = 256, GG = 8, GCG = 256, CHK = 128;
constexpr int XH = 4, XDH = 256, XW = 1024;
constexpr int NE = 64, FF = 512, NSLOT = NTOK * 2;
constexpr float EPS = 1e-6f;
constexpr size_t MiB = 1u << 20;
constexpr size_t WS_CTL = 0, CTL_ZERO_BYTES = 1 * MiB;
constexpr size_t WS_WRT = 1 * MiB;
constexpr size_t WS_WIN = 3 * MiB;
constexpr size_t WS_WOUT = 99 * MiB;
constexpr size_t WS_WQ = 131 * MiB;
constexpr size_t WS_WKV = 139 * MiB;
constexpr size_t WS_WO = 155 * MiB;
constexpr size_t WS_XN = 163 * MiB;
constexpr size_t WS_MN = 227 * MiB;
constexpr size_t WS_COS = 235 * MiB, WS_SIN = 239 * MiB;
constexpr size_t WS_PROJ = 243 * MiB;
constexpr size_t WS_RET = 435 * MiB;
constexpr size_t WS_MIX = 467 * MiB;
constexpr size_t WS_H = 531 * MiB;
constexpr size_t WS_QX = 659 * MiB;
constexpr size_t WS_KVX = 675 * MiB;
constexpr size_t WS_OX = 679 * MiB;
constexpr size_t WS_EID = 695 * MiB;
constexpr size_t WS_HACT = 696 * MiB;
constexpr size_t WS_Y = 712 * MiB;
constexpr size_t WS_SSP = 840 * MiB;
constexpr size_t WS_END = 842 * MiB;
constexpr int CW_TMO = 0, CW_CODE = 1, CW_BAR = 4096;
constexpr int RING_OFF = 0, RING_BYTES = 131072;
constexpr int LDSCTL_OFF = RING_BYTES, MISC_OFF = LDSCTL_OFF + 320;
constexpr int AUX_OFF = LDSCTL_OFF + 1024;
constexpr int LIST_OFF = AUX_OFF, SC_OFF = LIST_OFF + 16384;
constexpr int LDS_BYTES = 163840;

#define GAS __attribute__((address_space(1)))
#define LAS __attribute__((address_space(3)))
typedef unsigned short bf16;
typedef unsigned v4u __attribute__((ext_vector_type(4)));
typedef unsigned v2u __attribute__((ext_vector_type(2)));
typedef float f32x4 __attribute__((ext_vector_type(4)));
typedef short bf16x8 __attribute__((ext_vector_type(8)));
typedef GAS unsigned gu32;
#define RLX_AGENT __ATOMIC_RELAXED, __HIP_MEMORY_SCOPE_AGENT
#define LDS_WAIT() asm volatile("s_waitcnt lgkmcnt(0)" ::: "memory")
#define VM_WAIT() asm volatile("s_waitcnt vmcnt(0)" ::: "memory")
__device__ __forceinline__ unsigned f2bf(float f) { unsigned u = __builtin_bit_cast(unsigned, f); return (u + 0x7fffu + ((u >> 16) & 1u)) >> 16; }
__device__ __forceinline__ unsigned pk2(float lo, float hi) { return f2bf(lo) | (f2bf(hi) << 16); }
__device__ __forceinline__ float bf2f(unsigned b) { return __builtin_bit_cast(float, b << 16); }
__device__ __forceinline__ float bflo(unsigned w) { return __builtin_bit_cast(float, w << 16); }
__device__ __forceinline__ float bfhi(unsigned w) { return __builtin_bit_cast(float, w & 0xffff0000u); }
__device__ __forceinline__ float wave_sum(float v) {
#define WS_DPP(ctrl) v += __builtin_bit_cast(float, __builtin_amdgcn_update_dpp(0, __builtin_bit_cast(int, v), ctrl, 0xF, 0xF, true))
    WS_DPP(0xB1); WS_DPP(0x4E); WS_DPP(0x141); WS_DPP(0x140);
#undef WS_DPP
    const int iv = __builtin_bit_cast(int, v);
    const float r0 = __builtin_bit_cast(float, __builtin_amdgcn_readlane(iv, 0)), r1 = __builtin_bit_cast(float, __builtin_amdgcn_readlane(iv, 16)), r2 = __builtin_bit_cast(float, __builtin_amdgcn_readlane(iv, 32)), r3 = __builtin_bit_cast(float, __builtin_amdgcn_readlane(iv, 48));
    return (r0 + r1) + (r2 + r3);
}
__device__ __forceinline__ float fast_sigmoid(float x) { return __builtin_amdgcn_rcpf(1.0f + __builtin_amdgcn_exp2f(-1.4426950408889634f * x)); }
__device__ __forceinline__ float gelu_tanh_f(float x) { return x * fast_sigmoid(1.5957691216057308f * (x + 0.044715f * x * x * x)); }
__device__ __forceinline__ float silu_f(float x) { return x * fast_sigmoid(x); }
namespace pg8 {
#define PG8_LAS __attribute__((address_space(3)))
typedef unsigned short bf16_t;
typedef short bf16x8 __attribute__((ext_vector_type(8)));
typedef float f32x4 __attribute__((ext_vector_type(4)));
typedef unsigned u32x4 __attribute__((ext_vector_type(4)));
constexpr int BM = 256, BK = 64, HALF = 128, HTB = HALF * BK * 2  , STAGE_BYTES = 8 * HTB, NXCD = 8, WGM = 8;

__host__ __device__ __forceinline__ int lds_byte(int r, int c) { const int st = (r >> 4) * 2 + (c >> 5), rr = r & 15, cc = c & 31, ob = rr * 64 + cc * 2; return st * 1024 + (ob ^ (((ob >> 9) & 1) << 5)); }
__host__ __device__ __forceinline__ void stage_rc(int b, int& R, int& C) { const int st = b / 1024, sb = b % 1024, swz = sb ^ (((sb >> 9) & 1) << 5); R = (st >> 1) * 16 + swz / 64; C = (st & 1) * 32 + (swz % 64) / 2; }
__host__ __device__ __forceinline__ int perm32(int rho) { const int n = rho >> 4, i = rho & 15; return 8 * (i >> 2) + 4 * n + (i & 3); }

struct Unit { int pm, pn; };
struct Gemm { const bf16_t* A; const bf16_t* Bt; int M, N, K; };

struct StaticOrder {
    int nM, nN, nwg, G, c;
    __host__ __device__ void init(int M, int N, int G_, int c_) { nM = M / BM; nN = N / BM; nwg = nM * nN; G = G_; c = c_; }
    __host__ __device__ bool next(int i, Unit& u) const {
        const long L = (long)i * G + c; if (L >= nwg) return false;
        int wgid = (int)L; { const int q = nwg / NXCD, r = nwg % NXCD, xcd = wgid % NXCD, off = wgid / NXCD; wgid = (xcd < r ? xcd * (q + 1) : r * (q + 1) + (xcd - r) * q) + off; }
        const int nig = WGM * nN, gid = wgid / nig, fm = gid * WGM, gsz = (nM - fm) < WGM ? (nM - fm) : WGM;
        u.pm = fm + ((wgid % nig) % gsz); u.pn = (wgid % nig) / gsz; return true;
    }
    __device__ __forceinline__ void a_ready(const Unit&) const {}
    __device__ __forceinline__ void done(const Unit&) const {}
};

__device__ __forceinline__ unsigned cvt_pk_bf16(float lo, float hi) { unsigned r; asm volatile("v_cvt_pk_bf16_f32 %0, %1, %2" : "=v"(r) : "v"(lo), "v"(hi)); return r; }
typedef float f32x2 __attribute__((ext_vector_type(2)));
__device__ __forceinline__ f32x2 gelu_pk(f32x2 v) {
    const f32x2 av = __builtin_elementwise_abs(v), d = av * 0.2316418882f + 1.0f;
    f32x2 t; t.x = __builtin_amdgcn_rcpf(d.x); t.y = __builtin_amdgcn_rcpf(d.y);
    f32x2 q = t * 0.5307027145f + (-0.7265760135f); q = q * t + 0.7107068705f; q = q * t + (-0.142248368f); q = q * t + 0.127414796f; q = q * t;
    const f32x2 s = (v * v) * (-0.72134752044f);
    f32x2 e; e.x = __builtin_amdgcn_exp2f(s.x); e.y = __builtin_amdgcn_exp2f(s.y);
    const f32x2 m = v * (q * e), r = v - m;
    f32x2 o; o.x = v.x < 0.f ? m.x : r.x; o.y = v.y < 0.f ? m.y : r.y; return o;
}

template <int ACT  > struct EpiBf16 {
    static constexpr bool PERM = true, AFTER_DRAIN = false; static_assert(ACT == 0 || ACT == 1, "EpiBf16: ACT is 0 (none) or 1 (gelu_pk)");
    bf16_t* O; int ldc; const float* bias; int split_cols; size_t split_stride; float scale0;
    __device__ __forceinline__ void operator()(const f32x4 (&acc)[2][2][4][2], const Unit& u, int wr, int wc, int fr, int fq) const {
        const int row0 = u.pm * BM + wr * 64 + fr; int colt = u.pn * BM; bf16_t* base = O;
        float sc = 1.f; if (split_cols) { const int t = colt / split_cols; base += (size_t)t * split_stride; colt -= t * split_cols; if (t == 0) sc = scale0; }
        const int col0 = colt + wc * 32 + 8 * fq, bcol0 = u.pn * BM + wc * 32 + 8 * fq;
        f32x4 bv[2][2];
#pragma unroll
        for (int bj = 0; bj < 2; ++bj)
#pragma unroll
            for (int n = 0; n < 2; ++n) bv[bj][n] = bias ? *(const f32x4*)(bias + bcol0 + bj * HALF + 4 * n) : (f32x4){0.f, 0.f, 0.f, 0.f};
#pragma unroll
        for (int ai = 0; ai < 2; ++ai)
#pragma unroll
            for (int m = 0; m < 4; ++m) { bf16_t* rowp = base + (size_t)(row0 + ai * HALF + m * 16) * ldc + col0;
#pragma unroll
                for (int bj = 0; bj < 2; ++bj) { f32x4 v0 = acc[ai][bj][m][0] + bv[bj][0], v1 = acc[ai][bj][m][1] + bv[bj][1];
                    if (ACT == 1) { f32x2 a = gelu_pk((f32x2){v0[0], v0[1]}), b = gelu_pk((f32x2){v0[2], v0[3]}), c = gelu_pk((f32x2){v1[0], v1[1]}), d = gelu_pk((f32x2){v1[2], v1[3]});
                        v0 = (f32x4){a.x, a.y, b.x, b.y}; v1 = (f32x4){c.x, c.y, d.x, d.y}; }
                    v0 = v0 * sc; v1 = v1 * sc; u32x4 w; w.x = cvt_pk_bf16(v0[0], v0[1]); w.y = cvt_pk_bf16(v0[2], v0[3]); w.z = cvt_pk_bf16(v1[0], v1[1]); w.w = cvt_pk_bf16(v1[2], v1[3]);
                    *(u32x4*)(rowp + bj * HALF) = w; } }
    }
};

struct EpiProj {
    static constexpr bool PERM = true, AFTER_DRAIN = false;
    bf16_t* O; const float* cs; const float* sn;
    __device__ __forceinline__ void operator()(const f32x4 (&acc)[2][2][4][2], const Unit& u, int wr, int wc, int fr, int fq) const {
        const int sec = u.pn >> 3;
        const int row0 = u.pm * BM + wr * 64 + fr, j0 = wc * 32 + 8 * fq, col0 = u.pn * BM + j0;
#pragma unroll
        for (int ai = 0; ai < 2; ++ai)
#pragma unroll
            for (int m = 0; m < 4; ++m) {
                const int row = row0 + ai * HALF + m * 16;
                f32x4 a0 = acc[ai][0][m][0], a1 = acc[ai][0][m][1], b0 = acc[ai][1][m][0], b1 = acc[ai][1][m][1];
                if (sec < 2) {
                    const float* cp = cs + (size_t)row * 128 + j0; const float* sp = sn + (size_t)row * 128 + j0;
                    const f32x4 c0 = *(const f32x4*)cp, c1 = *(const f32x4*)(cp + 4), s0 = *(const f32x4*)sp, s1 = *(const f32x4*)(sp + 4);
                    const float sc = sec ? 0.0625f : 1.0f;
                    const f32x4 t0 = (a0 * c0 - b0 * s0) * sc, t1 = (a1 * c1 - b1 * s1) * sc;
                    b0 = (a0 * s0 + b0 * c0) * sc; b1 = (a1 * s1 + b1 * c1) * sc; a0 = t0; a1 = t1;
                } else if (sec == 3) {
#pragma unroll
                    for (int j = 0; j < 4; ++j) { a0[j] = silu_f(a0[j]); a1[j] = silu_f(a1[j]); b0[j] = silu_f(b0[j]); b1[j] = silu_f(b1[j]); }
                } else if (sec >= 4) {
#pragma unroll
                    for (int j = 0; j < 4; ++j) { a0[j] = gelu_tanh_f(a0[j]); a1[j] = gelu_tanh_f(a1[j]); b0[j] = gelu_tanh_f(b0[j]); b1[j] = gelu_tanh_f(b1[j]); }
                }
                bf16_t* rowp = O + (size_t)row * 12288 + col0;
                u32x4 w; w.x = cvt_pk_bf16(a0[0], a0[1]); w.y = cvt_pk_bf16(a0[2], a0[3]); w.z = cvt_pk_bf16(a1[0], a1[1]); w.w = cvt_pk_bf16(a1[2], a1[3]);
                *(u32x4*)rowp = w;
                w.x = cvt_pk_bf16(b0[0], b0[1]); w.y = cvt_pk_bf16(b0[2], b0[3]); w.z = cvt_pk_bf16(b1[0], b1[1]); w.w = cvt_pk_bf16(b1[2], b1[3]);
                *(u32x4*)(rowp + HALF) = w;
            }
    }
};
struct EpiResid {
    static constexpr bool PERM = true, AFTER_DRAIN = false;
    const bf16_t* base; bf16_t* out; int ldc;
    __device__ __forceinline__ void operator()(const f32x4 (&acc)[2][2][4][2], const Unit& u, int wr, int wc, int fr, int fq) const {
        const int row0 = u.pm * BM + wr * 64 + fr, col0 = u.pn * BM + wc * 32 + 8 * fq;
#pragma unroll
        for (int ai = 0; ai < 2; ++ai)
#pragma unroll
            for (int m = 0; m < 4; ++m) { const size_t off = (size_t)(row0 + ai * HALF + m * 16) * ldc + col0;
#pragma unroll
                for (int bj = 0; bj < 2; ++bj) { const u32x4 b = *(const u32x4*)(base + off + bj * HALF); const f32x4 a0 = acc[ai][bj][m][0], a1 = acc[ai][bj][m][1];
                    u32x4 w; w.x = cvt_pk_bf16(bflo(b.x) + a0[0], bfhi(b.x) + a0[1]); w.y = cvt_pk_bf16(bflo(b.y) + a0[2], bfhi(b.y) + a0[3]);
                    w.z = cvt_pk_bf16(bflo(b.z) + a1[0], bfhi(b.z) + a1[1]); w.w = cvt_pk_bf16(bflo(b.w) + a1[2], bfhi(b.w) + a1[3]);
                    *(u32x4*)(out + off + bj * HALF) = w; } }
    }
};

struct EpiResidNorm {
    static constexpr bool PERM = true, AFTER_DRAIN = false;
    const float* base; bf16_t* xb; float* ssp; int ldc;
    __device__ __forceinline__ void operator()(const f32x4 (&acc)[2][2][4][2], const Unit& u, int wr, int wc, int fr, int fq) const {
        const int row0 = u.pm * BM + wr * 64 + fr, col0 = u.pn * BM + wc * 32 + 8 * fq;
#pragma unroll
        for (int ai = 0; ai < 2; ++ai) { float sm[4];
#pragma unroll
            for (int m = 0; m < 4; ++m) { const int row = row0 + ai * HALF + m * 16; const size_t off = (size_t)row * ldc + col0; float ss = 0.f;
#pragma unroll
                for (int bj = 0; bj < 2; ++bj) { const f32x4 v0 = *(const f32x4*)(base + off + bj * HALF) + acc[ai][bj][m][0], v1 = *(const f32x4*)(base + off + bj * HALF + 4) + acc[ai][bj][m][1];
                    ss += ((v0[0] * v0[0] + v0[1] * v0[1]) + (v0[2] * v0[2] + v0[3] * v0[3])) + ((v1[0] * v1[0] + v1[1] * v1[1]) + (v1[2] * v1[2] + v1[3] * v1[3]));
                    u32x4 w; w.x = cvt_pk_bf16(v0[0], v0[1]); w.y = cvt_pk_bf16(v0[2], v0[3]); w.z = cvt_pk_bf16(v1[0], v1[1]); w.w = cvt_pk_bf16(v1[2], v1[3]);
                    *(u32x4*)(xb + off + bj * HALF) = w; }
                ss += __shfl_xor(ss, 16); ss += __shfl_xor(ss, 32);
                sm[m] = ss; }
            { const float sv = fq == 0 ? sm[0] : fq == 1 ? sm[1] : fq == 2 ? sm[2] : sm[3]; ssp[(size_t)(u.pn * 4 + wc) * NTOK + u.pm * BM + wr * 64 + ai * HALF + 16 * fq + fr] = sv; } }
    }
};
struct EpiBf16RowScale {
    static constexpr bool PERM = true, AFTER_DRAIN = false;
    bf16_t* O; int ldc; const PG8_LAS float* rs;
    __device__ __forceinline__ void operator()(const f32x4 (&acc)[2][2][4][2], const Unit& u, int wr, int wc, int fr, int fq) const {
        const int rl0 = wr * 64 + fr, col0 = u.pn * BM + wc * 32 + 8 * fq;
#pragma unroll
        for (int ai = 0; ai < 2; ++ai)
#pragma unroll
            for (int m = 0; m < 4; ++m) { const int rl = rl0 + ai * HALF + m * 16; const float sc = rs[rl]; bf16_t* rowp = O + (size_t)(u.pm * BM + rl) * ldc + col0;
#pragma unroll
                for (int bj = 0; bj < 2; ++bj) { const f32x4 v0 = acc[ai][bj][m][0] * sc, v1 = acc[ai][bj][m][1] * sc;
                    u32x4 w; w.x = cvt_pk_bf16(v0[0], v0[1]); w.y = cvt_pk_bf16(v0[2], v0[3]); w.z = cvt_pk_bf16(v1[0], v1[1]); w.w = cvt_pk_bf16(v1[2], v1[3]);
                    *(u32x4*)(rowp + bj * HALF) = w; } }
    }
};
template <class Epi, class Sched, bool ALIGN_EPI = false, bool SP2 = false>
__device__ __forceinline__ void gemm_phase(PG8_LAS unsigned char* lds, const Gemm g, const Sched& S, const Epi& E) {
    int tid = threadIdx.x; asm volatile("" : "+v"(tid));
    const int wid = __builtin_amdgcn_readfirstlane(tid >> 6), lane = tid & 63, wr = wid >> 2, wc = wid & 3, fr = lane & 15, fq = lane >> 4;
    const int K = g.K, nt = K / BK;
    unsigned voffA[2], voffB[2];
#pragma unroll
    for (int i = 0; i < 2; ++i) { int R, C; stage_rc(tid * 16 + i * 8192, R, C); const int Rb = Epi::PERM ? ((R & ~31) + perm32(R & 31)) : R;
        voffA[i] = (unsigned)(R * K + C) * 2u; voffB[i] = (unsigned)(Rb * K + C) * 2u; }
    const size_t kstep = (size_t)(BK * 2);
    const size_t hstep = (size_t)HALF * K * 2;
    const size_t tstep = 2 * hstep;
    const unsigned ldsw = (unsigned)wid * 1024u;
    const int aoff = lds_byte(wr * 64 + fr, fq * 8), boff = lds_byte(wc * 32 + fr, fq * 8);
#define PG8_SA(b, h) (((b) * 2 + (h)) * HTB)
#define PG8_SB(b, h) ((4 + (b) * 2 + (h)) * HTB)
#define PG8_STAGE(bufoff, gbase, voff) do { _Pragma("unroll") for (int _i = 0; _i < 2; ++_i) \
        __builtin_amdgcn_global_load_lds((const unsigned*)((const char*)(gbase) + (voff)[_i]), (PG8_LAS unsigned*)(lds + (bufoff) + ldsw + _i * 8192), 16, 0, 0); } while (0)
#define PG8_LDA(dst, b, h) do { _Pragma("unroll") for (int m = 0; m < 4; ++m) _Pragma("unroll") for (int k = 0; k < 2; ++k) dst[m][k] = *(const PG8_LAS bf16x8*)(lds + PG8_SA(b, h) + aoff + m * 2048 + k * 1024); } while (0)
#define PG8_LDB(dst, b, h) do { _Pragma("unroll") for (int n = 0; n < 2; ++n) _Pragma("unroll") for (int k = 0; k < 2; ++k) dst[n][k] = *(const PG8_LAS bf16x8*)(lds + PG8_SB(b, h) + boff + n * 2048 + k * 1024); } while (0)
#define PG8_MMA(ai, bj, At, Bt) do { __builtin_amdgcn_s_setprio(1); _Pragma("unroll") for (int m = 0; m < 4; ++m) _Pragma("unroll") for (int n = 0; n < 2; ++n) _Pragma("unroll") for (int k = 0; k < 2; ++k) \
        acc[ai][bj][m][n] = __builtin_amdgcn_mfma_f32_16x16x32_bf16(Bt[n][k], At[m][k], acc[ai][bj][m][n], 0, 0, 0); __builtin_amdgcn_s_setprio(0); } while (0)
#define PG8_WAIT_V(n) asm volatile("s_waitcnt vmcnt(" #n ")" ::: "memory")
#define PG8_WAIT_L(n) asm volatile("s_waitcnt lgkmcnt(" #n ")" ::: "memory")
#define PG8_BAR __builtin_amdgcn_s_barrier()
#define PG8_SCHED __builtin_amdgcn_sched_barrier(0)
    Unit cur, nxt; int ui = 0;
    if (!S.next(0, cur)) return;
    f32x4 acc[2][2][4][2];
#pragma unroll
    for (int a = 0; a < 2; ++a)
#pragma unroll
        for (int b = 0; b < 2; ++b)
#pragma unroll
            for (int m = 0; m < 4; ++m)
#pragma unroll
                for (int n = 0; n < 2; ++n) acc[a][b][m][n] = (f32x4){0.f, 0.f, 0.f, 0.f};
    bf16x8 At[4][2], B0[2][2], B1[2][2];
    const char* cA = (const char*)g.A + (size_t)cur.pm * tstep; const char* cB = (const char*)g.Bt + (size_t)cur.pn * tstep;
    S.a_ready(cur);
    if constexpr (SP2) {
        PG8_STAGE(PG8_SB(0, 0), cB, voffB); PG8_STAGE(PG8_SB(0, 1), cB + hstep, voffB); PG8_STAGE(PG8_SA(0, 0), cA, voffA); PG8_STAGE(PG8_SA(0, 1), cA + hstep, voffA);
        if (wr == 1) PG8_BAR;
        PG8_WAIT_V(2); PG8_BAR;
        PG8_STAGE(PG8_SB(1, 0), cB + kstep, voffB); PG8_STAGE(PG8_SA(1, 0), cA + kstep, voffA); PG8_STAGE(PG8_SB(1, 1), cB + hstep + kstep, voffB);
        PG8_WAIT_V(6); PG8_BAR;
    } else {
        PG8_STAGE(PG8_SB(0, 0), cB, voffB); PG8_STAGE(PG8_SA(0, 0), cA, voffA); PG8_STAGE(PG8_SB(0, 1), cB + hstep, voffB); PG8_STAGE(PG8_SA(0, 1), cA + hstep, voffA);
        if (wr == 1) PG8_BAR;
        PG8_WAIT_V(4); PG8_BAR;
        PG8_STAGE(PG8_SB(1, 0), cB + kstep, voffB); PG8_STAGE(PG8_SA(1, 0), cA + kstep, voffA); PG8_STAGE(PG8_SB(1, 1), cB + hstep + kstep, voffB);
        PG8_WAIT_V(6); PG8_BAR;
    }
    for (;;) {
        const bool has_next = S.next(ui + 1, nxt);
        const char* nA = has_next ? (const char*)g.A + (size_t)nxt.pm * tstep : cA; const char* nB = has_next ? (const char*)g.Bt + (size_t)nxt.pn * tstep : cB;
        for (int t = 0; t < nt; t += 2) {
            const bool last = (t == nt - 2);
            const char* a1 = cA + (size_t)(t + 1) * kstep;
            const char* a2 = last ? nA : cA + (size_t)(t + 2) * kstep; const char* b2 = last ? nB : cB + (size_t)(t + 2) * kstep;
            const char* a3 = a2 + kstep; const char* b3 = b2 + kstep;
            if (last && has_next) S.a_ready(nxt);
            if constexpr (SP2) {
            const int relax = __builtin_amdgcn_readfirstlane(((t == 0) && (ui > 0)) ? 1 : 0);
            PG8_LDB(B0, 0, 0); PG8_LDB(B1, 0, 1); PG8_SCHED; PG8_LDA(At, 0, 0); PG8_STAGE(PG8_SA(1, 1), a1 + hstep, voffA);
            asm volatile("s_cmp_lg_u32 %0, 0\n\ts_cbranch_scc1 .Lpg8r%=\n\ts_waitcnt vmcnt(8)\n\ts_branch .Lpg8e%=\n.Lpg8r%=:\n\ts_waitcnt vmcnt(24)\n.Lpg8e%=:" :: "s"(relax) : "scc", "memory");
            PG8_WAIT_L(0); PG8_BAR; PG8_MMA(0, 0, At, B0); PG8_MMA(0, 1, At, B1); PG8_BAR; PG8_SCHED;
            PG8_LDA(At, 0, 1); PG8_STAGE(PG8_SB(0, 0), b2, voffB); PG8_STAGE(PG8_SB(0, 1), b2 + hstep, voffB); PG8_STAGE(PG8_SA(0, 0), a2, voffA);
            asm volatile("s_cmp_lg_u32 %0, 0\n\ts_cbranch_scc1 .Lpg8r%=\n\ts_waitcnt vmcnt(8)\n\ts_branch .Lpg8e%=\n.Lpg8r%=:\n\ts_waitcnt vmcnt(24)\n.Lpg8e%=:" :: "s"(relax) : "scc", "memory");
            PG8_WAIT_L(0); PG8_BAR; PG8_MMA(1, 0, At, B0); PG8_MMA(1, 1, At, B1); PG8_BAR; PG8_SCHED;
            PG8_LDB(B0, 1, 0); PG8_LDB(B1, 1, 1); PG8_SCHED; PG8_LDA(At, 1, 0); PG8_STAGE(PG8_SA(0, 1), a2 + hstep, voffA);
            PG8_WAIT_V(8); PG8_WAIT_L(0); PG8_BAR; PG8_MMA(0, 0, At, B0); PG8_MMA(0, 1, At, B1); PG8_BAR; PG8_SCHED;
            PG8_LDA(At, 1, 1); PG8_STAGE(PG8_SB(1, 0), b3, voffB); PG8_STAGE(PG8_SB(1, 1), b3 + hstep, voffB); PG8_STAGE(PG8_SA(1, 0), a3, voffA);
            PG8_WAIT_V(8); PG8_WAIT_L(0); PG8_BAR; PG8_MMA(1, 0, At, B0); PG8_MMA(1, 1, At, B1); PG8_BAR; PG8_SCHED;
            } else {
            PG8_LDB(B0, 0, 0); PG8_SCHED; PG8_LDA(At, 0, 0); PG8_STAGE(PG8_SA(1, 1), a1 + hstep, voffA);
            PG8_WAIT_L(8); PG8_BAR; PG8_WAIT_L(0); PG8_MMA(0, 0, At, B0); PG8_BAR; PG8_SCHED;
            PG8_LDB(B1, 0, 1); PG8_STAGE(PG8_SB(0, 0), b2, voffB);
            PG8_BAR; PG8_WAIT_L(0); PG8_MMA(0, 1, At, B1); PG8_BAR;
            PG8_LDA(At, 0, 1); PG8_STAGE(PG8_SA(0, 0), a2, voffA);
            PG8_BAR; PG8_WAIT_L(0); PG8_MMA(1, 0, At, B0); PG8_BAR; PG8_SCHED;
            PG8_STAGE(PG8_SB(0, 1), b2 + hstep, voffB);
            PG8_WAIT_V(6); PG8_BAR; PG8_MMA(1, 1, At, B1); PG8_BAR;
            PG8_LDB(B0, 1, 0); PG8_SCHED; PG8_LDA(At, 1, 0); PG8_STAGE(PG8_SA(0, 1), a2 + hstep, voffA);
            PG8_WAIT_L(8); PG8_BAR; PG8_WAIT_L(0); PG8_MMA(0, 0, At, B0); PG8_BAR; PG8_SCHED;
            PG8_LDB(B1, 1, 1); PG8_STAGE(PG8_SB(1, 0), b3, voffB);
            PG8_BAR; PG8_WAIT_L(0); PG8_MMA(0, 1, At, B1); PG8_BAR;
            PG8_LDA(At, 1, 1); PG8_STAGE(PG8_SA(1, 0), a3, voffA);
            PG8_BAR; PG8_WAIT_L(0); PG8_MMA(1, 0, At, B0); PG8_BAR; PG8_SCHED;
            PG8_STAGE(PG8_SB(1, 1), b3 + hstep, voffB);
            PG8_WAIT_V(6); PG8_BAR; PG8_MMA(1, 1, At, B1); PG8_BAR;
            }
        }
        if constexpr (ALIGN_EPI) { if (wr == 0) PG8_BAR; }
        if constexpr (!Epi::AFTER_DRAIN) { E(acc, cur, wr, wc, fr, fq); S.done(cur); }
        if (!has_next) break;
#pragma unroll
        for (int a = 0; a < 2; ++a)
#pragma unroll
            for (int b = 0; b < 2; ++b)
#pragma unroll
                for (int m = 0; m < 4; ++m)
#pragma unroll
                    for (int n = 0; n < 2; ++n) acc[a][b][m][n] = (f32x4){0.f, 0.f, 0.f, 0.f};
        cur = nxt; cA = nA; cB = nB; ++ui;
        if constexpr (ALIGN_EPI) { if (wr == 1) PG8_BAR; }
    }
    PG8_WAIT_V(0);
    if constexpr (!ALIGN_EPI) { if (wr == 0) PG8_BAR; }
    PG8_BAR;
    if constexpr (Epi::AFTER_DRAIN) { E.fused(acc, cur, wr, wc, fr, fq, lds, wid, lane); S.done(cur); }
#undef PG8_SA
#undef PG8_SB
#undef PG8_STAGE
#undef PG8_LDA
#undef PG8_LDB
#undef PG8_MMA
#undef PG8_WAIT_V
#undef PG8_WAIT_L
#undef PG8_BAR
#undef PG8_SCHED
}
}
#define XB_TMO      128
#define XB_XCNT(j)  (256  + 64 * (j))
#define XB_XSUB(j)  (1280 + 64 * (j))
#define XB_XGEN(j)  (2304 + 64 * (j))
#define XB_TOP      3328
#define XB_TOPGEN   3392
#define XCD_BAR_WORDS 3456
#define XB_SPIN_CAP (1u << 18)

__device__ __forceinline__ unsigned xb_ld(unsigned* p)              { return __hip_atomic_load(p, __ATOMIC_RELAXED, __HIP_MEMORY_SCOPE_AGENT); }
__device__ __forceinline__ unsigned xb_add(unsigned* p, unsigned v) { return __hip_atomic_fetch_add(p, v, __ATOMIC_RELAXED, __HIP_MEMORY_SCOPE_AGENT); }
__device__ __forceinline__ unsigned xb_xcc_id() { return (unsigned)__builtin_amdgcn_s_getreg((3 << 11) | 20) & 0xFu; }
#define XB_SPIN(cond, bar) do { unsigned _sp = 0; while (cond) { __builtin_amdgcn_s_sleep(1); \
    if ((++_sp & 255u) == 0u) { if (xb_ld(&(bar)[XB_TMO])) break; if (_sp > XB_SPIN_CAP) { atomicAdd(&(bar)[XB_TMO], 1u); break; } } } } while (0)

struct XcdBarrier {
    unsigned* bar; unsigned x;
    volatile LAS unsigned* st;
};

__device__ __forceinline__ XcdBarrier xcd_barrier_post(unsigned* bar, volatile LAS unsigned* st) {
    XcdBarrier b; b.bar = bar; b.x = xb_xcc_id(); b.st = st;
    if (threadIdx.x == 0) (void)xb_add(&bar[XB_XCNT(b.x)], 1u);
    return b;
}
__device__ __forceinline__ void xcd_barrier_complete(unsigned* bar, unsigned x, unsigned& nloc, unsigned& nx) {
    const unsigned G = gridDim.x * gridDim.y * gridDim.z;
    unsigned sum, cnt, mine, sp = 0u;
    for (;;) {
        sum = 0u; cnt = 0u; mine = 0u;
#pragma unroll
        for (unsigned j = 0; j < 16; ++j) { const unsigned c = xb_ld(&bar[XB_XCNT(j)]); sum += c; cnt += (c > 0u) ? 1u : 0u; mine = (j == x) ? c : mine; }
        if (sum == G) break;
        __builtin_amdgcn_s_sleep(1);
        if ((++sp & 255u) == 0u) { if (xb_ld(&bar[XB_TMO])) break; if (sp > XB_SPIN_CAP) { atomicAdd(&bar[XB_TMO], 1u); break; } }
    }
    nloc = mine > 0u ? mine : 1u; nx = cnt > 0u ? cnt : 1u;
}

__device__ __forceinline__ void xcd_barrier(const XcdBarrier& b) {
    asm volatile("s_waitcnt vmcnt(0)" ::: "memory");
    __syncthreads();
    if (threadIdx.x == 0) {
        unsigned* bar = b.bar;
        __builtin_amdgcn_s_waitcnt(0);
        unsigned nloc = b.st[0], nx = b.st[1];
        if (nloc == 0u) { xcd_barrier_complete(bar, b.x, nloc, nx); b.st[0] = nloc; b.st[1] = nx; }
        const unsigned old = xb_add(&bar[XB_XSUB(b.x)], 1u);
        const unsigned gen = old / nloc;
        if (old + 1u == (gen + 1u) * nloc) {
            __builtin_amdgcn_fence(__ATOMIC_RELEASE, "agent");
            asm volatile("s_waitcnt vmcnt(0)" ::: "memory");
            const unsigned og = xb_add(&bar[XB_TOP], 1u);
            const unsigned tg = og / nx;
            if (og + 1u == (tg + 1u) * nx) xb_add(&bar[XB_TOPGEN], 1u);
            else XB_SPIN(xb_ld(&bar[XB_TOPGEN]) == tg, bar);
            __builtin_amdgcn_fence(__ATOMIC_ACQUIRE, "agent");
            xb_add(&bar[XB_XGEN(b.x)], 1u);
            asm volatile("s_waitcnt vmcnt(0)" ::: "memory");
        } else {
            XB_SPIN(xb_ld(&bar[XB_XGEN(b.x)]) == gen, bar);
            __builtin_amdgcn_fence(__ATOMIC_ACQUIRE, "agent");
            asm volatile("s_waitcnt vmcnt(0)" ::: "memory");
        }
    }
    __syncthreads();
}


__device__ __forceinline__ void p0_transpose_item(const float* W, int K, int N, bf16* WT, LAS float* scr, int item, int lane, const float* kscale = nullptr) {
    const int tn_ = N / 128, t_ = item >> 3, w_ = item & 7, kb = (t_ / tn_) * 2 + (w_ >> 2), nb = (t_ % tn_) * 4 + (w_ & 3), k0 = 64 * kb, n0 = 32 * nb;
    {
        const float* wp = W + (size_t)(k0 + (lane >> 3)) * N + n0 + 4 * (lane & 7); f32x4 t[8];
#pragma unroll
        for (int i = 0; i < 8; ++i) t[i] = __builtin_nontemporal_load((const f32x4*)(wp + (size_t)(8 * i) * N));
#pragma unroll
        for (int i = 0; i < 8; ++i) { LAS float* d = scr + ((lane >> 3) + 8 * i) * 33 + 4 * (lane & 7); d[0] = t[i].x; d[1] = t[i].y; d[2] = t[i].z; d[3] = t[i].w; } }
    LDS_WAIT(); asm volatile("" ::: "memory");
    const int c = lane & 7;
#pragma unroll
    for (int j = 0; j < 4; ++j) { const int n = (lane >> 3) + 8 * j; const LAS float* s = scr + (8 * c) * 33 + n;
        f32x4 ka = {1.f, 1.f, 1.f, 1.f}, kb = {1.f, 1.f, 1.f, 1.f}; if (kscale) { ka = *(const f32x4*)(kscale + k0 + 8 * c); kb = *(const f32x4*)(kscale + k0 + 8 * c + 4); }
        v4u o; o.x = pk2(s[0 * 33] * ka.x, s[1 * 33] * ka.y); o.y = pk2(s[2 * 33] * ka.z, s[3 * 33] * ka.w); o.z = pk2(s[4 * 33] * kb.x, s[5 * 33] * kb.y); o.w = pk2(s[6 * 33] * kb.z, s[7 * 33] * kb.w);
        *(v4u*)(WT + (size_t)(n0 + n) * K + k0 + 8 * c) = o; }
    LDS_WAIT(); asm volatile("" ::: "memory");
}
__device__ __forceinline__ void rms_row_to_bf16(const float* xrow, const f32x4 (&gg)[16], bf16* orow, int lane) {
    const float* xr = xrow + 8 * lane; f32x4 v[16]; float ss = 0.f;
#pragma unroll
    for (int j = 0; j < 8; ++j) { v[2 * j] = __builtin_nontemporal_load((const f32x4*)(xr + 512 * j)); v[2 * j + 1] = __builtin_nontemporal_load((const f32x4*)(xr + 512 * j + 4)); }
#pragma unroll
    for (int j = 0; j < 16; ++j) ss += (v[j].x * v[j].x + v[j].y * v[j].y) + (v[j].z * v[j].z + v[j].w * v[j].w);
    const float rs = rsqrtf(wave_sum(ss) * (1.f / D) + EPS);
    bf16* o8 = orow + 8 * lane;
#pragma unroll
    for (int j = 0; j < 8; ++j) { const f32x4 a = v[2 * j], c = v[2 * j + 1], ga = gg[2 * j], gc = gg[2 * j + 1]; v4u o;
        o.x = pk2(a.x * rs * ga.x, a.y * rs * ga.y); o.y = pk2(a.z * rs * ga.z, a.w * rs * ga.w); o.z = pk2(c.x * rs * gc.x, c.y * rs * gc.y); o.w = pk2(c.z * rs * gc.z, c.w * rs * gc.w);
        *(v4u*)(o8 + 512 * j) = o; }
}
__device__ __forceinline__ int block_excl_scan(int v, LAS int* sc, int tid, int& tot) {
    const int lane = tid & 63, w = tid >> 6; int x = v;
#pragma unroll
    for (int o = 1; o < 64; o <<= 1) { const int y = __shfl_up(x, o); if (lane >= o) x += y; }
    __syncthreads();
    if (lane == 63) sc[w] = x;
    __syncthreads();
    int base = 0, t = 0;
#pragma unroll
    for (int i = 0; i < 8; ++i) { const int s = sc[i]; if (i < w) base += s; t += s; }
    tot = t; return base + x - v;
}
__device__ __forceinline__ int build_list(const int* eid, int e, LAS int* list, LAS int* sc, int tid, int& off) {
    const int4* p = (const int4*)(eid + 32 * tid); unsigned mask = 0u; int cm = 0, cl = 0;
#pragma unroll
    for (int i = 0; i < 8; ++i) { const int4 v = p[i];
        if (v.x == e) { mask |= 1u << (4 * i); ++cm; } if (v.y == e) { mask |= 2u << (4 * i); ++cm; } if (v.z == e) { mask |= 4u << (4 * i); ++cm; } if (v.w == e) { mask |= 8u << (4 * i); ++cm; }
        cl += (v.x < e) + (v.y < e) + (v.z < e) + (v.w < e); }
    int tot; int pos = block_excl_scan(cm, sc, tid, tot);
    int tl; (void)block_excl_scan(cl, sc + 8, tid, tl); off = tl;
    while (mask) { const int b = __builtin_ctz(mask); mask &= mask - 1u; list[pos++] = 32 * tid + b; }
    __syncthreads();
    return tot;
}


__device__ __forceinline__ int build_list16(const int* eid, int e, LAS unsigned short* list, LAS int* sc, int tid, int& off) {
    const int4* p = (const int4*)(eid + 32 * tid); unsigned mask = 0u; int cm = 0, cl = 0;
#pragma unroll
    for (int i = 0; i < 8; ++i) { const int4 v = p[i];
        if (v.x == e) { mask |= 1u << (4 * i); ++cm; } if (v.y == e) { mask |= 2u << (4 * i); ++cm; } if (v.z == e) { mask |= 4u << (4 * i); ++cm; } if (v.w == e) { mask |= 8u << (4 * i); ++cm; }
        cl += (v.x < e) + (v.y < e) + (v.z < e) + (v.w < e); }
    int tot; int pos = block_excl_scan(cm, sc, tid, tot);
    int tl; (void)block_excl_scan(cl, sc + 8, tid, tl); off = tl;
    while (mask) { const int b = __builtin_ctz(mask); mask &= mask - 1u; list[pos++] = (unsigned short)(32 * tid + b); }
    __syncthreads();
    return tot;
}
__device__ __forceinline__ int pack4_fp8_sat(float a, float b, float c, float d) {
    a = __builtin_amdgcn_fmed3f(a, -448.0f, 448.0f); b = __builtin_amdgcn_fmed3f(b, -448.0f, 448.0f); c = __builtin_amdgcn_fmed3f(c, -448.0f, 448.0f); d = __builtin_amdgcn_fmed3f(d, -448.0f, 448.0f);
    int w = __builtin_amdgcn_cvt_pk_fp8_f32(a, b, 0, false); return __builtin_amdgcn_cvt_pk_fp8_f32(c, d, w, true); }
__device__ __forceinline__ void rows4x4_transpose(unsigned& w0, unsigned& w1, unsigned& w2, unsigned& w3) {
    { const auto r0 = __builtin_amdgcn_permlane32_swap(w0, w2, false, false); w0 = r0[0]; w2 = r0[1]; const auto r1 = __builtin_amdgcn_permlane32_swap(w1, w3, false, false); w1 = r1[0]; w3 = r1[1]; }
    { const auto r0 = __builtin_amdgcn_permlane16_swap(w0, w1, false, false); w0 = r0[0]; w1 = r0[1]; const auto r1 = __builtin_amdgcn_permlane16_swap(w2, w3, false, false); w2 = r1[0]; w3 = r1[1]; }
}
__device__ __forceinline__ unsigned cvtpk(float lo, float hi) { unsigned r; asm("v_cvt_pk_bf16_f32 %0, %1, %2" : "=v"(r) : "v"(lo), "v"(hi)); return r; }
typedef float f32x2g __attribute__((ext_vector_type(2)));
typedef short s16x4 __attribute__((ext_vector_type(4)));
#define MOE_KEY(q) ((0x78 >> (2 * (q))) & 3)
typedef int v4i __attribute__((ext_vector_type(4)));
typedef int v8i __attribute__((ext_vector_type(8)));
template <int NSEG, int NSL, class Epi>
__device__ __forceinline__ void moe_kloop(LAS unsigned char* lds, int tid, int wave, int lane, const unsigned char* Asrc, const unsigned (&aoff)[3], int ndma, const float* bptr, int ldb, int K, size_t bsegb, float wscale, const Epi& E, const float* bnext, int ldbn, bool pre) {
    const int fr = lane & 15, fq = lane >> 4, c4 = lane & 31, kq = 2 * wave + (lane >> 5);
    const unsigned ldsbase = (unsigned)(size_t)lds;
    const unsigned b_wr = ldsbase + 49152u + (unsigned)((4 * c4) * 64 + (((kq >> 2) ^ MOE_KEY(c4 & 3)) << 4) + (kq & 3) * 4);
    const unsigned a_dma = (unsigned)(wave * 3072), r_dma = 65536u + (unsigned)(wave * 4096), r_rd = 65536u + (unsigned)((4 * kq) * 512 + c4 * 16);
    const unsigned a_rd = (unsigned)((wave * 16 + fr) * 64), b_rd = 49152u + (unsigned)(fr * 64);
    const unsigned xk = (unsigned)((fq ^ MOE_KEY((fr >> 2) & 3)) << 4);
    const size_t ldbb = (size_t)ldb * 4; const int S = K >> 6, T = S * NSEG;
    f32x4 acc[3][8];
#pragma unroll
    for (int sl = 0; sl < 3; ++sl)
#pragma unroll
        for (int nt = 0; nt < 8; ++nt) acc[sl][nt] = (f32x4){0.f, 0.f, 0.f, 0.f};
#define MOE_GW(g_) (((g_) >= T) ? (g_) - T : (g_))
#define MOE_FETCH_A(g_, bo) do { const GAS char* ap_ = (const GAS char*)Asrc + (MOE_GW(g_) % S) * 64; _Pragma("unroll") for (int i_ = 0; i_ < 3; ++i_) if (i_ < ndma) \
        __builtin_amdgcn_global_load_lds((const GAS unsigned*)(ap_ + aoff[i_]), (LAS unsigned*)(lds + (bo) + a_dma + i_ * 1024), 16, 0, 0); } while (0)
#define MOE_FETCH_B(g_, slot) do { const size_t lb_ = (g_) >= T ? (size_t)ldbn * 4 : ldbb; const GAS char* bp_ = (const GAS char*)((g_) >= T ? bnext : bptr) + (size_t)(MOE_GW(g_) / S) * bsegb + (size_t)((MOE_GW(g_) % S) * 64) * lb_; _Pragma("unroll") for (int j_ = 0; j_ < 4; ++j_) \
        __builtin_amdgcn_global_load_lds((const GAS unsigned*)(bp_ + (size_t)(2 * j_) * lb_), (LAS unsigned*)(lds + r_dma + (slot) * 32768u + j_ * 1024), 16, 0, 2  ); } while (0)
#define MOE_CONVERT(slot, bo8) do { f32x4 x_[4]; _Pragma("unroll") for (int i_ = 0; i_ < 4; ++i_) x_[i_] = *(const LAS f32x4*)(lds + r_rd + (slot) * 32768u + i_ * 512); \
        _Pragma("unroll") for (int j_ = 0; j_ < 4; ++j_) { int w_ = __builtin_amdgcn_cvt_pk_fp8_f32(x_[0][j_] * wscale, x_[1][j_] * wscale, 0, false); w_ = __builtin_amdgcn_cvt_pk_fp8_f32(x_[2][j_] * wscale, x_[3][j_] * wscale, w_, true); \
            if ((bo8) == 0u) { if (j_ == 0) asm volatile("ds_write_b32 %0, %1" :: "v"(b_wr), "v"(w_) : "memory"); else if (j_ == 1) asm volatile("ds_write_b32 %0, %1 offset:64" :: "v"(b_wr), "v"(w_) : "memory"); \
                else if (j_ == 2) asm volatile("ds_write_b32 %0, %1 offset:128" :: "v"(b_wr), "v"(w_) : "memory"); else asm volatile("ds_write_b32 %0, %1 offset:192" :: "v"(b_wr), "v"(w_) : "memory"); } \
            else { if (j_ == 0) asm volatile("ds_write_b32 %0, %1 offset:8192" :: "v"(b_wr), "v"(w_) : "memory"); else if (j_ == 1) asm volatile("ds_write_b32 %0, %1 offset:8256" :: "v"(b_wr), "v"(w_) : "memory"); \
                else if (j_ == 2) asm volatile("ds_write_b32 %0, %1 offset:8320" :: "v"(b_wr), "v"(w_) : "memory"); else asm volatile("ds_write_b32 %0, %1 offset:8384" :: "v"(b_wr), "v"(w_) : "memory"); } } } while (0)
#define MOE_DSR(dst, addr, off) asm volatile("ds_read_b128 %0, %1 offset:" #off : "=v"(dst) : "v"(addr))
#define MOE_FENCE() asm volatile("" ::: "memory")
#define MOE_SYNC() do { asm volatile("s_waitcnt lgkmcnt(0)" ::: "memory"); __builtin_amdgcn_s_barrier(); asm volatile("" ::: "memory"); } while (0)
    __builtin_amdgcn_s_waitcnt(0); __builtin_amdgcn_s_barrier(); asm volatile("" ::: "memory");
    MOE_FETCH_A(0, 0u); if (!pre) { MOE_FETCH_B(0, 0u); MOE_FETCH_B(1, 1u); }
    asm volatile("s_waitcnt vmcnt(0)" ::: "memory");
    MOE_CONVERT(0u, 0u);
    MOE_SYNC();
    v8i fa_[3], fb_[8];
#pragma unroll
    for (int i = 0; i < 3; ++i) fa_[i] = (v8i){0, 0, 0, 0, 0, 0, 0, 0};
#pragma unroll
    for (int i = 0; i < 8; ++i) fb_[i] = (v8i){0, 0, 0, 0, 0, 0, 0, 0};
#define MOE_READS(CUR) v4i ta_[3], tb_[8]; { const unsigned a0_ = a_rd + xk, b0_ = b_rd + xk; if ((CUR) == 0u) { \
          MOE_DSR(ta_[0], a0_, 0); MOE_DSR(ta_[1], a0_, 8192); if (NSL == 3) MOE_DSR(ta_[2], a0_, 16384); \
          MOE_DSR(tb_[0], b0_, 0); MOE_DSR(tb_[1], b0_, 1024); MOE_DSR(tb_[2], b0_, 2048); MOE_DSR(tb_[3], b0_, 3072); MOE_DSR(tb_[4], b0_, 4096); MOE_DSR(tb_[5], b0_, 5120); MOE_DSR(tb_[6], b0_, 6144); MOE_DSR(tb_[7], b0_, 7168); } else { \
          MOE_DSR(ta_[0], a0_, 24576); MOE_DSR(ta_[1], a0_, 32768); if (NSL == 3) MOE_DSR(ta_[2], a0_, 40960); \
          MOE_DSR(tb_[0], b0_, 8192); MOE_DSR(tb_[1], b0_, 9216); MOE_DSR(tb_[2], b0_, 10240); MOE_DSR(tb_[3], b0_, 11264); MOE_DSR(tb_[4], b0_, 12288); MOE_DSR(tb_[5], b0_, 13312); MOE_DSR(tb_[6], b0_, 14336); MOE_DSR(tb_[7], b0_, 15360); } }
#define MOE_WAIT_LO() do { if (NSL == 3) asm volatile("s_waitcnt lgkmcnt(4)" : "+v"(ta_[0]), "+v"(ta_[1]), "+v"(ta_[2]), "+v"(tb_[0]), "+v"(tb_[1]), "+v"(tb_[2]), "+v"(tb_[3]) :: "memory"); \
          else asm volatile("s_waitcnt lgkmcnt(4)" : "+v"(ta_[0]), "+v"(ta_[1]), "+v"(tb_[0]), "+v"(tb_[1]), "+v"(tb_[2]), "+v"(tb_[3]) :: "memory"); } while (0)
#define MOE_WAIT_HI() asm volatile("s_waitcnt lgkmcnt(0)" : "+v"(tb_[4]), "+v"(tb_[5]), "+v"(tb_[6]), "+v"(tb_[7]) :: "memory")
#define MOE_PUT(dst, src, H) do { (dst)[4 * (H) + 0] = (src)[0]; (dst)[4 * (H) + 1] = (src)[1]; (dst)[4 * (H) + 2] = (src)[2]; (dst)[4 * (H) + 3] = (src)[3]; } while (0)
#pragma unroll 1
    for (int s = 0; s < T; s += 2) {
        {
            MOE_FETCH_A(s + 1, 24576u);
            MOE_READS(0u);
            MOE_FENCE(); MOE_FETCH_B(s + 2, 0u); MOE_FENCE();
            MOE_WAIT_LO(); MOE_WAIT_HI();
#pragma unroll
            for (int sl_ = 0; sl_ < NSL; ++sl_) MOE_PUT(fa_[sl_], ta_[sl_], 0);
#pragma unroll
            for (int nt_ = 0; nt_ < 8; ++nt_) MOE_PUT(fb_[nt_], tb_[nt_], 0);
            asm volatile("s_waitcnt vmcnt(4)" ::: "memory");
            MOE_CONVERT(1u, 8192u);
            MOE_SYNC();
        }
        {
            MOE_FETCH_A(s + 2, 0u);
            MOE_READS(1u);
            MOE_WAIT_LO();
#pragma unroll
            for (int sl_ = 0; sl_ < NSL; ++sl_) MOE_PUT(fa_[sl_], ta_[sl_], 1);
#pragma unroll
            for (int nt_ = 0; nt_ < 4; ++nt_) MOE_PUT(fb_[nt_], tb_[nt_], 1);
#pragma unroll
            for (int nt_ = 0; nt_ < 4; ++nt_)
#pragma unroll
                for (int sl_ = 0; sl_ < NSL; ++sl_) acc[sl_][nt_] = __builtin_amdgcn_mfma_scale_f32_16x16x128_f8f6f4(fb_[nt_], fa_[sl_], acc[sl_][nt_], 0, 0, 0, 0, 0, 0);
            MOE_FENCE(); MOE_FETCH_B(s + 3, 1u); MOE_FENCE();
            MOE_WAIT_HI();
#pragma unroll
            for (int nt_ = 4; nt_ < 8; ++nt_) MOE_PUT(fb_[nt_], tb_[nt_], 1);
#pragma unroll
            for (int nt_ = 4; nt_ < 8; ++nt_)
#pragma unroll
                for (int sl_ = 0; sl_ < NSL; ++sl_) acc[sl_][nt_] = __builtin_amdgcn_mfma_scale_f32_16x16x128_f8f6f4(fb_[nt_], fa_[sl_], acc[sl_][nt_], 0, 0, 0, 0, 0, 0);
            MOE_FENCE();
            asm volatile("s_waitcnt vmcnt(4)" ::: "memory");
            MOE_CONVERT(0u, 0u);
            MOE_SYNC();
        }
        if (NSEG > 1 && (s + 2) % S == 0) { E(s / S, acc);
#pragma unroll
            for (int sl = 0; sl < 3; ++sl)
#pragma unroll
                for (int nt = 0; nt < 8; ++nt) acc[sl][nt] = (f32x4){0.f, 0.f, 0.f, 0.f}; }
    }
    asm volatile("s_waitcnt vmcnt(0)" ::: "memory"); MOE_SYNC();
    if (NSEG == 1) E(0, acc);
#undef MOE_GW
#undef MOE_FETCH_A
#undef MOE_FETCH_B
#undef MOE_CONVERT
#undef MOE_FENCE
#undef MOE_DSR
#undef MOE_READS
#undef MOE_WAIT_LO
#undef MOE_WAIT_HI
#undef MOE_PUT
#undef MOE_SYNC
}

__device__ __forceinline__ void moe_prefetch_w(LAS unsigned char* lds, int wave, const float* bptr, int ldb) {
    const size_t lb = (size_t)ldb * 4;
#pragma unroll
    for (int st = 0; st < 2; ++st)
#pragma unroll
        for (int j = 0; j < 4; ++j) __builtin_amdgcn_global_load_lds((const GAS unsigned*)((const GAS char*)bptr + (size_t)(64 * st + 2 * j) * lb), (LAS unsigned*)(lds + 65536u + (unsigned)(wave * 4096) + st * 32768u + j * 1024), 16, 0, 2);
}
struct Args { const void* in[25]; float* out; unsigned char* ws; };
#define PTRS() const __attribute__((address_space(4))) Args* K_ = (const __attribute__((address_space(4))) Args*)__builtin_amdgcn_kernarg_segment_ptr(); asm volatile("" : "+s"(K_)); \
    int tid; asm volatile("v_mbcnt_lo_u32_b32 %0, -1, 0\n\tv_mbcnt_hi_u32_b32 %0, -1, %0" : "=v"(tid)); tid |= wave0 << 6; const int lane = tid & 63, wave = __builtin_amdgcn_readfirstlane(tid >> 6); \
    const int G = gridDim.x, bid = blockIdx.x, gw = bid * NWAVES + wave, NGW = G * NWAVES, gtid = bid * NT + tid, NGT = G * NT; (void)lane; (void)gw; (void)NGW; (void)gtid; (void)NGT; \
    unsigned char* ws = K_->ws; \
    const float* x = (const float*)K_->in[0]; const float* mem = (const float*)K_->in[1]; const int* pos = (const int*)K_->in[2]; \
    const float* g_mix = (const float*)K_->in[3]; const float* w_in = (const float*)K_->in[4]; const float* ret_g = (const float*)K_->in[5]; \
    const float* ln_g = (const float*)K_->in[6]; const float* ln_b = (const float*)K_->in[7]; const float* gm_ws = (const float*)K_->in[8]; const float* gm_bs = (const float*)K_->in[9]; \
    const float* w_out = (const float*)K_->in[10]; const float* g_xa = (const float*)K_->in[11]; const float* g_mem = (const float*)K_->in[12]; \
    const float* wq = (const float*)K_->in[13]; const float* wkv = (const float*)K_->in[14]; const float* wo = (const float*)K_->in[15]; \
    const float* g_moe = (const float*)K_->in[16]; const float* rgw = (const float*)K_->in[17]; const float* rgb = (const float*)K_->in[18]; \
    const float* rew = (const float*)K_->in[19]; const float* reb = (const float*)K_->in[20]; \
    const float* wg = (const float*)K_->in[21]; const float* wu = (const float*)K_->in[22]; const float* wd = (const float*)K_->in[23]; const float* g_fin = (const float*)K_->in[24]; \
    float* out = K_->out; \
    float* WrT = (float*)(ws + WS_WRT); \
    bf16* WtIn = (bf16*)(ws + WS_WIN); bf16* WtOut = (bf16*)(ws + WS_WOUT); bf16* WtQ = (bf16*)(ws + WS_WQ); bf16* WtKV = (bf16*)(ws + WS_WKV); bf16* WtO = (bf16*)(ws + WS_WO); \
    bf16* XN = (bf16*)(ws + WS_XN); bf16* MN = (bf16*)(ws + WS_MN); float* COS = (float*)(ws + WS_COS); float* SIN = (float*)(ws + WS_SIN); \
    bf16* PROJ = (bf16*)(ws + WS_PROJ); bf16* RET = (bf16*)(ws + WS_RET); bf16* MIX = (bf16*)(ws + WS_MIX); bf16* HB = (bf16*)(ws + WS_H); \
    bf16* QX = (bf16*)(ws + WS_QX); bf16* KX = (bf16*)(ws + WS_KVX); bf16* VT = KX + (size_t)NMEM * XW; bf16* OX = (bf16*)(ws + WS_OX); \
    int* EID = (int*)(ws + WS_EID); float* GATE = (float*)(ws + WS_EID + 65536); int* SLOTS = (int*)(ws + WS_EID + 131072); int* OFFCNT = (int*)(ws + WS_EID + 196608); float* GSTAT = (float*)(ws + WS_EID + 262144); float* SSP = (float*)(ws + WS_SSP); \
    unsigned char* HACT8 = (unsigned char*)(ws + WS_HACT); unsigned char* XN8 = (unsigned char*)(ws + WS_XN); unsigned char* Y8 = (unsigned char*)(ws + WS_Y);
__global__ void __launch_bounds__(NWAVES * 64, 2) mk_fwd(Args a) {
    extern __shared__ __attribute__((aligned(16))) unsigned char lds_raw[];
    LAS unsigned char* lds = (LAS unsigned char*)lds_raw;
    const int tid0 = threadIdx.x;
    const int wave0 = __builtin_amdgcn_readfirstlane(tid0 >> 6);
    for (int u = tid0; u < (LDS_BYTES - LDSCTL_OFF) / 4; u += NT) ((LAS unsigned*)(lds + LDSCTL_OFF))[u] = 0u;
    __syncthreads();
    volatile LAS unsigned* MISC = (volatile LAS unsigned*)(lds + MISC_OFF);
    XcdBarrier bar; { PTRS(); bar = xcd_barrier_post((unsigned*)(ws + WS_CTL) + CW_BAR, MISC + 8); }

#ifndef SK_P0
    { PTRS();
    {
        LAS float* scr = (LAS float*)(lds + RING_OFF + wave * 16384);
        constexpr int I_IN = (D / 64) * (INC / 32), I_OUT = (D / 64) * (D / 32), I_Q = (D / 64) * (XW / 32), I_KV = (D / 64) * (2 * XW / 32), I_O = (XW / 64) * (D / 32);
        constexpr int NITEMS = I_IN + I_OUT + I_Q + I_KV + I_O;
        for (int it = gw; it < NITEMS; it += NGW) {
            int r = it;
            if (r < I_IN) { p0_transpose_item(w_in, D, INC, WtIn, scr, r, lane); continue; } r -= I_IN;
            if (r < I_OUT) { p0_transpose_item(w_out, D, D, WtOut, scr, r, lane); continue; } r -= I_OUT;
            if (r < I_Q) { p0_transpose_item(wq, D, XW, WtQ, scr, r, lane, g_xa); continue; } r -= I_Q;
            if (r < I_KV) { p0_transpose_item(wkv, D, 2 * XW, WtKV, scr, r, lane); continue; } r -= I_KV;
            p0_transpose_item(wo, XW, D, WtO, scr, r, lane);
        }
        for (int i = gtid; i < 72 * D; i += NGT) { const int j = i >> 12, k = i & (D - 1); WrT[i] = j < 8 ? rgw[(size_t)k * 8 + j] : rew[(size_t)k * 64 + (j - 8)]; }
        { f32x4 gg[16];
#pragma unroll
          for (int j = 0; j < 16; ++j) gg[j] = *(const f32x4*)(g_mix + 8 * lane + 512 * (j >> 1) + 4 * (j & 1));
          for (int m = gw; m < NTOK; m += NGW) rms_row_to_bf16(x + (size_t)m * D, gg, XN + (size_t)m * D, lane);
#pragma unroll
          for (int j = 0; j < 16; ++j) gg[j] = *(const f32x4*)(g_mem + 8 * lane + 512 * (j >> 1) + 4 * (j & 1));
          for (int m = gw; m < NMEM; m += NGW) rms_row_to_bf16(mem + (size_t)m * D, gg, MN + (size_t)m * D, lane); }
        for (int i = gtid; i < NTOK * 128; i += NGT) { const int j = i & 127, row = i >> 7; const float inv = exp2f(-(float)(2 * j) * (13.287712379549449f / 256.0f)); const float ang = (float)pos[row] * inv;
            float rev = ang * 0.15915494309189535f; rev -= floorf(rev); COS[i] = __builtin_amdgcn_cosf(rev); SIN[i] = __builtin_amdgcn_sinf(rev); }
    }
    xcd_barrier(bar);

    }
#endif
#ifndef SK_P1
    { PTRS();
    {   pg8::Gemm g{XN, WtIn, NTOK, INC, D}; pg8::StaticOrder S; S.init(NTOK, INC, G, bid);
        pg8::EpiProj E{PROJ, COS, SIN};
#if P1_ROUND_BARRIER
        struct RoundUnit { pg8::StaticOrder S; int r; __device__ bool next(int i, pg8::Unit& o) const { return i == 0 && S.next(r, o); } __device__ __forceinline__ void a_ready(const pg8::Unit&) const {} __device__ __forceinline__ void done(const pg8::Unit&) const {} };
        const int rounds = (S.nwg + G - 1) / G;
#pragma unroll 1
        for (int r = 0; r < rounds; ++r) { RoundUnit R{S, r}; pg8::gemm_phase<pg8::EpiProj, RoundUnit, PG8_ALIGN, PG8_SP2>(lds + RING_OFF, g, R, E); if (r + 1 < rounds) xcd_barrier(bar); }
#else
        pg8::gemm_phase<pg8::EpiProj, pg8::StaticOrder, PG8_ALIGN, PG8_SP2>(lds + RING_OFF, g, S, E);
#endif
    }
    xcd_barrier(bar);

    }
#endif
#ifndef SK_P2
    { PTRS();
    {
        constexpr int KT_OFF = 0, VT_OFF = 65536, VS_OFF = VT_OFF + 8704, ST_OFF = VS_OFF + 8704;
        const int fr = lane & 15, fq = lane >> 4, qt = wave < 4 ? wave : 11 - wave;
        const int kswz = ((fr & 3) << 2) | ((fr >> 2) & 3);
        for (int ui = 0; ; ++ui) {
            int vb; if (G == 256) { if (ui >= 1) break; vb = (((bid & 7) * 4 + (bid >> 6)) << 3) | ((bid >> 3) & 7); } else { vb = bid + ui * G; if (vb >= NB * RH * 8) break; }
            const int es = vb & 7, h = (vb >> 3) & 7, b = vb >> 6;
            const float l2g = log2f(1.0f - exp2f(-5.0f - (float)h));
            float An[8], Br[4];
#pragma unroll
            for (int nt = 0; nt < 8; ++nt) An[nt] = exp2f(16.0f * (float)(qt - nt) * l2g);
#pragma unroll
            for (int r = 0; r < 4; ++r) { Br[r] = exp2f((float)(fr - 4 * fq - r) * l2g); }
            const float rsc1 = exp2f((float)(16 * qt + fr + 1) * l2g);
            const float cdec = exp2f(128.0f * l2g);
            const float vsc0 = exp2f((float)(127 - (tid >> 3)) * l2g), vsc1 = exp2f((float)(127 - 64 - (tid >> 3)) * l2g);
            f32x4 st[2][2];
#pragma unroll
            for (int et = 0; et < 2; ++et)
#pragma unroll
                for (int dt = 0; dt < 2; ++dt) st[et][dt] = (f32x4){0.f, 0.f, 0.f, 0.f};
            __syncthreads();
            { const v4u z = {0u, 0u, 0u, 0u}; *(LAS v4u*)(lds + ST_OFF + tid * 32) = z; *(LAS v4u*)(lds + ST_OFF + tid * 32 + 16) = z; }
            for (int c = 0; c < SEQ / CHK; ++c) {
                const size_t tok0 = (size_t)b * SEQ + (size_t)c * CHK;
                {
                    const int ch32 = tid & 31, rb = tid >> 5; const bf16* src = PROJ + (tok0 + rb) * INC + RW + h * RDH + ch32 * 8;
                    const unsigned woff = (unsigned)((ch32 >> 4) * 32768 + 256 * rb + 16 * ((ch32 & 15) ^ (((rb & 3) << 2) | ((rb >> 2) & 3))));
                    v4u kv[8];
#pragma unroll
                    for (int i = 0; i < 8; ++i) kv[i] = *(const v4u*)(src + (size_t)(16 * i) * INC);
#pragma unroll
                    for (int i = 0; i < 8; ++i) *(LAS v4u*)(lds + KT_OFF + woff + i * 4096) = kv[i];
                }
                {
                    const int eg = tid & 7, tk = tid >> 3;
#pragma unroll
                    for (int i = 0; i < 2; ++i) { const v2u vv = *(const v2u*)(PROJ + (tok0 + tk + 64 * i) * INC + 2 * RW + h * RDH + es * 32 + eg * 4); const float sc = i ? vsc1 : vsc0;
                        LAS bf16* vt = (LAS bf16*)(lds + VT_OFF) + (4 * eg) * 136 + tk + 64 * i; LAS bf16* vs = (LAS bf16*)(lds + VS_OFF) + (4 * eg) * 136 + tk + 64 * i;
                        vt[0] = (bf16)(vv.x & 0xffffu); vt[136] = (bf16)(vv.x >> 16); vt[272] = (bf16)(vv.y & 0xffffu); vt[408] = (bf16)(vv.y >> 16);
                        vs[0] = (bf16)f2bf(bflo(vv.x) * sc); vs[136] = (bf16)f2bf(bfhi(vv.x) * sc); vs[272] = (bf16)f2bf(bflo(vv.y) * sc); vs[408] = (bf16)f2bf(bfhi(vv.y) * sc); }
                }
                bf16x8 qf[8];
                { const bf16* qsrc = PROJ + (tok0 + 16 * qt + fr) * INC + h * RDH + 8 * fq;
#pragma unroll
                  for (int s8 = 0; s8 < 8; ++s8) qf[s8] = *(const bf16x8*)(qsrc + 32 * s8); }
                __syncthreads();
                v4u pk[4];
#pragma unroll
                for (int s2 = 0; s2 < 4; ++s2) { v4u pw = {0u, 0u, 0u, 0u};
                    if (2 * s2 <= qt) {
                        f32x4 a0 = {0.f, 0.f, 0.f, 0.f}, a1 = {0.f, 0.f, 0.f, 0.f};
#pragma unroll
                        for (int s8 = 0; s8 < 8; ++s8) { const unsigned ko = (unsigned)((s8 >> 2) * 32768 + 256 * (32 * s2 + fr) + 16 * ((4 * (s8 & 3) + fq) ^ kswz));
                            const bf16x8 kf0 = *(const LAS bf16x8*)(lds + KT_OFF + ko), kf1 = *(const LAS bf16x8*)(lds + KT_OFF + ko + 4096);
                            a0 = __builtin_amdgcn_mfma_f32_16x16x32_bf16(kf0, qf[s8], a0, 0, 0, 0); a1 = __builtin_amdgcn_mfma_f32_16x16x32_bf16(kf1, qf[s8], a1, 0, 0, 0); }
                        { const int nt = 2 * s2; float p0 = a0[0] * An[nt] * Br[0], p1 = a0[1] * An[nt] * Br[1], p2 = a0[2] * An[nt] * Br[2], p3 = a0[3] * An[nt] * Br[3];
                          if (nt == qt) { const int dq = fr - 4 * fq; p0 = dq >= 0 ? p0 : 0.f; p1 = dq >= 1 ? p1 : 0.f; p2 = dq >= 2 ? p2 : 0.f; p3 = dq >= 3 ? p3 : 0.f; }
                          pw.x = cvtpk(p0, p1); pw.y = cvtpk(p2, p3); }
                        if (2 * s2 + 1 <= qt) { const int nt = 2 * s2 + 1; float p0 = a1[0] * An[nt] * Br[0], p1 = a1[1] * An[nt] * Br[1], p2 = a1[2] * An[nt] * Br[2], p3 = a1[3] * An[nt] * Br[3];
                          if (nt == qt) { const int dq = fr - 4 * fq; p0 = dq >= 0 ? p0 : 0.f; p1 = dq >= 1 ? p1 : 0.f; p2 = dq >= 2 ? p2 : 0.f; p3 = dq >= 3 ? p3 : 0.f; }
                          pw.z = cvtpk(p0, p1); pw.w = cvtpk(p2, p3); } }
                    pk[s2] = pw; }
                f32x4 oi[2], oc[2];
#pragma unroll
                for (int et = 0; et < 2; ++et) { oi[et] = (f32x4){0.f, 0.f, 0.f, 0.f}; oc[et] = (f32x4){0.f, 0.f, 0.f, 0.f}; }
#pragma unroll
                for (int s2 = 0; s2 < 4; ++s2) if (2 * s2 <= qt) {
#pragma unroll
                    for (int et = 0; et < 2; ++et) { const LAS unsigned char* vp = lds + VT_OFF + (16 * et + fr) * 272 + (32 * s2 + 4 * fq) * 2;
                        const v2u lo = *(const LAS v2u*)vp, hi = *(const LAS v2u*)(vp + 32); const v4u vw = {lo.x, lo.y, hi.x, hi.y};
                        oi[et] = __builtin_amdgcn_mfma_f32_16x16x32_bf16(__builtin_bit_cast(bf16x8, vw), __builtin_bit_cast(bf16x8, pk[s2]), oi[et], 0, 0, 0); } }
#pragma unroll
                for (int s8 = 0; s8 < 8; ++s8)
#pragma unroll
                    for (int et = 0; et < 2; ++et) { const bf16x8 sf = *(const LAS bf16x8*)(lds + ST_OFF + (16 * et + fr) * 512 + (((4 * s8 + fq) ^ fr) << 4));
                        oc[et] = __builtin_amdgcn_mfma_f32_16x16x32_bf16(sf, qf[s8], oc[et], 0, 0, 0); }
#pragma unroll
                for (int et = 0; et < 2; ++et) { v2u o; o.x = pk2(oi[et][0] + rsc1 * oc[et][0], oi[et][1] + rsc1 * oc[et][1]); o.y = pk2(oi[et][2] + rsc1 * oc[et][2], oi[et][3] + rsc1 * oc[et][3]);
                    *(v2u*)(RET + (tok0 + 16 * qt + fr) * RW + h * RDH + es * 32 + 16 * et + 4 * fq) = o; }
#pragma unroll
                for (int et = 0; et < 2; ++et)
#pragma unroll
                    for (int dt = 0; dt < 2; ++dt) st[et][dt] = st[et][dt] * cdec;
#pragma unroll
                for (int ks = 0; ks < 4; ++ks) { bf16x8 af[2];
#pragma unroll
                    for (int et = 0; et < 2; ++et) af[et] = *(const LAS bf16x8*)(lds + VS_OFF + (16 * et + fr) * 272 + 64 * ks + 16 * fq);
#pragma unroll
                    for (int dt = 0; dt < 2; ++dt) { const int cc = 2 * wave + dt, q_ = fr >> 2, p_ = fr & 3;
                        const int r0 = 32 * ks + 8 * fq + q_, r1 = r0 + 4;
                        const unsigned a0 = (unsigned)((cc >> 3) * 32768 + 256 * r0 + 16 * ((2 * (cc & 7) + (p_ >> 1)) ^ (((r0 & 3) << 2) | ((r0 >> 2) & 3))) + 8 * (p_ & 1));
                        const unsigned a1 = (unsigned)((cc >> 3) * 32768 + 256 * r1 + 16 * ((2 * (cc & 7) + (p_ >> 1)) ^ (((r1 & 3) << 2) | ((r1 >> 2) & 3))) + 8 * (p_ & 1));
                        const s16x4 t0 = __builtin_amdgcn_ds_read_tr16_b64_v4i16((LAS s16x4*)(lds + KT_OFF + a0)), t1 = __builtin_amdgcn_ds_read_tr16_b64_v4i16((LAS s16x4*)(lds + KT_OFF + a1));
                        const bf16x8 kf = __builtin_shufflevector(t0, t1, 0, 1, 2, 3, 4, 5, 6, 7);
#pragma unroll
                        for (int et = 0; et < 2; ++et) st[et][dt] = __builtin_amdgcn_mfma_f32_16x16x32_bf16(af[et], kf, st[et][dt], 0, 0, 0); } }
                __syncthreads();
#pragma unroll
                for (int et = 0; et < 2; ++et)
#pragma unroll
                    for (int dt = 0; dt < 2; ++dt)
#pragma unroll
                        for (int r = 0; r < 4; ++r) { const int e = 16 * et + 4 * fq + r, d = 32 * wave + 16 * dt + fr;
                            *(LAS bf16*)(lds + ST_OFF + e * 512 + ((((d >> 3) ^ (e & 15)) << 4) + (d & 7) * 2)) = (bf16)f2bf(st[et][dt][r]); }
            }
        }
        for (int m = gw; m < NTOK; m += NGW) { const bf16* p_ = PROJ + (size_t)m * INC + 5 * RW + lane * 8; float xv[32]; float s_ = 0.f;
#pragma unroll
            for (int i = 0; i < 4; ++i) { const v4u w = *(const v4u*)(p_ + 512 * i); xv[8 * i + 0] = bflo(w.x); xv[8 * i + 1] = bfhi(w.x); xv[8 * i + 2] = bflo(w.y); xv[8 * i + 3] = bfhi(w.y); xv[8 * i + 4] = bflo(w.z); xv[8 * i + 5] = bfhi(w.z); xv[8 * i + 6] = bflo(w.w); xv[8 * i + 7] = bfhi(w.w); }
#pragma unroll
            for (int i = 0; i < 32; ++i) s_ += xv[i];
            const float mu = wave_sum(s_) * (1.f / GMW); float q_ = 0.f;
#pragma unroll
            for (int i = 0; i < 32; ++i) { const float d_ = xv[i] - mu; q_ += d_ * d_; }
            const float rs = rsqrtf(wave_sum(q_) * (1.f / GMW) + EPS);
            if (lane == 0) { GSTAT[2 * m] = mu; GSTAT[2 * m + 1] = rs; } }
    }
    xcd_barrier(bar);
    }
#endif

#ifndef SK_P3
    { PTRS();
    for (int row = gw; row < NTOK; row += NGW) {
        const int c0 = (lane >> 3) * 256 + (lane & 7) * 8; const bf16* rp = RET + (size_t)row * RW + c0; const bf16* gp = PROJ + (size_t)row * INC + 3 * RW + c0;
        v4u rv[4], gv[4];
#pragma unroll
        for (int i = 0; i < 4; ++i) { rv[i] = *(const v4u*)(rp + 64 * i); gv[i] = *(const v4u*)(gp + 64 * i); }
        float v[32]; float s_ = 0.f;
#pragma unroll
        for (int i = 0; i < 4; ++i) { v[8 * i + 0] = bflo(rv[i].x); v[8 * i + 1] = bfhi(rv[i].x); v[8 * i + 2] = bflo(rv[i].y); v[8 * i + 3] = bfhi(rv[i].y); v[8 * i + 4] = bflo(rv[i].z); v[8 * i + 5] = bfhi(rv[i].z); v[8 * i + 6] = bflo(rv[i].w); v[8 * i + 7] = bfhi(rv[i].w); }
#pragma unroll
        for (int i = 0; i < 32; ++i) s_ += v[i];
        s_ += __shfl_xor(s_, 1); s_ += __shfl_xor(s_, 2); s_ += __shfl_xor(s_, 4);
        const float mu = s_ * (1.f / 256.f); float q_ = 0.f;
#pragma unroll
        for (int i = 0; i < 32; ++i) { v[i] -= mu; q_ += v[i] * v[i]; }
        q_ += __shfl_xor(q_, 1); q_ += __shfl_xor(q_, 2); q_ += __shfl_xor(q_, 4);
        const float rs = rsqrtf(q_ * (1.f / 256.f) + EPS);
#pragma unroll
        for (int i = 0; i < 4; ++i) { const f32x4 ga = *(const f32x4*)(ret_g + c0 + 64 * i), gb = *(const f32x4*)(ret_g + c0 + 64 * i + 4); v4u o;
            o.x = pk2(bflo(gv[i].x) * (v[8 * i + 0] * rs * ga.x), bfhi(gv[i].x) * (v[8 * i + 1] * rs * ga.y)); o.y = pk2(bflo(gv[i].y) * (v[8 * i + 2] * rs * ga.z), bfhi(gv[i].y) * (v[8 * i + 3] * rs * ga.w));
            o.z = pk2(bflo(gv[i].z) * (v[8 * i + 4] * rs * gb.x), bfhi(gv[i].z) * (v[8 * i + 5] * rs * gb.y)); o.w = pk2(bflo(gv[i].w) * (v[8 * i + 6] * rs * gb.z), bfhi(gv[i].w) * (v[8 * i + 7] * rs * gb.w));
            *(v4u*)(MIX + (size_t)row * D + c0 + 64 * i) = o; }
    }
    {
        const int fr = lane & 15, fq = lane >> 4, tt = wave < 4 ? wave : 11 - wave, q_ = fr >> 2, p_ = fr & 3;
        for (int ui = 0; ; ++ui) {
            int un; if (G == 256) { if (ui >= 2) break; un = (((bid & 7) * 8 + ui * 4 + (bid >> 6)) << 3) | ((bid >> 3) & 7); } else { un = bid + ui * G; if (un >= NB * (SEQ / CHK) * GG) break; }
            const int g = un & 7, n = (un >> 3) & 15, b = un >> 7; const size_t row0 = (size_t)b * SEQ + n * CHK;
            __syncthreads();
            {   const int ch = tid & 31, rb = tid >> 5; const int c0 = g * GCG + ch * 8;
                const f32x4 lga = *(const f32x4*)(ln_g + c0), lgb = *(const f32x4*)(ln_g + c0 + 4), lba = *(const f32x4*)(ln_b + c0), lbb = *(const f32x4*)(ln_b + c0 + 4);
                const unsigned woff = (unsigned)((ch >> 4) * 32768 + 256 * rb + 16 * ((ch & 15) ^ (((rb & 3) << 2) | ((rb >> 2) & 3))));
#pragma unroll
                for (int i = 0; i < 8; ++i) { const size_t row = row0 + rb + 16 * i; const v4u w = *(const v4u*)(PROJ + row * INC + 5 * RW + c0); const float mu = GSTAT[2 * row], rs = GSTAT[2 * row + 1];
                    v4u o; o.x = cvtpk((bflo(w.x) - mu) * rs * lga.x + lba.x, (bfhi(w.x) - mu) * rs * lga.y + lba.y); o.y = cvtpk((bflo(w.y) - mu) * rs * lga.z + lba.z, (bfhi(w.y) - mu) * rs * lga.w + lba.w);
                    o.z = cvtpk((bflo(w.z) - mu) * rs * lgb.x + lbb.x, (bfhi(w.z) - mu) * rs * lgb.y + lbb.y); o.w = cvtpk((bflo(w.w) - mu) * rs * lgb.z + lbb.z, (bfhi(w.w) - mu) * rs * lgb.w + lbb.w);
                    *(LAS v4u*)(lds + woff + i * 4096) = o; } }
            const int t_ = 16 * tt + fr, kmax = (16 * tt + 15) >> 5;
            v4u wf[4];
#pragma unroll
            for (int ks = 0; ks < 4; ++ks) { v4u w = {0u, 0u, 0u, 0u};
                if (ks <= kmax) { const float* wp = gm_ws + ((size_t)g * CHK + t_) * CHK + 32 * ks + 8 * fq; const f32x4 a = *(const f32x4*)wp, c = *(const f32x4*)(wp + 4); const int s0 = 32 * ks + 8 * fq;
                    w.x = cvtpk(s0 + 0 <= t_ ? a.x : 0.f, s0 + 1 <= t_ ? a.y : 0.f); w.y = cvtpk(s0 + 2 <= t_ ? a.z : 0.f, s0 + 3 <= t_ ? a.w : 0.f);
                    w.z = cvtpk(s0 + 4 <= t_ ? c.x : 0.f, s0 + 5 <= t_ ? c.y : 0.f); w.w = cvtpk(s0 + 6 <= t_ ? c.z : 0.f, s0 + 7 <= t_ ? c.w : 0.f); }
                wf[ks] = w; }
            const float bias = gm_bs[g * CHK + t_];
            __syncthreads();
            f32x4 acc[16];
#pragma unroll
            for (int ct = 0; ct < 16; ++ct) acc[ct] = (f32x4){0.f, 0.f, 0.f, 0.f};
#pragma unroll
            for (int ks = 0; ks < 4; ++ks) if (ks <= kmax) {
                const int r0 = 32 * ks + 8 * fq + q_, r1 = r0 + 4;
                const unsigned x0 = (unsigned)(((r0 & 3) << 2) | ((r0 >> 2) & 3)), x1 = (unsigned)(((r1 & 3) << 2) | ((r1 >> 2) & 3));
#pragma unroll
                for (int ct = 0; ct < 16; ++ct) { const unsigned chk = (unsigned)(2 * (ct & 7) + (p_ >> 1));
                    const s16x4 t0 = __builtin_amdgcn_ds_read_tr16_b64_v4i16((LAS s16x4*)(lds + (ct >> 3) * 32768 + 256 * r0 + 16 * (chk ^ x0) + 8 * (p_ & 1)));
                    const s16x4 t1 = __builtin_amdgcn_ds_read_tr16_b64_v4i16((LAS s16x4*)(lds + (ct >> 3) * 32768 + 256 * r1 + 16 * (chk ^ x1) + 8 * (p_ & 1)));
                    const bf16x8 vf = __builtin_shufflevector(t0, t1, 0, 1, 2, 3, 4, 5, 6, 7);
                    acc[ct] = __builtin_amdgcn_mfma_f32_16x16x32_bf16(vf, __builtin_bit_cast(bf16x8, wf[ks]), acc[ct], 0, 0, 0);
                    if ((ct & 7) == 7) asm volatile("" ::: "memory"); } }
            {   const size_t row = row0 + t_; const bf16* up = PROJ + row * INC + 4 * RW + g * GCG;
#pragma unroll
                for (int c4 = 0; c4 < 16; c4 += 4) { unsigned ox[4], oy[4];
                    const v4u ua = *(const v4u*)(up + 16 * (c4 + fq)), ub = *(const v4u*)(up + 16 * (c4 + fq) + 8);
                    unsigned ux[4] = {ua.x, ua.z, ub.x, ub.z}, uy[4] = {ua.y, ua.w, ub.y, ub.w};
                    rows4x4_transpose(ux[0], ux[1], ux[2], ux[3]); rows4x4_transpose(uy[0], uy[1], uy[2], uy[3]);
#pragma unroll
                    for (int i = 0; i < 4; ++i) { const int ct = c4 + i;
                        ox[i] = cvtpk(bflo(ux[i]) * (acc[ct][0] + bias), bfhi(ux[i]) * (acc[ct][1] + bias)); oy[i] = cvtpk(bflo(uy[i]) * (acc[ct][2] + bias), bfhi(uy[i]) * (acc[ct][3] + bias)); }
                    rows4x4_transpose(ox[0], ox[1], ox[2], ox[3]); rows4x4_transpose(oy[0], oy[1], oy[2], oy[3]);
                    bf16* o16 = MIX + row * D + RW + g * GCG + 16 * (c4 + fq);
                    *(v4u*)o16 = (v4u){ox[0], oy[0], ox[1], oy[1]}; *(v4u*)(o16 + 8) = (v4u){ox[2], oy[2], ox[3], oy[3]}; } }
        }
    }
    xcd_barrier(bar);

    }
#endif
#ifndef SK_P4
    { PTRS();
    {   pg8::Gemm g{MIX, WtOut, NTOK, D, D}; pg8::StaticOrder S; S.init(NTOK, D, G, bid);
        pg8::EpiResidNorm E{x, XN, SSP, D};
        pg8::gemm_phase<pg8::EpiResidNorm, pg8::StaticOrder, PG8_ALIGN, PG8_SP2>(lds + RING_OFF, g, S, E); }
    xcd_barrier(bar);
    }
#endif
#ifndef SK_P5
    { PTRS();
    {   pg8::Gemm g{XN, WtQ, NTOK, XW, D}; pg8::StaticOrder S; S.init(NTOK, XW, G, bid);
        LAS float* rs = (LAS float*)(lds + AUX_OFF);
        for (int ui = 0; ; ++ui) { pg8::Unit u; if (!S.next(ui, u)) break;
            __syncthreads();
            if (tid < 256) { const float* sp = SSP + u.pm * 256 + tid; float ss = 0.f;
#pragma unroll
                for (int j = 0; j < 16; ++j) ss += (sp[(size_t)(4 * j) * NTOK] + sp[(size_t)(4 * j + 1) * NTOK]) + (sp[(size_t)(4 * j + 2) * NTOK] + sp[(size_t)(4 * j + 3) * NTOK]);
                rs[tid] = rsqrtf(ss * (1.f / D) + EPS); }
            __syncthreads();
            pg8::Gemm g1 = g;
            struct OneUnit { pg8::Unit u; __device__ bool next(int i, pg8::Unit& o) const { if (i) return false; o = u; return true; } __device__ __forceinline__ void a_ready(const pg8::Unit&) const {} __device__ __forceinline__ void done(const pg8::Unit&) const {} } O1{u};
            pg8::EpiBf16RowScale E{QX, XW, rs};
            pg8::gemm_phase<pg8::EpiBf16RowScale, OneUnit, PG8_ALIGN, PG8_SP2>(lds + RING_OFF, g1, O1, E); } }
    {   pg8::Gemm g{MN, WtKV, NMEM, XW, D}; pg8::StaticOrder S; S.init(NMEM, XW, G, (bid + G - 128 % G) % G);
        pg8::EpiBf16<0> E{KX, XW, nullptr, 0, 0, 1.f};
        pg8::gemm_phase<pg8::EpiBf16<0>, pg8::StaticOrder, PG8_ALIGN, PG8_SP2>(lds + RING_OFF, g, S, E); }
    {   pg8::Gemm g{WtKV + (size_t)XW * D, MN, XW, NMEM, D}; pg8::StaticOrder S; S.init(XW, NMEM, G, (bid + G - 144 % G) % G);
        pg8::EpiBf16<0> E{VT, NMEM, nullptr, 0, 0, 1.f};
        pg8::gemm_phase<pg8::EpiBf16<0>, pg8::StaticOrder, PG8_ALIGN, PG8_SP2>(lds + RING_OFF, g, S, E); }
    xcd_barrier(bar);
    }
#endif
#ifndef SK_P6
    { PTRS();
    {
        const int fr = lane & 15, fq = lane >> 4; const int kkey = (((fr >> 2) & 3) << 2) | (fr & 3);
        for (int ui = 0; ; ++ui) {
            int un; if (G == 256) { if (ui >= 1) break; un = ((((bid & 7) * 2 + (bid >> 7)) << 4) | ((bid >> 3) & 15)); } else { un = bid + ui * G; if (un >= NB * XH * 16) break; }
            const int qb = un & 15, h = (un >> 4) & 3, b = un >> 6; const size_t row0 = (size_t)b * SEQ + qb * 128;
            const int ch = tid & 31, rb = tid >> 5;
            __syncthreads();
            {   v4u kv[16]; const bf16* src = KX + ((size_t)b * MEML + rb) * XW + h * XDH + ch * 8;
#pragma unroll
                for (int i = 0; i < 16; ++i) kv[i] = *(const v4u*)(src + (size_t)(16 * i) * XW);
#pragma unroll
                for (int i = 0; i < 16; ++i) { const int m = rb + 16 * i; *(LAS v4u*)(lds + m * 512 + ((ch ^ ((((m >> 3) & 3) << 2) | (m & 3))) << 4)) = kv[i]; } }
            bf16x8 qf[8];
            { const bf16* qsrc = QX + (row0 + 16 * wave + fr) * XW + h * XDH + 8 * fq;
#pragma unroll
              for (int s8 = 0; s8 < 8; ++s8) qf[s8] = *(const bf16x8*)(qsrc + 32 * s8); }
            __syncthreads();
            f32x4 sa[16];
#pragma unroll
            for (int nt = 0; nt < 16; ++nt) { f32x4 a = {0.f, 0.f, 0.f, 0.f}; const int mrow = 32 * (nt >> 1) + 8 * (fr >> 2) + 4 * (nt & 1) + (fr & 3);
#pragma unroll
                for (int s8 = 0; s8 < 8; ++s8) { const bf16x8 kf = *(const LAS bf16x8*)(lds + mrow * 512 + (((4 * s8 + fq) ^ kkey) << 4)); a = __builtin_amdgcn_mfma_f32_16x16x32_bf16(kf, qf[s8], a, 0, 0, 0); }
                sa[nt] = a; if (nt & 1) asm volatile("" ::: "memory"); }
            float mx = sa[0][0];
#pragma unroll
            for (int nt = 0; nt < 16; ++nt) mx = fmaxf(fmaxf(fmaxf(mx, sa[nt][0]), fmaxf(sa[nt][1], sa[nt][2])), sa[nt][3]);
            mx = fmaxf(mx, __shfl_xor(mx, 16)); mx = fmaxf(mx, __shfl_xor(mx, 32));
            float sum = 0.f; const float cs = 0.0625f * 1.4426950408889634f;
#pragma unroll
            for (int nt = 0; nt < 16; ++nt)
#pragma unroll
                for (int r = 0; r < 4; ++r) { const float e = __builtin_amdgcn_exp2f((sa[nt][r] - mx) * cs); sa[nt][r] = e; sum += e; }
            sum += __shfl_xor(sum, 16); sum += __shfl_xor(sum, 32);
            const float inv = 1.0f / sum;
            v4u pf[8];
#pragma unroll
            for (int s8 = 0; s8 < 8; ++s8) { v4u w; w.x = cvtpk(sa[2 * s8][0] * inv, sa[2 * s8][1] * inv); w.y = cvtpk(sa[2 * s8][2] * inv, sa[2 * s8][3] * inv);
                w.z = cvtpk(sa[2 * s8 + 1][0] * inv, sa[2 * s8 + 1][1] * inv); w.w = cvtpk(sa[2 * s8 + 1][2] * inv, sa[2 * s8 + 1][3] * inv); pf[s8] = w; }
            asm volatile("" ::: "memory");
            v4u vreg[16];
            { const bf16* src = VT + ((size_t)h * XDH + rb) * NMEM + b * MEML + ch * 8;
#pragma unroll
              for (int i = 0; i < 16; ++i) vreg[i] = *(const v4u*)(src + (size_t)(16 * i) * NMEM); }
            __syncthreads();
#pragma unroll
            for (int i = 0; i < 16; ++i) { const int d = rb + 16 * i; *(LAS v4u*)(lds + d * 512 + ((ch ^ (d & 15)) << 4)) = vreg[i]; }
            __syncthreads();
            f32x4 o[16];
#pragma unroll
            for (int dt = 0; dt < 16; ++dt) o[dt] = (f32x4){0.f, 0.f, 0.f, 0.f};
#pragma unroll
            for (int s8 = 0; s8 < 8; ++s8)
#pragma unroll
                for (int dt = 0; dt < 16; ++dt) { const bf16x8 vf = *(const LAS bf16x8*)(lds + (16 * dt + fr) * 512 + (((4 * s8 + fq) ^ fr) << 4));
                    o[dt] = __builtin_amdgcn_mfma_f32_16x16x32_bf16(vf, __builtin_bit_cast(bf16x8, pf[s8]), o[dt], 0, 0, 0); if ((dt & 7) == 7) asm volatile("" ::: "memory"); }
            bf16* op = OX + (row0 + 16 * wave + fr) * XW + h * XDH;
#pragma unroll
            for (int c4 = 0; c4 < 16; c4 += 4) { unsigned ox[4], oy[4];
#pragma unroll
                for (int i = 0; i < 4; ++i) { ox[i] = cvtpk(o[c4 + i][0], o[c4 + i][1]); oy[i] = cvtpk(o[c4 + i][2], o[c4 + i][3]); }
                rows4x4_transpose(ox[0], ox[1], ox[2], ox[3]); rows4x4_transpose(oy[0], oy[1], oy[2], oy[3]);
                bf16* o16 = op + 16 * (c4 + fq);
                *(v4u*)o16 = (v4u){ox[0], oy[0], ox[1], oy[1]}; *(v4u*)(o16 + 8) = (v4u){ox[2], oy[2], ox[3], oy[3]}; }
        }
    }
    xcd_barrier(bar);
    }
#endif
#ifndef SK_P7
    { PTRS();
    {   pg8::Gemm g{OX, WtO, NTOK, D, XW}; pg8::StaticOrder S; S.init(NTOK, D, G, bid);
        pg8::EpiResid E{XN, HB, D};
        pg8::gemm_phase<pg8::EpiResid, pg8::StaticOrder, PG8_ALIGN, PG8_SP2>(lds + RING_OFF, g, S, E); }
    xcd_barrier(bar);
    }
#endif
#ifndef SK_P7b
    { PTRS();
    __syncthreads();
    for (int i = tid; i < 8 * D / 4; i += NT) ((LAS f32x4*)lds)[i] = ((const f32x4*)WrT)[i];
    __syncthreads();
    for (int m = gw; m < NTOK; m += NGW) {
        const v2u* xr = (const v2u*)(HB + (size_t)m * D) + lane; f32x4 v[16]; float ss = 0.f;
#pragma unroll
        for (int j = 0; j < 16; ++j) { const v2u t = xr[64 * j]; v[j] = (f32x4){bflo(t.x), bfhi(t.x), bflo(t.y), bfhi(t.y)}; ss += (v[j].x * v[j].x + v[j].y * v[j].y) + (v[j].z * v[j].z + v[j].w * v[j].w); }
        const float rs = rsqrtf(wave_sum(ss) * (1.f / D) + EPS);
        const f32x4* gr = (const f32x4*)g_moe + lane; int* o8 = (int*)(XN8 + (size_t)m * D) + lane;
#pragma unroll
        for (int j = 0; j < 16; ++j) { const f32x4 gg = gr[64 * j]; v[j] = v[j] * rs * gg; }
        asm volatile("" ::: "memory");
#pragma unroll
        for (int j = 0; j < 16; ++j) o8[64 * j] = pack4_fp8_sat(v[j].x, v[j].y, v[j].z, v[j].w);
        int gi = 0; float gm = -3.0e38f, den = 0.f;
#pragma unroll 1
        for (int j = 0; j < 8; ++j) { const LAS f32x4* wr_ = (const LAS f32x4*)(lds + j * 16384) + lane; float acc = 0.f;
#pragma unroll
            for (int q = 0; q < 16; ++q) { const f32x4 w = wr_[64 * q]; acc += (v[q].x * w.x + v[q].y * w.y) + (v[q].z * w.z + v[q].w * w.w); }
            const float l = wave_sum(acc) + rgb[j];
            if (l > gm) { den = den * __expf(gm - l) + 1.0f; gm = l; gi = j; } else den += __expf(l - gm); }
        const float ggate = 1.0f / den;
        int i0 = 0, i1 = 0; float v0 = -3.0e38f, v1 = -3.0e38f;
#pragma unroll 1
        for (int p = 0; p < 8; p += 2) { const f32x4* wa_ = (const f32x4*)(WrT + (size_t)(8 + gi * 8 + p) * D) + lane; const f32x4* wb_ = wa_ + D / 4; float acca = 0.f, accb = 0.f;
#pragma unroll
            for (int q = 0; q < 16; ++q) { const f32x4 wa = wa_[64 * q], wb = wb_[64 * q]; acca += (v[q].x * wa.x + v[q].y * wa.y) + (v[q].z * wa.z + v[q].w * wa.w); accb += (v[q].x * wb.x + v[q].y * wb.y) + (v[q].z * wb.z + v[q].w * wb.w); }
            const float la = wave_sum(acca) + reb[gi * 8 + p], lb = wave_sum(accb) + reb[gi * 8 + p + 1];
            if (la > v0) { v1 = v0; i1 = i0; v0 = la; i0 = p; } else if (la > v1) { v1 = la; i1 = p; }
            if (lb > v0) { v1 = v0; i1 = i0; v0 = lb; i0 = p + 1; } else if (lb > v1) { v1 = lb; i1 = p + 1; } }
        const float e1 = __expf(v1 - v0), g0 = 1.0f / (1.0f + e1), g1 = e1 / (1.0f + e1);
        if (lane == 0) { EID[2 * m] = gi * 8 + i0; EID[2 * m + 1] = gi * 8 + i1; GATE[2 * m] = g0 * ggate; GATE[2 * m + 1] = g1 * ggate; }
    }
    if (G == 256) {
        __syncthreads();
        const int xcd = XCD_OF(bid), i = IDX_OF(bid); const int e = xcd * 8 + (i >> 3), hs = i & 7;
        moe_prefetch_w(lds, wave, ((lane & 31) < 16 ? wg : wu) + (size_t)e * D * FF + (size_t)(8 * wave + (lane >> 5)) * FF + hs * 64 + 4 * (lane & 15), FF);
        if (tid == 0) MISC[13] = 1u; }
    xcd_barrier(bar);
    }
#endif
#ifndef SK_P9
    { PTRS();
    {   LAS unsigned short* list = (LAS unsigned short*)(lds + LIST_OFF); LAS int* sc = (LAS int*)(lds + SC_OFF);
        const float* whave = nullptr;
        const bool xpre = MISC[13] != 0u;
        if (tid == 0) MISC[12] = 0u;
        for (int ui = 0; ; ++ui) {
            int un; if (G == 256) { if (ui >= 2) break; const int xcd = XCD_OF(bid), i = IDX_OF(bid); un = ((xcd * 8 + ui * 4 + (i >> 3)) << 3) | (i & 7); } else { un = bid + ui * G; if (un >= NE * 8) break; }
            const int e = un >> 3, hs = un & 7; int off; __syncthreads();
            int tl = tid; asm volatile("" : "+v"(tl));
            const int cnt = build_list16(EID, e, list, sc, tl, off);
            if (hs == 0) { for (int r = tl; r < cnt; r += NT) SLOTS[off + r] = (int)list[r]; if (tid == 0) { OFFCNT[2 * e] = off; OFFCNT[2 * e + 1] = cnt; } }
            const float* bptr = ((lane & 31) < 16 ? wg : wu) + (size_t)e * D * FF + (size_t)(8 * wave + (lane >> 5)) * FF + hs * 64 + 4 * (lane & 15);
            for (int row0 = 0; row0 < cnt; row0 += 384) {
                unsigned aoff[3];
#pragma unroll
                for (int i = 0; i < 3; ++i) { const int r = min(row0 + 16 * (3 * wave + i) + (lane >> 2), cnt - 1); aoff[i] = (unsigned)(list[r] >> 1) * (unsigned)D + (unsigned)(((lane & 3) ^ MOE_KEY((lane >> 4) & 3)) << 4); }
                const int nrp = (min(cnt - row0, 384) + 15) & ~15; const int ndma = max(0, min(3, (nrp - 48 * wave + 15) >> 4));
                auto epi = [=](int, const f32x4 (&acc)[3][8]) {
                    const int fr = lane & 15, fq = lane >> 4; const float is = 1.0f / 64.0f;
#pragma unroll
                    for (int sl = 0; sl < 3; ++sl) { const int r = row0 + (wave + 8 * sl) * 16 + fr; unsigned w[4];
#pragma unroll
                        for (int nt = 0; nt < 4; ++nt) { const f32x4 gv = acc[sl][nt] * is, uv = acc[sl][nt + 4] * is;
                            w[nt] = (unsigned)pack4_fp8_sat(silu_f(gv[0]) * uv[0], silu_f(gv[1]) * uv[1], silu_f(gv[2]) * uv[2], silu_f(gv[3]) * uv[3]); }
                        rows4x4_transpose(w[0], w[1], w[2], w[3]);
                        if (r < cnt && r < row0 + 384) *(v4u*)(HACT8 + (size_t)(off + r) * FF + hs * 64 + 16 * fq) = (v4u){w[0], w[1], w[2], w[3]}; } };
                const bool lastpass = row0 + 384 >= cnt; const bool xph = lastpass && G == 256 && ui == 1;
                const float* bnx = (lastpass && G == 256 && ui == 0) ? bptr + (size_t)4 * D * FF
                                 : xph ? wd + (size_t)(e - 4) * FF * D + (size_t)(8 * wave + (lane >> 5)) * D + hs * 512 + 4 * (lane & 31) : bptr;
                const bool pre = __builtin_amdgcn_readfirstlane((int)(whave == bptr)) != 0 || (xpre && ui == 0 && row0 == 0);
                if (16 * (wave + 16) < nrp) moe_kloop<1, 3>(lds, tid, wave, lane, XN8, aoff, ndma, bptr, FF, D, (size_t)0, 64.0f, epi, bnx, xph ? D : FF, pre);
                else moe_kloop<1, 2>(lds, tid, wave, lane, XN8, aoff, ndma, bptr, FF, D, (size_t)0, 64.0f, epi, bnx, xph ? D : FF, pre);
                whave = bnx; if (xph && tid == 0) MISC[12] = 1u;
            }
        }
    }
    xcd_barrier(bar);
    }
#endif
#ifndef SK_P10
    { PTRS();
    {   const float* whave = nullptr; const bool xpre = MISC[12] != 0u;
        for (int ui = 0; ; ++ui) {
            int un; if (G == 256) { if (ui >= 2) break; const int xcd = XCD_OF(bid), i = IDX_OF(bid); un = ((xcd * 8 + ui * 4 + (i >> 3)) << 3) | (i & 7); } else { un = bid + ui * G; if (un >= NE * 8) break; }
            const int e = un >> 3, c8 = un & 7; const int off = OFFCNT[2 * e], cnt = OFFCNT[2 * e + 1];
            const float* bptr = wd + (size_t)e * FF * D + (size_t)(8 * wave + (lane >> 5)) * D + c8 * 512 + 4 * (lane & 31);
            for (int row0 = 0; row0 < cnt; row0 += 384) {
                unsigned aoff[3];
#pragma unroll
                for (int i = 0; i < 3; ++i) { const int r = min(row0 + 16 * (3 * wave + i) + (lane >> 2), cnt - 1); aoff[i] = (unsigned)(off + r) * (unsigned)FF + (unsigned)(((lane & 3) ^ MOE_KEY((lane >> 4) & 3)) << 4); }
                const int nrp = (min(cnt - row0, 384) + 15) & ~15; const int ndma = max(0, min(3, (nrp - 48 * wave + 15) >> 4));
                const int fr = lane & 15, fq = lane >> 4;
                int slot[3]; float gt[3];
#pragma unroll
                for (int sl = 0; sl < 3; ++sl) { const int r = row0 + (wave + 8 * sl) * 16 + fr; slot[sl] = (r < cnt && r < row0 + 384) ? SLOTS[off + r] : -1; gt[sl] = slot[sl] >= 0 ? GATE[slot[sl]] : 0.f; }
                auto epi = [=](int seg, const f32x4 (&acc)[3][8]) {
#pragma unroll
                    for (int sl = 0; sl < 3; ++sl) { unsigned w[8];
#pragma unroll
                        for (int nt = 0; nt < 8; ++nt) { const f32x4 v = acc[sl][nt]; w[nt] = (unsigned)pack4_fp8_sat(gt[sl] * v[0], gt[sl] * v[1], gt[sl] * v[2], gt[sl] * v[3]); }
#pragma unroll
                        for (int a = 0; a < 8; a += 4) rows4x4_transpose(w[a + 0], w[a + 1], w[a + 2], w[a + 3]);
                        if (slot[sl] >= 0) { unsigned char* yp = Y8 + (size_t)slot[sl] * D + c8 * 512 + seg * 128 + 16 * fq;
                            __builtin_nontemporal_store((v4u){w[0], w[1], w[2], w[3]}, (v4u*)yp); __builtin_nontemporal_store((v4u){w[4], w[5], w[6], w[7]}, (v4u*)(yp + 64)); } } };
                const bool lastpass = row0 + 384 >= cnt; const float* bnx = (lastpass && G == 256 && ui == 0) ? bptr + (size_t)4 * FF * D : bptr;
                const bool pre = __builtin_amdgcn_readfirstlane((int)(whave == bptr)) != 0 || (xpre && ui == 0 && row0 == 0);
                if (16 * (wave + 16) < nrp) moe_kloop<4, 3>(lds, tid, wave, lane, HACT8, aoff, ndma, bptr, D, FF, (size_t)128 * 4, 16.0f, epi, bnx, D, pre);
                else moe_kloop<4, 2>(lds, tid, wave, lane, HACT8, aoff, ndma, bptr, D, FF, (size_t)128 * 4, 16.0f, epi, bnx, D, pre);
                whave = bnx;
            }
        }
    }
    xcd_barrier(bar);
    }
#endif
#ifndef SK_P11
    { PTRS();
    f32x4 ga[8], gb[8];
#pragma unroll
    for (int j = 0; j < 8; ++j) { ga[j] = *(const f32x4*)(g_fin + 8 * lane + 512 * j); gb[j] = *(const f32x4*)(g_fin + 8 * lane + 512 * j + 4); }
    for (int m = gw; m < NTOK; m += NGW) {
        const bf16* hr = HB + (size_t)m * D + 8 * lane; const unsigned char* y0 = Y8 + (size_t)(2 * m) * D + 8 * lane; const unsigned char* y1 = y0 + D;
        f32x4 va[8], vb[8]; float ss = 0.f; const float ys = 1.0f / 16.0f;
#pragma unroll
        for (int j = 0; j < 8; ++j) { const v2u a0 = __builtin_nontemporal_load((const v2u*)(y0 + 512 * j)), a1 = __builtin_nontemporal_load((const v2u*)(y1 + 512 * j)); const v4u hh = __builtin_nontemporal_load((const v4u*)(hr + 512 * j)); f32x4 ta = (f32x4){bflo(hh.x), bfhi(hh.x), bflo(hh.y), bfhi(hh.y)}, tb = (f32x4){bflo(hh.z), bfhi(hh.z), bflo(hh.w), bfhi(hh.w)};
            const f32x2g p0 = __builtin_amdgcn_cvt_pk_f32_fp8((int)a0.x, false), p1 = __builtin_amdgcn_cvt_pk_f32_fp8((int)a0.x, true), p2 = __builtin_amdgcn_cvt_pk_f32_fp8((int)a0.y, false), p3 = __builtin_amdgcn_cvt_pk_f32_fp8((int)a0.y, true);
            const f32x2g q0 = __builtin_amdgcn_cvt_pk_f32_fp8((int)a1.x, false), q1 = __builtin_amdgcn_cvt_pk_f32_fp8((int)a1.x, true), q2 = __builtin_amdgcn_cvt_pk_f32_fp8((int)a1.y, false), q3 = __builtin_amdgcn_cvt_pk_f32_fp8((int)a1.y, true);
            ta.x = (ta.x + p0.x * ys) + q0.x * ys; ta.y = (ta.y + p0.y * ys) + q0.y * ys; ta.z = (ta.z + p1.x * ys) + q1.x * ys; ta.w = (ta.w + p1.y * ys) + q1.y * ys;
            tb.x = (tb.x + p2.x * ys) + q2.x * ys; tb.y = (tb.y + p2.y * ys) + q2.y * ys; tb.z = (tb.z + p3.x * ys) + q3.x * ys; tb.w = (tb.w + p3.y * ys) + q3.y * ys;
            va[j] = ta; vb[j] = tb; ss += ((ta.x * ta.x + ta.y * ta.y) + (ta.z * ta.z + ta.w * ta.w)) + ((tb.x * tb.x + tb.y * tb.y) + (tb.z * tb.z + tb.w * tb.w)); }
        const float rs = rsqrtf(wave_sum(ss) * (1.f / D) + EPS);
        float* orow = out + (size_t)m * D + 8 * lane;
#pragma unroll
        for (int j = 0; j < 8; ++j) { __builtin_nontemporal_store(va[j] * rs * ga[j], (f32x4*)(orow + 512 * j)); __builtin_nontemporal_store(vb[j] * rs * gb[j], (f32x4*)(orow + 512 * j + 4)); }
    }
    }
#endif
}

extern "C" void kernel_launch(void* const* d_in, const int* in_sizes, int n_in, void* d_out, int out_size, void* d_ws, size_t ws_size, hipStream_t stream) {
    static int grid = 0;
    if (grid == 0) {
        if (n_in != 25 || out_size != NTOK * D || ws_size < WS_END) { fprintf(stderr, "kernel_launch: unexpected shapes (n_in %d out %d ws %zu)\n", n_in, out_size, ws_size); grid = -1; return; }
        int dev = 0, cus = 0, per_cu = 0;
        if (hipGetDevice(&dev) != hipSuccess || hipDeviceGetAttribute(&cus, hipDeviceAttributeMultiprocessorCount, dev) != hipSuccess) { grid = -1; return; }
        if (hipFuncSetAttribute((const void*)mk_fwd, hipFuncAttributeMaxDynamicSharedMemorySize, LDS_BYTES) != hipSuccess) { fprintf(stderr, "kernel_launch: hipFuncSetAttribute failed\n"); grid = -1; return; }
        if (hipOccupancyMaxActiveBlocksPerMultiprocessor(&per_cu, (const void*)mk_fwd, NWAVES * 64, LDS_BYTES) != hipSuccess || per_cu < 1) { fprintf(stderr, "kernel_launch: occupancy query reports %d blocks per CU\n", per_cu); }
        (void)hipGetLastError();
        grid = cus;
    }
    if (grid < 0) return;
    if (hipMemsetAsync((char*)d_ws + WS_CTL, 0, CTL_ZERO_BYTES, stream) != hipSuccess) return;
    Args a{};
    for (int i = 0; i < 25; ++i) a.in[i] = d_in[i];
    a.out = (float*)d_out; a.ws = (unsigned char*)d_ws;
    hipLaunchKernelGGL(mk_fwd, dim3(grid), dim3(NWAVES * 64), LDS_BYTES, stream, a);
}
```
